# Optimizing an MI355X kernel written in HIP

```python
import jax
import jax.numpy as jnp
from jax import lax
import numpy as np

D_MODEL = 1024
BATCH = 2
SEQ = 8192
DEPTH = 2
DEC_BATCH = 32
DEC_SEQ = 1
PAST_LEN = 16384
PAGE_SIZE = 128

ATTN_GROUPS = ((128, 1), (512, 4), (2048, 16))
N_GROUPS = 3
HEADS_PER_GROUP = 4
HD_A = 128
ATTN_BLK = 128
N_BUCKETS = 32
REL_MAX_DIST = 2048
HR = 4
DK_R = 128
DV_R = 256
RET_CHUNK = 128
N_KEYS = 128
N_EXPERTS = N_KEYS * N_KEYS
PEER_HEADS = 8
PEER_TOPK = 16
PEER_DQ = 256
PEER_BLK = 128
EPS = 1e-6
NEG = -1e30

QA_W = N_GROUPS * HEADS_PER_GROUP * HD_A
RQ_W = HR * DK_R
RV_W = HR * DV_R
ATTN_OUT_W = HEADS_PER_GROUP * HD_A
SPLITS = (QA_W, QA_W, QA_W, RQ_W, RQ_W, RV_W, RV_W, 2 * D_MODEL)
IN_COLS = sum(SPLITS)

kernel_name = 'dilated_attn_retention_peer_hybrid_step'


def _rms(x, w=None):
    xf = x.astype(jnp.float32)
    y = xf * lax.rsqrt(jnp.mean(xf * xf, axis=-1, keepdims=True) + EPS)
    return y if w is None else y * w.astype(jnp.float32)


def _t5_bucket(dist):
    dist = np.asarray(dist, np.int64)
    max_exact = N_BUCKETS // 2
    ratio = np.log(np.maximum(dist, 1) / max_exact) / np.log(REL_MAX_DIST / max_exact)
    large = np.minimum(max_exact + (ratio * (N_BUCKETS - max_exact)).astype(np.int64), N_BUCKETS - 1)
    return np.where(dist < max_exact, dist, large).astype(np.int32)


def _to_sub(x, d):
    b, s = x.shape[:2]
    ls = s // d
    lp = -(-ls // ATTN_BLK) * ATTN_BLK
    x = x.reshape((b, ls, d) + x.shape[2:])
    x = jnp.moveaxis(x, 2, 1).reshape((b * d, ls) + x.shape[3:])
    x = jnp.pad(x, [(0, 0), (0, lp - ls)] + [(0, 0)] * (x.ndim - 2))
    return x.reshape((b * d, lp // ATTN_BLK, ATTN_BLK) + x.shape[2:])


def _from_sub(y, b, s, d):
    ls = s // d
    y = y.reshape((b * d, -1) + y.shape[3:])[:, :ls]
    y = y.reshape((b, d, ls) + y.shape[2:])
    return jnp.moveaxis(y, 1, 2).reshape((b, s) + y.shape[3:])


def _dilated_prompt(q, k, v, bias_tab, window, d):
    b, s = q.shape[:2]
    steps = window // d
    qb, kb, vb = _to_sub(q, d), _to_sub(k, d), _to_sub(v, d)
    nb = qb.shape[1]

    def with_prev(t):
        prev = jnp.pad(t, [(0, 0), (1, 0)] + [(0, 0)] * (t.ndim - 2))[:, :-1]
        return jnp.concatenate([prev, t], axis=2)

    kk, vv = with_prev(kb), with_prev(vb)
    qi = np.arange(ATTN_BLK)[:, None]
    ki = np.arange(2 * ATTN_BLK)[None, :]
    m = ATTN_BLK + qi - ki
    band = (m >= 0) & (m <= steps)
    bias = jnp.transpose(bias_tab[_t5_bucket(np.clip(m, 0, steps) * d)], (2, 0, 1))
    mask = jnp.asarray(band)[None] & ((jnp.arange(nb)[:, None, None] > 0) | jnp.asarray(ki >= ATTN_BLK)[None])
    sc = jnp.einsum('nbqhd,nbkhd->nbhqk', qb, kk) + bias
    sc = jnp.where(mask[None, :, None], sc, NEG)
    lse = jax.nn.logsumexp(sc, axis=-1)
    p = jnp.exp(sc - lse[..., None])
    o = jnp.einsum('nbhqk,nbkhd->nbqhd', p, vv)
    lse = jnp.moveaxis(lse, 2, 3)
    return _from_sub(o, b, s, d), _from_sub(lse, b, s, d)


def _dilated_sample(q, k, v, kv_buf, bias_tab, window, d):
    t = q.shape[1]
    lg = kv_buf.shape[1]
    steps = window // d
    j = np.arange(steps + 1)
    idx = lg + np.arange(t)[:, None] - j[None, :] * d
    valid = jnp.asarray(idx >= 0)
    idx = np.maximum(idx, 0)
    keys = jnp.concatenate([kv_buf[:, :, 0].astype(jnp.float32), k], axis=1)
    vals = jnp.concatenate([kv_buf[:, :, 1].astype(jnp.float32), v], axis=1)
    kg, vg = keys[:, idx], vals[:, idx]
    bias = bias_tab[_t5_bucket(j * d)].T
    sc = jnp.einsum('bthd,btjhd->bthj', q, kg) + bias
    sc = jnp.where(valid[None, :, None, :], sc, NEG)
    lse = jax.nn.logsumexp(sc, axis=-1)
    p = jnp.exp(sc - lse[..., None])
    return jnp.einsum('bthj,btjhd->bthd', p, vg), lse


def _combine(outs, lses):
    w = jax.nn.softmax(jnp.stack(lses, 0), axis=0)
    return jnp.einsum('gbthd,gbth->bthd', jnp.stack(outs, 0), w)


def _attn_prompt(q, k, v, bias_g, out_dtype):
    outs, lses, rows = [], [], []
    for g, (window, dil) in enumerate(ATTN_GROUPS):
        o, l = _dilated_prompt(q[:, :, g], k[:, :, g], v[:, :, g], bias_g[:, g], window, dil)
        outs.append(o)
        lses.append(l)
        keep = min(window, q.shape[1])
        rows.append(jnp.stack([k[:, -keep:, g], v[:, -keep:, g]], axis=2).astype(out_dtype))
    return _combine(outs, lses), rows


def _attn_sample(q, k, v, bufs, bias_g, out_dtype):
    outs, lses, rows = [], [], []
    for g, (window, dil) in enumerate(ATTN_GROUPS):
        o, l = _dilated_sample(q[:, :, g], k[:, :, g], v[:, :, g], bufs[g], bias_g[:, g], window, dil)
        outs.append(o)
        lses.append(l)
        rows.append(jnp.stack([k[:, :, g], v[:, :, g]], axis=2).astype(out_dtype))
    return _combine(outs, lses), rows


def _rotary(x, pos):
    half = DK_R // 2
    ang = jnp.asarray(1.0 / (10000.0 ** np.linspace(0.0, 1.0, half)), jnp.float32)
    theta = pos.astype(jnp.float32)[:, None] * ang[None, :]
    c, s = jnp.cos(theta)[:, None, :], jnp.sin(theta)[:, None, :]
    x1, x2 = x[..., :half], x[..., half:]
    return jnp.concatenate([x1 * c - x2 * s, x1 * s + x2 * c], axis=-1)


def _retention_chunk(r, q, k, v, log_g):
    n = np.arange(q.shape[1])
    diff = n[:, None] - n[None, :]
    decay = jnp.where(jnp.asarray(diff >= 0)[None],
                      jnp.exp(jnp.asarray(np.maximum(diff, 0), jnp.float32)[None] * log_g[:, None, None]), 0.0)
    s = jnp.einsum('blhd,bmhd->bhlm', q, k) * decay[None]
    inner = jnp.einsum('bhlm,bmhe->blhe', s, v)
    xi = jnp.exp(jnp.asarray(n + 1, jnp.float32)[:, None] * log_g[None, :])
    cross = jnp.einsum('blhd,bhde->blhe', q, r) * xi[None, :, :, None]
    zeta = jnp.exp(jnp.asarray(n[::-1], jnp.float32)[:, None] * log_g[None, :])
    r_new = (jnp.exp(q.shape[1] * log_g)[None, :, None, None] * r
             + jnp.einsum('blhd,blhe->bhde', k * zeta[None, :, :, None], v))
    return r_new, inner + cross


def _retention_prompt(q, k, v, log_g):
    b, s = q.shape[:2]
    nc = s // RET_CHUNK

    def chunks(t):
        return jnp.moveaxis(t.reshape((b, nc, RET_CHUNK) + t.shape[2:]), 1, 0)

    r0 = jnp.zeros((b, HR, DK_R, DV_R), jnp.float32)

    def step(r, xs):
        return _retention_chunk(r, xs[0], xs[1], xs[2], log_g)

    r, o = lax.scan(step, r0, (chunks(q), chunks(k), chunks(v)))
    return jnp.moveaxis(o, 0, 1).reshape(b, s, HR, DV_R), r


def _retention_sample(q, k, v, r0, log_g):
    r, o = _retention_chunk(r0, q, k, v, log_g)
    return o, r


def _peer(h, w_q, sub_keys, u, v):
    lead = h.shape[:-1]
    t = h.reshape(-1, D_MODEL)
    n = t.shape[0]
    n_pad = -(-n // PEER_BLK) * PEER_BLK
    t = jnp.pad(t, ((0, n_pad - n), (0, 0)))
    half = PEER_DQ // 2
    sk = sub_keys.astype(jnp.float32)

    def block(tb):
        q = (tb @ w_q).reshape(PEER_BLK, PEER_HEADS, 2, half).astype(jnp.float32)
        sc = jnp.einsum('nhpc,pkc->nhpk', q, sk)
        sv, si = lax.top_k(sc, PEER_TOPK)
        cand = sv[:, :, 0, :, None] + sv[:, :, 1, None, :]
        cidx = si[:, :, 0, :, None] * N_KEYS + si[:, :, 1, None, :]
        fv, fi = lax.top_k(cand.reshape(PEER_BLK, PEER_HEADS, PEER_TOPK * PEER_TOPK), PEER_TOPK)
        eidx = jnp.take_along_axis(cidx.reshape(PEER_BLK, PEER_HEADS, -1), fi, axis=-1)
        gate = jax.nn.softmax(fv, axis=-1)
        act = jax.nn.gelu(jnp.einsum('nd,nhkd->nhk', tb, u[eidx]).astype(jnp.float32), approximate=False)
        coef = (gate * act).astype(v.dtype)
        return jnp.einsum('nhk,nhkd->nd', coef, v[eidx])

    out = lax.map(block, t.reshape(-1, PEER_BLK, D_MODEL))
    return out.reshape(n_pad, D_MODEL)[:n].reshape(lead + (D_MODEL,))


def _layer(x, pos, attn_fn, ret_fn, norm1, w_in, b_gate, qn, kn, w_oa, w_or, w_out, norm2, pwq, psk, pu, pv):
    dt = x.dtype
    lead = x.shape[:2]
    h = _rms(x, norm1).astype(dt)
    z = h @ w_in
    idx = np.cumsum(SPLITS)[:-1].tolist()
    qa, ka, va, qr, kr, vr, gr, gt = jnp.split(z, idx, axis=-1)
    ga = (N_GROUPS, HEADS_PER_GROUP, HD_A)
    qa = _rms(qa.reshape(lead + ga), qn[:, None, :]) * (HD_A ** -0.5)
    ka = _rms(ka.reshape(lead + ga), kn[:, None, :])
    va = va.reshape(lead + ga).astype(jnp.float32)
    a, kv_rows = attn_fn(qa, ka, va)
    qr = _rotary(qr.reshape(lead + (HR, DK_R)).astype(jnp.float32), pos)
    kr = _rotary(kr.reshape(lead + (HR, DK_R)).astype(jnp.float32), pos) * (DK_R ** -0.5)
    vr = vr.reshape(lead + (HR, DV_R)).astype(jnp.float32)
    o, r_new = ret_fn(qr, kr, vr)
    o = _rms(o) * jax.nn.silu(gr.reshape(lead + (HR, DV_R)).astype(jnp.float32))
    br = o.reshape(lead + (RV_W,)).astype(dt) @ w_or
    ba = a.reshape(lead + (ATTN_OUT_W,)).astype(dt) @ w_oa
    g_a, g_b = jnp.split(gt + b_gate, 2, axis=-1)
    mixed = jax.nn.sigmoid(g_a) * ba + jax.nn.sigmoid(g_b) * br
    x = x + (mixed @ w_out).astype(dt)
    x = x + _peer(_rms(x, norm2).astype(dt), pwq, psk, pu, pv).astype(dt)
    return x, kv_rows, r_new


def setup_inputs(seed: int = 0) -> dict:
    key = jax.random.key(seed)
    ks = jax.random.split(key, 24)
    f32 = jnp.float32

    def nrm(k, shape, scale):
        return jax.random.normal(k, shape, f32) * scale

    past = [min(w, PAST_LEN) for w, _ in ATTN_GROUPS]
    kvs = (HEADS_PER_GROUP, HD_A)
    return {
        'x_prompt': nrm(ks[0], (BATCH, SEQ, D_MODEL), 1.0),
        'x_sample': nrm(ks[1], (DEC_BATCH, DEC_SEQ, D_MODEL), 1.0),
        'cache_kv_d1': nrm(ks[2], (DEPTH, DEC_BATCH, past[0], 2) + kvs, 1.0),
        'cache_kv_d4': nrm(ks[3], (DEPTH, DEC_BATCH, past[1], 2) + kvs, 1.0),
        'cache_kv_d16': nrm(ks[4], (DEPTH, DEC_BATCH, past[2], 2) + kvs, 1.0),
        'state_ret': nrm(ks[5], (DEPTH, DEC_BATCH, HR, DK_R, DV_R), 0.1),
        'rel_bias': nrm(ks[6], (N_BUCKETS, N_GROUPS * HEADS_PER_GROUP), 0.5),
        'norm1_w': 1.0 + nrm(ks[7], (DEPTH, D_MODEL), 0.02),
        'w_in': nrm(ks[8], (DEPTH, D_MODEL, IN_COLS), D_MODEL ** -0.5),
        'b_gate': nrm(ks[9], (DEPTH, 2 * D_MODEL), 0.1),
        'q_norm_w': 1.0 + nrm(ks[10], (DEPTH, N_GROUPS, HD_A), 0.02),
        'k_norm_w': 1.0 + nrm(ks[11], (DEPTH, N_GROUPS, HD_A), 0.02),
        'w_o_attn': nrm(ks[12], (DEPTH, ATTN_OUT_W, D_MODEL), ATTN_OUT_W ** -0.5),
        'w_o_ret': nrm(ks[13], (DEPTH, RV_W, D_MODEL), RV_W ** -0.5),
        'w_out': nrm(ks[14], (DEPTH, D_MODEL, D_MODEL), D_MODEL ** -0.5),
        'norm2_w': 1.0 + nrm(ks[15], (DEPTH, D_MODEL), 0.02),
        'peer_w_q': nrm(ks[16], (DEPTH, D_MODEL, PEER_HEADS * PEER_DQ), D_MODEL ** -0.5),
        'peer_sub_keys': nrm(ks[17], (DEPTH, 2, N_KEYS, PEER_DQ // 2), (PEER_DQ // 2) ** -0.5),
        'peer_u': nrm(ks[18], (DEPTH, N_EXPERTS, D_MODEL), D_MODEL ** -0.5),
        'peer_v': nrm(ks[19], (DEPTH, N_EXPERTS, D_MODEL), 0.1),
    }


def reference(x_prompt, x_sample, cache_kv_d1, cache_kv_d4, cache_kv_d16, state_ret, rel_bias,
              norm1_w, w_in, b_gate, q_norm_w, k_norm_w, w_o_attn, w_o_ret, w_out, norm2_w,
              peer_w_q, peer_sub_keys, peer_u, peer_v):
    dt = x_prompt.dtype
    bias_g = rel_bias.reshape(N_BUCKETS, N_GROUPS, HEADS_PER_GROUP).astype(jnp.float32)
    log_g = jnp.asarray(np.log(1.0 - 2.0 ** (-5.0 - np.arange(HR))), jnp.float32)
    pos_p = jnp.arange(x_prompt.shape[1], dtype=jnp.int32)
    pos_s = PAST_LEN + jnp.arange(x_sample.shape[1], dtype=jnp.int32)
    caches = (cache_kv_d1, cache_kv_d4, cache_kv_d16)
    xp, xs = x_prompt, x_sample
    kv_p = [[], [], []]
    kv_s = [[], [], []]
    ret_p, ret_s = [], []
    for l in range(DEPTH):
        lw = (norm1_w[l], w_in[l], b_gate[l], q_norm_w[l], k_norm_w[l], w_o_attn[l], w_o_ret[l],
              w_out[l], norm2_w[l], peer_w_q[l], peer_sub_keys[l], peer_u[l], peer_v[l])
        xp, rows, r = _layer(xp, pos_p,
                             lambda q, k, v: _attn_prompt(q, k, v, bias_g, dt),
                             lambda q, k, v: _retention_prompt(q, k, v, log_g), *lw)
        for g in range(N_GROUPS):
            kv_p[g].append(rows[g])
        ret_p.append(r.astype(dt))
        bufs = tuple(c[l] for c in caches)
        r0 = state_ret[l].astype(jnp.float32)
        xs, rows, r = _layer(xs, pos_s,
                             lambda q, k, v: _attn_sample(q, k, v, bufs, bias_g, dt),
                             lambda q, k, v: _retention_sample(q, k, v, r0, log_g), *lw)
        for g in range(N_GROUPS):
            kv_s[g].append(rows[g])
        ret_s.append(r.astype(dt))
    kv_d1_prompt = jnp.stack(kv_p[0])
    kv_d4_prompt = jnp.stack(kv_p[1])
    kv_d16_prompt = jnp.stack(kv_p[2])
    ret_prompt = jnp.stack(ret_p)
    kv_d1_sample = jnp.stack(kv_s[0])
    kv_d4_sample = jnp.stack(kv_s[1])
    kv_d16_sample = jnp.stack(kv_s[2])
    ret_sample = jnp.stack(ret_s)
    return (xp, xs, kv_d1_prompt, kv_d4_prompt, kv_d16_prompt, ret_prompt, kv_d1_sample, kv_d4_sample, kv_d16_sample, ret_sample)
```

```cpp
#include <hip/hip_runtime.h>
#include <math.h>
#include <stdio.h>
#include <string.h>
namespace pg8 {
#define PG8_LAS __attribute__((address_space(3)))
typedef unsigned short bf16_t;
typedef short bf16x8 __attribute__((ext_vector_type(8)));
typedef float f32x4 __attribute__((ext_vector_type(4)));
typedef unsigned u32x4 __attribute__((ext_vector_type(4)));
constexpr int BM = 256, BK = 64, HALF = 128, HTB = HALF * BK * 2  , STAGE_BYTES = 8 * HTB, NXCD = 8, WGM = 8;

__host__ __device__ __forceinline__ int lds_byte(int r, int c) { const int st = (r >> 4) * 2 + (c >> 5), rr = r & 15, cc = c & 31, ob = rr * 64 + cc * 2; return st * 1024 + (ob ^ (((ob >> 9) & 1) << 5)); }
__host__ __device__ __forceinline__ void stage_rc(int b, int& R, int& C) { const int st = b / 1024, sb = b % 1024, swz = sb ^ (((sb >> 9) & 1) << 5); R = (st >> 1) * 16 + swz / 64; C = (st & 1) * 32 + (swz % 64) / 2; }
__host__ __device__ __forceinline__ int perm32(int rho) { const int n = rho >> 4, i = rho & 15; return 8 * (i >> 2) + 4 * n + (i & 3); }

struct Unit { int pm, pn; };
struct Gemm { const bf16_t* A; const bf16_t* Bt; int M, N, K; };

struct StaticOrder {
    int nM, nN, nwg, G, c;
    __host__ __device__ void init(int M, int N, int G_, int c_) { nM = M / BM; nN = N / BM; nwg = nM * nN; G = G_; c = c_; }
    __host__ __device__ bool next(int i, Unit& u) const {
        const long L = (long)i * G + c; if (L >= nwg) return false;
        int wgid = (int)L; { const int q = nwg / NXCD, r = nwg % NXCD, xcd = wgid % NXCD, off = wgid / NXCD; wgid = (xcd < r ? xcd * (q + 1) : r * (q + 1) + (xcd - r) * q) + off; }
        const int nig = WGM * nN, gid = wgid / nig, fm = gid * WGM, gsz = (nM - fm) < WGM ? (nM - fm) : WGM;
        u.pm = fm + ((wgid % nig) % gsz); u.pn = (wgid % nig) / gsz; return true;
    }
    __device__ __forceinline__ void a_ready(const Unit&) const {}
    __device__ __forceinline__ void done(const Unit&) const {}
};
__device__ __forceinline__ unsigned cvt_pk_bf16(float lo, float hi) { unsigned r; asm volatile("v_cvt_pk_bf16_f32 %0, %1, %2" : "=v"(r) : "v"(lo), "v"(hi)); return r; }
template <class Epi, class Sched, bool STAMP = false>
__device__ __forceinline__ void gemm_phase(PG8_LAS unsigned char* lds, const Gemm g, const Sched& S, const Epi& E, unsigned long long* stamps, int tid_in) {
    int tid_ = tid_in; asm volatile("" : "+v"(tid_));
    const int tid = tid_, wid = __builtin_amdgcn_readfirstlane(tid >> 6), lane = tid & 63, wr = wid >> 2, wc = wid & 3, fr = lane & 15, fq = lane >> 4;
    const int K = g.K, nt = K / BK;
    int ts_lo = 0, ts_hi = 0, nts = 0; const unsigned long long rt_entry = STAMP ? (unsigned long long)wall_clock64() : 0ull;
#define PG8_STAMP() do { if (STAMP && wid == 0 && nts < 64) { const unsigned long long _c = (unsigned long long)clock64(); \
        ts_lo = (lane == nts) ? (int)(unsigned)_c : ts_lo; ts_hi = (lane == nts) ? (int)(unsigned)(_c >> 32) : ts_hi; ++nts; } } while (0)
    PG8_STAMP();
    unsigned voffA[2], voffB[2];
#pragma unroll
    for (int i = 0; i < 2; ++i) { int R, C; stage_rc(tid * 16 + i * 8192, R, C); const int Rb = Epi::PERM ? ((R & ~31) + perm32(R & 31)) : R;
        voffA[i] = (unsigned)(R * K + C) * 2u; voffB[i] = (unsigned)(Rb * K + C) * 2u; }
    const size_t kstep = (size_t)(BK * 2);
    const size_t hstep = (size_t)HALF * K * 2;
    const size_t tstep = 2 * hstep;
    const unsigned ldsw = (unsigned)wid * 1024u;
    const int aoff = lds_byte(wr * 64 + fr, fq * 8), boff = lds_byte(wc * 32 + fr, fq * 8);
#define PG8_SA(b, h) (((b) * 2 + (h)) * HTB)
#define PG8_SB(b, h) ((4 + (b) * 2 + (h)) * HTB)
#define PG8_STAGE(bufoff, gbase, voff) do { _Pragma("unroll") for (int _i = 0; _i < 2; ++_i) \
        __builtin_amdgcn_global_load_lds((const unsigned*)((const char*)(gbase) + (voff)[_i]), (PG8_LAS unsigned*)(lds + (bufoff) + ldsw + _i * 8192), 16, 0, 0); } while (0)
#define PG8_LDA(dst, b, h) do { _Pragma("unroll") for (int m = 0; m < 4; ++m) _Pragma("unroll") for (int k = 0; k < 2; ++k) dst[m][k] = *(const PG8_LAS bf16x8*)(lds + PG8_SA(b, h) + aoff + m * 2048 + k * 1024); } while (0)
#define PG8_LDB(dst, b, h) do { _Pragma("unroll") for (int n = 0; n < 2; ++n) _Pragma("unroll") for (int k = 0; k < 2; ++k) dst[n][k] = *(const PG8_LAS bf16x8*)(lds + PG8_SB(b, h) + boff + n * 2048 + k * 1024); } while (0)
#define PG8_MMA(ai, bj, At, Bt) do { __builtin_amdgcn_s_setprio(1); _Pragma("unroll") for (int m = 0; m < 4; ++m) _Pragma("unroll") for (int n = 0; n < 2; ++n) _Pragma("unroll") for (int k = 0; k < 2; ++k) \
        acc[ai][bj][m][n] = __builtin_amdgcn_mfma_f32_16x16x32_bf16(Bt[n][k], At[m][k], acc[ai][bj][m][n], 0, 0, 0); __builtin_amdgcn_s_setprio(0); } while (0)
#define PG8_WAIT_V(n) asm volatile("s_waitcnt vmcnt(" #n ")" ::: "memory")
#define PG8_WAIT_L(n) asm volatile("s_waitcnt lgkmcnt(" #n ")" ::: "memory")
#define PG8_BAR __builtin_amdgcn_s_barrier()
#define PG8_SCHED __builtin_amdgcn_sched_barrier(0)
    Unit cur, nxt; int ui = 0;
    if (!S.next(0, cur)) return;
    f32x4 acc[2][2][4][2];
#pragma unroll
    for (int a = 0; a < 2; ++a)
#pragma unroll
        for (int b = 0; b < 2; ++b)
#pragma unroll
            for (int m = 0; m < 4; ++m)
#pragma unroll
                for (int n = 0; n < 2; ++n) acc[a][b][m][n] = (f32x4){0.f, 0.f, 0.f, 0.f};
    bf16x8 At[4][2], B0[2][2], B1[2][2];
    const char* cA = (const char*)g.A + (size_t)cur.pm * tstep; const char* cB = (const char*)g.Bt + (size_t)cur.pn * tstep;
    S.a_ready(cur);
    PG8_STAGE(PG8_SB(0, 0), cB, voffB); PG8_STAGE(PG8_SA(0, 0), cA, voffA); PG8_STAGE(PG8_SB(0, 1), cB + hstep, voffB); PG8_STAGE(PG8_SA(0, 1), cA + hstep, voffA);
    if (wr == 1) PG8_BAR;
    PG8_WAIT_V(4); PG8_BAR;
    PG8_STAGE(PG8_SB(1, 0), cB + kstep, voffB); PG8_STAGE(PG8_SA(1, 0), cA + kstep, voffA); PG8_STAGE(PG8_SB(1, 1), cB + hstep + kstep, voffB);
    PG8_WAIT_V(6); PG8_BAR;
    PG8_STAMP();
    for (;;) {
        const bool has_next = S.next(ui + 1, nxt);
        const char* nA = has_next ? (const char*)g.A + (size_t)nxt.pm * tstep : cA; const char* nB = has_next ? (const char*)g.Bt + (size_t)nxt.pn * tstep : cB;
        for (int t = 0; t < nt; t += 2) {
            const bool last = (t == nt - 2);
            const char* a1 = cA + (size_t)(t + 1) * kstep;
            const char* a2 = last ? nA : cA + (size_t)(t + 2) * kstep; const char* b2 = last ? nB : cB + (size_t)(t + 2) * kstep;
            const char* a3 = a2 + kstep; const char* b3 = b2 + kstep;
            if (last && has_next) S.a_ready(nxt);
            PG8_LDB(B0, 0, 0); PG8_SCHED; PG8_LDA(At, 0, 0); PG8_STAGE(PG8_SA(1, 1), a1 + hstep, voffA);
            PG8_WAIT_L(8); PG8_BAR; PG8_WAIT_L(0); PG8_MMA(0, 0, At, B0); PG8_BAR; PG8_SCHED;
            PG8_LDB(B1, 0, 1); PG8_STAGE(PG8_SB(0, 0), b2, voffB);
            PG8_BAR; PG8_WAIT_L(0); PG8_MMA(0, 1, At, B1); PG8_BAR;
            PG8_LDA(At, 0, 1); PG8_STAGE(PG8_SA(0, 0), a2, voffA);
            PG8_BAR; PG8_WAIT_L(0); PG8_MMA(1, 0, At, B0); PG8_BAR; PG8_SCHED;
            PG8_STAGE(PG8_SB(0, 1), b2 + hstep, voffB);
            PG8_WAIT_V(6); PG8_BAR; PG8_MMA(1, 1, At, B1); PG8_BAR;
            PG8_LDB(B0, 1, 0); PG8_SCHED; PG8_LDA(At, 1, 0); PG8_STAGE(PG8_SA(0, 1), a2 + hstep, voffA);
            PG8_WAIT_L(8); PG8_BAR; PG8_WAIT_L(0); PG8_MMA(0, 0, At, B0); PG8_BAR; PG8_SCHED;
            PG8_LDB(B1, 1, 1); PG8_STAGE(PG8_SB(1, 0), b3, voffB);
            PG8_BAR; PG8_WAIT_L(0); PG8_MMA(0, 1, At, B1); PG8_BAR;
            PG8_LDA(At, 1, 1); PG8_STAGE(PG8_SA(1, 0), a3, voffA);
            PG8_BAR; PG8_WAIT_L(0); PG8_MMA(1, 0, At, B0); PG8_BAR; PG8_SCHED;
            PG8_STAGE(PG8_SB(1, 1), b3 + hstep, voffB);
            PG8_WAIT_V(6); PG8_BAR; PG8_MMA(1, 1, At, B1); PG8_BAR;
        }
        PG8_STAMP();
        if constexpr (!Epi::AFTER_DRAIN) { E(acc, cur, wr, wc, fr, fq); S.done(cur); }
        PG8_STAMP();
        if (!has_next) break;
#pragma unroll
        for (int a = 0; a < 2; ++a)
#pragma unroll
            for (int b = 0; b < 2; ++b)
#pragma unroll
                for (int m = 0; m < 4; ++m)
#pragma unroll
                    for (int n = 0; n < 2; ++n) acc[a][b][m][n] = (f32x4){0.f, 0.f, 0.f, 0.f};
        cur = nxt; cA = nA; cB = nB; ++ui;
    }
    PG8_WAIT_V(0);
    if (wr == 0) PG8_BAR;
    PG8_BAR;
    if constexpr (Epi::AFTER_DRAIN) { E.fused(acc, cur, wr, wc, fr, fq, lds, wid, lane); S.done(cur); }
    PG8_STAMP();
    if (STAMP && wid == 0) { stamps[lane] = lane < nts ? (((unsigned long long)(unsigned)ts_hi << 32) | (unsigned)ts_lo) : 0ull;
        if (lane == 62) stamps[62] = rt_entry; if (lane == 63) stamps[63] = (unsigned long long)wall_clock64(); }
#undef PG8_STAMP
#undef PG8_SA
#undef PG8_SB
#undef PG8_STAGE
#undef PG8_LDA
#undef PG8_LDB
#undef PG8_MMA
#undef PG8_WAIT_V
#undef PG8_WAIT_L
#undef PG8_BAR
#undef PG8_SCHED
}
}

#define XB_TMO      128
#define XB_XCNT(j)  (256  + 64 * (j))
#define XB_XSUB(j)  (1280 + 64 * (j))
#define XB_XGEN(j)  (2304 + 64 * (j))
#define XB_TOP      3328
#define XB_TOPGEN   3392
#define XCD_BAR_WORDS 3456
#define XB_SPIN_CAP (1u << 18)
#define LAS __attribute__((address_space(3)))

__device__ __forceinline__ unsigned xb_ld(unsigned* p)              { return __hip_atomic_load(p, __ATOMIC_RELAXED, __HIP_MEMORY_SCOPE_AGENT); }
__device__ __forceinline__ unsigned xb_add(unsigned* p, unsigned v) { return __hip_atomic_fetch_add(p, v, __ATOMIC_RELAXED, __HIP_MEMORY_SCOPE_AGENT); }
__device__ __forceinline__ unsigned xb_xcc_id() { return (unsigned)__builtin_amdgcn_s_getreg((3 << 11) | 20) & 0xFu; }
#define XB_SPIN(cond, bar) do { unsigned _sp = 0; while (cond) { __builtin_amdgcn_s_sleep(1); \
    if ((++_sp & 255u) == 0u) { if (xb_ld(&(bar)[XB_TMO])) break; if (_sp > XB_SPIN_CAP) { atomicAdd(&(bar)[XB_TMO], 1u); break; } } } } while (0)

struct XcdBarrier {
    int wv;
    unsigned* bar; unsigned x;
    volatile LAS unsigned* st;
};

__device__ __forceinline__ unsigned xb_lane() { return __builtin_amdgcn_mbcnt_hi(~0u, __builtin_amdgcn_mbcnt_lo(~0u, 0u)); }
__device__ __forceinline__ XcdBarrier xcd_barrier_post(unsigned* bar, volatile LAS unsigned* st, int wv) {
    XcdBarrier b; b.wv = wv; b.bar = bar; b.x = xb_xcc_id(); b.st = st;
    if (wv == 0 && xb_lane() == 0u) (void)xb_add(&bar[XB_XCNT(b.x)], 1u);
    return b;
}
__device__ __forceinline__ void xcd_barrier_complete(unsigned* bar, unsigned x, unsigned& nloc, unsigned& nx) {
    const unsigned G = gridDim.x * gridDim.y * gridDim.z;
    unsigned sum, cnt, mine, sp = 0u;
    for (;;) {
        sum = 0u; cnt = 0u; mine = 0u;
#pragma unroll
        for (unsigned j = 0; j < 16; ++j) { const unsigned c = xb_ld(&bar[XB_XCNT(j)]); sum += c; cnt += (c > 0u) ? 1u : 0u; mine = (j == x) ? c : mine; }
        if (sum == G) break;
        __builtin_amdgcn_s_sleep(1);
        if ((++sp & 255u) == 0u) { if (xb_ld(&bar[XB_TMO])) break; if (sp > XB_SPIN_CAP) { atomicAdd(&bar[XB_TMO], 1u); break; } }
    }
    nloc = mine > 0u ? mine : 1u; nx = cnt > 0u ? cnt : 1u;
}

__device__ __forceinline__ void xcd_barrier(const XcdBarrier& b) {
    asm volatile("s_waitcnt vmcnt(0)" ::: "memory");
    __syncthreads();
    if (b.wv == 0 && xb_lane() == 0u) {
        unsigned* bar = b.bar;
        __builtin_amdgcn_s_waitcnt(0);
        unsigned nloc = b.st[0], nx = b.st[1];
        if (nloc == 0u) { xcd_barrier_complete(bar, b.x, nloc, nx); b.st[0] = nloc; b.st[1] = nx; }
        const unsigned old = xb_add(&bar[XB_XSUB(b.x)], 1u);
        const unsigned gen = old / nloc;
        if (old + 1u == (gen + 1u) * nloc) {
            __builtin_amdgcn_fence(__ATOMIC_RELEASE, "agent");
            asm volatile("s_waitcnt vmcnt(0)" ::: "memory");
            const unsigned og = xb_add(&bar[XB_TOP], 1u);
            const unsigned tg = og / nx;
            if (og + 1u == (tg + 1u) * nx) xb_add(&bar[XB_TOPGEN], 1u);
            else XB_SPIN(xb_ld(&bar[XB_TOPGEN]) == tg, bar);
            __builtin_amdgcn_fence(__ATOMIC_ACQUIRE, "agent");
            xb_add(&bar[XB_XGEN(b.x)], 1u);
            asm volatile("s_waitcnt vmcnt(0)" ::: "memory");
        } else {
            XB_SPIN(xb_ld(&bar[XB_XGEN(b.x)]) == gen, bar);
            __builtin_amdgcn_fence(__ATOMIC_ACQUIRE, "agent");
            asm volatile("s_waitcnt vmcnt(0)" ::: "memory");
        }
    }
    __syncthreads();
}


namespace mk {
using pg8::bf16_t; using pg8::bf16x8; using pg8::f32x4; using pg8::u32x4;
typedef unsigned u32x2 __attribute__((ext_vector_type(2)));
typedef short s16x4 __attribute__((ext_vector_type(4)));
typedef int i32x4 __attribute__((ext_vector_type(4)));
typedef __bf16 bf2_t __attribute__((ext_vector_type(2)));

constexpr int DM = 1024, NP = 16384, NSMP = 32, NR = NP + NSMP, INC = 9728, NLAYER = 2;
constexpr int C_QA = 0, C_KA = 1536, C_VA = 3072, C_QR = 4608, C_KR = 5120, C_VR = 5632, C_GR = 6656, C_GA = 7680, C_GB = 8704;
constexpr float EPS = 1e-6f;
constexpr int LDS_BYTES = 162816, LDS_BAR = 162800;

constexpr size_t al256(size_t x) { return (x + 255) & ~(size_t)255; }
constexpr size_t WS_CTL = 0, CTL_BYTES = 65536;
constexpr size_t SZ_WTIN = (size_t)INC * DM * 2, SZ_WTOA = (size_t)DM * 512 * 2, SZ_WSQ = (size_t)DM * DM * 2, SZ_WTS = (size_t)2048 * DM * 2, SZ_TAB = (size_t)16384 * DM * 2;
constexpr size_t WS_WTIN = WS_CTL + CTL_BYTES;
constexpr size_t WS_WTOA = WS_WTIN + NLAYER * SZ_WTIN;
constexpr size_t WS_WTOR = WS_WTOA + NLAYER * SZ_WTOA;
constexpr size_t WS_WTOUT = WS_WTOR + NLAYER * SZ_WSQ;
constexpr size_t WS_WTS = WS_WTOUT + NLAYER * SZ_WSQ;
constexpr size_t WS_UBF = WS_WTS + NLAYER * SZ_WTS;
constexpr size_t WS_VBF = WS_UBF + NLAYER * SZ_TAB;
constexpr size_t WS_XRES = WS_VBF + NLAYER * SZ_TAB;
constexpr size_t WS_H = WS_XRES + al256((size_t)NR * DM * 4);
constexpr size_t WS_H2 = WS_H + al256((size_t)NR * DM * 2);
constexpr size_t WS_Z = WS_H2 + al256((size_t)NR * DM * 2);
constexpr size_t WS_OG = WS_Z + al256((size_t)NR * INC * 2);
constexpr size_t WS_LSE = WS_OG + al256((size_t)3 * NR * 512 * 2);
constexpr size_t WS_AO = WS_LSE + al256((size_t)3 * NR * 4 * 4);
constexpr size_t WS_RU = WS_AO + al256((size_t)NR * 512 * 2);
constexpr size_t WS_RS = WS_RU + (size_t)2 * 64 * 4 * 32768 * 4;
constexpr size_t WS_ORET = WS_RS + (size_t)2 * 64 * 4 * 32768 * 2;
constexpr size_t WS_MIX1 = WS_ORET + al256((size_t)NR * DM * 2);
constexpr size_t WS_MIXED = WS_MIX1 + al256((size_t)NR * DM * 4);
constexpr size_t WS_SC = WS_MIXED + al256((size_t)NR * DM * 2);
constexpr size_t WS_END = WS_SC + al256((size_t)NR * 2048 * 4);

constexpr size_t O_YP = 0, O_YS = O_YP + (size_t)NP * DM, O_KV1P = O_YS + (size_t)NSMP * DM;
constexpr size_t O_KV4P = O_KV1P + (size_t)2 * 2 * 128 * 1024, O_KV16P = O_KV4P + (size_t)2 * 2 * 512 * 1024, O_RETP = O_KV16P + (size_t)2 * 2 * 2048 * 1024;
constexpr size_t O_KV1S = O_RETP + (size_t)2 * 2 * 4 * 32768, O_KV4S = O_KV1S + 65536, O_KV16S = O_KV4S + 65536, O_RETS = O_KV16S + 65536;
constexpr size_t O_END = O_RETS + (size_t)2 * 32 * 4 * 32768;

struct Params {
    const float* in[20]; float* out; unsigned char* ws;
    float ang[64]; float logg[4];
    unsigned char bucket[3][132]; unsigned char padb[4];
    int ph_lo, ph_hi, use_bar, pad0;
};
static_assert(sizeof(Params) == 20 * 8 + 16 + 256 + 16 + 400 + 16, "Params has holes");

__device__ __forceinline__ unsigned pkbf(float lo, float hi) { unsigned r; asm("v_cvt_pk_bf16_f32 %0, %1, %2" : "=v"(r) : "v"(lo), "v"(hi)); return r; }
__device__ __forceinline__ float bflo(unsigned u) { return __uint_as_float(u << 16); }
__device__ __forceinline__ float bfhi(unsigned u) { return __uint_as_float(u & 0xffff0000u); }
__device__ __forceinline__ float bf1(bf16_t u) { return __uint_as_float(((unsigned)u) << 16); }
__device__ __forceinline__ bf16_t tobf1(float f) { return (bf16_t)(pkbf(f, 0.f) & 0xffffu); }
__device__ __forceinline__ unsigned offb(unsigned row, unsigned ch) { return 256u * row + 16u * (ch ^ (((row & 3u) << 2) | ((row >> 2) & 3u))); }
__device__ __forceinline__ s16x4 trr(LAS unsigned char* p) { return __builtin_amdgcn_ds_read_tr16_b64_v4i16((LAS s16x4*)p); }
__device__ __forceinline__ bf16x8 cat4(s16x4 a, s16x4 b) { bf16x8 r; r[0] = a[0]; r[1] = a[1]; r[2] = a[2]; r[3] = a[3]; r[4] = b[0]; r[5] = b[1]; r[6] = b[2]; r[7] = b[3]; return r; }
__device__ __forceinline__ bf16x8 pack8(f32x4 a, f32x4 b) { u32x4 w; w.x = pkbf(a[0], a[1]); w.y = pkbf(a[2], a[3]); w.z = pkbf(b[0], b[1]); w.w = pkbf(b[2], b[3]); return __builtin_bit_cast(bf16x8, w); }
__device__ __forceinline__ f32x4 mfma16(bf16x8 a, bf16x8 b, f32x4 c) { return __builtin_amdgcn_mfma_f32_16x16x32_bf16(a, b, c, 0, 0, 0); }
__device__ __forceinline__ float wsum64(float v) { v += __shfl_xor(v, 32); v += __shfl_xor(v, 16); v += __shfl_xor(v, 8); v += __shfl_xor(v, 4); v += __shfl_xor(v, 2); v += __shfl_xor(v, 1); return v; }
__device__ __forceinline__ float sigmoidf_(float x) { return 1.f / (1.f + __expf(-x)); }
__device__ __forceinline__ int med3i(int a, int b, int c) { int r; asm("v_med3_i32 %0, %1, %2, %3" : "=v"(r) : "v"(a), "v"(b), "v"(c)); return r; }
__device__ __forceinline__ int sortable(float x) { const int b = __float_as_int(x); return b ^ ((b >> 31) & 0x7fffffff); }
__device__ __forceinline__ float unsortable(int s) { return __int_as_float(s ^ ((s >> 31) & 0x7fffffff)); }
__device__ __forceinline__ void ins16(int (&sv)[16], int x) {
#pragma unroll
    for (int i = 15; i >= 1; --i) sv[i] = med3i(sv[i - 1], sv[i], x);
    sv[0] = sv[0] > x ? sv[0] : x;
}
__device__ __forceinline__ float dot2bf(unsigned a, unsigned b, float c) { return __builtin_amdgcn_fdot2_f32_bf16(__builtin_bit_cast(bf2_t, a), __builtin_bit_cast(bf2_t, b), c, false); }

template <class Q> struct EpiQuad {
    static constexpr bool PERM = false, AFTER_DRAIN = false;
    Q q;
    __device__ __forceinline__ void operator()(const f32x4 (&acc)[2][2][4][2], const pg8::Unit& u, int wr, int wc, int fr, int fq) const {
        const int row0 = u.pm * 256 + wr * 64 + fr, col0 = u.pn * 256 + wc * 32 + 4 * fq;
#pragma unroll
        for (int ai = 0; ai < 2; ++ai)
#pragma unroll
            for (int m = 0; m < 4; ++m)
#pragma unroll
                for (int bj = 0; bj < 2; ++bj)
#pragma unroll
                    for (int n = 0; n < 2; ++n) { q.quad(row0 + ai * 128 + m * 16, col0 + bj * 128 + n * 16, acc[ai][bj][m][n]); if (Q::FENCE) asm volatile("" ::: "memory"); }
    }
};
struct QZ { static constexpr bool FENCE = false; bf16_t* Z; const float* bg;
    __device__ __forceinline__ void quad(int row, int col, f32x4 v) const {
        if (col >= C_GA) { const f32x4 b = *(const f32x4*)(bg + (col - C_GA)); v[0] = sigmoidf_(v[0] + b[0]); v[1] = sigmoidf_(v[1] + b[1]); v[2] = sigmoidf_(v[2] + b[2]); v[3] = sigmoidf_(v[3] + b[3]); }
        u32x2 w; w.x = pkbf(v[0], v[1]); w.y = pkbf(v[2], v[3]); *(u32x2*)(Z + (size_t)row * INC + col) = w; } };
struct QGateA { static constexpr bool FENCE = true; const bf16_t* Z; float* M1;
    __device__ __forceinline__ void quad(int row, int col, f32x4 v) const {
        const u32x2 g = *(const u32x2*)(Z + (size_t)row * INC + C_GA + col);
        f32x4 o; o[0] = bflo(g.x) * v[0]; o[1] = bfhi(g.x) * v[1]; o[2] = bflo(g.y) * v[2]; o[3] = bfhi(g.y) * v[3];
        *(f32x4*)(M1 + (size_t)row * DM + col) = o; } };
struct QGateB { static constexpr bool FENCE = true; const bf16_t* Z; const float* M1; bf16_t* MX;
    __device__ __forceinline__ void quad(int row, int col, f32x4 v) const {
        const u32x2 g = *(const u32x2*)(Z + (size_t)row * INC + C_GB + col); const f32x4 m = *(const f32x4*)(M1 + (size_t)row * DM + col);
        u32x2 w; w.x = pkbf(m[0] + bflo(g.x) * v[0], m[1] + bfhi(g.x) * v[1]); w.y = pkbf(m[2] + bflo(g.y) * v[2], m[3] + bfhi(g.y) * v[3]); *(u32x2*)(MX + (size_t)row * DM + col) = w; } };
struct QRes { static constexpr bool FENCE = true; float* X;
    __device__ __forceinline__ void quad(int row, int col, f32x4 v) const { f32x4* p = (f32x4*)(X + (size_t)row * DM + col); *p = *p + v; } };
struct QKey { static constexpr bool FENCE = false; int* SC;
    __device__ __forceinline__ void quad(int row, int col, f32x4 v) const {
        i32x4 k; const int kb = 127 - (col & 127);
        k[0] = (sortable(v[0]) & ~127) | kb; k[1] = (sortable(v[1]) & ~127) | (kb - 1); k[2] = (sortable(v[2]) & ~127) | (kb - 2); k[3] = (sortable(v[3]) & ~127) | (kb - 3);
        *(i32x4*)(SC + ((size_t)(row >> 4) * 512 + (col >> 2)) * 64 + (row & 15) * 4) = k; } };

template <class Q> __device__ __forceinline__ void skinny(const bf16_t* Hs, const bf16_t* Bt, int N, int K, const Q& q, int gw, int nw, int lane_) {
    int lane = lane_; asm volatile("" : "+v"(lane));
    const int fr = lane & 15, fq = lane >> 4;
    for (int ct = gw; ct < (N >> 4); ct += nw) {
        f32x4 a0 = {0.f, 0.f, 0.f, 0.f}, a1 = {0.f, 0.f, 0.f, 0.f};
        const bf16_t* bp = Bt + (size_t)(ct * 16 + fr) * K + fq * 8; const bf16_t* h0 = Hs + (size_t)fr * K + fq * 8; const bf16_t* h1 = h0 + (size_t)16 * K;
#pragma unroll 4
        for (int s = 0; s < K; s += 32) { const bf16x8 w = *(const bf16x8*)(bp + s); const bf16x8 x0 = *(const bf16x8*)(h0 + s); const bf16x8 x1 = *(const bf16x8*)(h1 + s);
            a0 = mfma16(w, x0, a0); a1 = mfma16(w, x1, a1); }
        q.quad(NP + fr, ct * 16 + 4 * fq, a0); q.quad(NP + 16 + fr, ct * 16 + 4 * fq, a1);
    }
}

__device__ __forceinline__ void tconv_tile(const float* src, int K, int N, bf16_t* dst, int tile, LAS float* T, int tid) {
    const int ntn = N >> 6, tk = tile / ntn, tn = tile - tk * ntn, k0 = tk * 64, n0 = tn * 64;
#pragma unroll
    for (int i = 0; i < 2; ++i) { const int idx = tid + 512 * i, kr = idx >> 4, c4 = idx & 15; const float4 v = *(const float4*)(src + (size_t)(k0 + kr) * N + n0 + c4 * 4);
        LAS float* t = T + kr * 65 + c4 * 4; t[0] = v.x; t[1] = v.y; t[2] = v.z; t[3] = v.w; }
    __syncthreads();
    { const int n = tid >> 3, kq = tid & 7; float f[8];
#pragma unroll
      for (int i = 0; i < 8; ++i) f[i] = T[(kq * 8 + i) * 65 + n];
      u32x4 w; w.x = pkbf(f[0], f[1]); w.y = pkbf(f[2], f[3]); w.z = pkbf(f[4], f[5]); w.w = pkbf(f[6], f[7]);
      *(u32x4*)(dst + (size_t)(n0 + n) * K + k0 + kq * 8) = w; }
    __syncthreads();
}
__device__ __forceinline__ void wts_unit(const float* pwq, const float* sk, bf16_t* WtS, int hp, int dt, LAS float* skc, LAS float* pwc, int tid) {
    const int p = hp & 1, d0 = dt * 64;
#pragma unroll
    for (int i = 0; i < 8; ++i) { const int idx = tid + 512 * i, k = idx >> 5, c4 = idx & 31; const float4 v = *(const float4*)(sk + (size_t)(p * 128 + k) * 128 + c4 * 4);
        skc[(c4 * 4 + 0) * 132 + k] = v.x; skc[(c4 * 4 + 1) * 132 + k] = v.y; skc[(c4 * 4 + 2) * 132 + k] = v.z; skc[(c4 * 4 + 3) * 132 + k] = v.w; }
#pragma unroll
    for (int i = 0; i < 4; ++i) { const int idx = tid + 512 * i, d = idx >> 5, c4 = idx & 31; const float4 v = *(const float4*)(pwq + (size_t)(d0 + d) * 2048 + hp * 128 + c4 * 4);
        pwc[(c4 * 4 + 0) * 68 + d] = v.x; pwc[(c4 * 4 + 1) * 68 + d] = v.y; pwc[(c4 * 4 + 2) * 68 + d] = v.z; pwc[(c4 * 4 + 3) * 68 + d] = v.w; }
    __syncthreads();
    const int tk = tid & 31, td = tid >> 5;
    float acc[4][4];
#pragma unroll
    for (int i = 0; i < 4; ++i)
#pragma unroll
        for (int j = 0; j < 4; ++j) acc[i][j] = 0.f;
#pragma unroll 4
    for (int c = 0; c < 128; ++c) { const f32x4 a = *(const LAS f32x4*)(skc + c * 132 + tk * 4); const f32x4 b = *(const LAS f32x4*)(pwc + c * 68 + td * 4);
#pragma unroll
        for (int i = 0; i < 4; ++i)
#pragma unroll
            for (int j = 0; j < 4; ++j) acc[i][j] += a[i] * b[j]; }
#pragma unroll
    for (int i = 0; i < 4; ++i) { u32x2 w; w.x = pkbf(acc[i][0], acc[i][1]); w.y = pkbf(acc[i][2], acc[i][3]); *(u32x2*)(WtS + (size_t)(hp * 128 + tk * 4 + i) * DM + d0 + td * 4) = w; }
    __syncthreads();
}
__device__ __forceinline__ void p0_prologue(const Params& P, LAS unsigned char* lds, int tid, int bid, int G) {
    unsigned char* ws = P.ws;
    for (int u = bid; u < NLAYER * 3072; u += G) {
        const int l = u / 3072, t = u - l * 3072;
        if (t < 2432) tconv_tile(P.in[8] + (size_t)l * DM * INC, DM, INC, (bf16_t*)(ws + WS_WTIN + l * SZ_WTIN), t, (LAS float*)lds, tid);
        else if (t < 2560) tconv_tile(P.in[12] + (size_t)l * 512 * DM, 512, DM, (bf16_t*)(ws + WS_WTOA + l * SZ_WTOA), t - 2432, (LAS float*)lds, tid);
        else if (t < 2816) tconv_tile(P.in[13] + (size_t)l * DM * DM, DM, DM, (bf16_t*)(ws + WS_WTOR + l * SZ_WSQ), t - 2560, (LAS float*)lds, tid);
        else tconv_tile(P.in[14] + (size_t)l * DM * DM, DM, DM, (bf16_t*)(ws + WS_WTOUT + l * SZ_WSQ), t - 2816, (LAS float*)lds, tid);
    }
    for (int u = bid; u < NLAYER * 256; u += G) {
        const int l = u >> 8, r = u & 255, hp = r >> 4, dt = r & 15;
        wts_unit(P.in[16] + (size_t)l * DM * 2048, P.in[17] + (size_t)l * 2 * 128 * 128, (bf16_t*)(ws + WS_WTS + l * SZ_WTS), hp, dt, (LAS float*)lds, (LAS float*)(lds + 128 * 132 * 4), tid);
    }
    { const size_t n8 = (size_t)NLAYER * 16384 * DM / 8, step = (size_t)G * 512;
      for (int tb = 0; tb < 2; ++tb) { const float* src = P.in[18 + tb]; bf16_t* dst = (bf16_t*)(ws + (tb ? WS_VBF : WS_UBF));
        for (size_t i = (size_t)bid * 512 + tid; i < n8; i += step) { const float4 a = *(const float4*)(src + i * 8), b = *(const float4*)(src + i * 8 + 4);
            u32x4 w; w.x = pkbf(a.x, a.y); w.y = pkbf(a.z, a.w); w.z = pkbf(b.x, b.y); w.w = pkbf(b.z, b.w); *(u32x4*)(dst + i * 8) = w; } } }
    { const int lane = tid & 63, gw = bid * 8 + (tid >> 6), nw = G * 8; float* X = (float*)(ws + WS_XRES); bf16_t* H = (bf16_t*)(ws + WS_H); const float* nw1 = P.in[7];
      for (int row = gw; row < NR; row += nw) { const float* x = row < NP ? P.in[0] + (size_t)row * DM : P.in[1] + (size_t)(row - NP) * DM;
        float4 v[4]; float ss = 0.f;
#pragma unroll
        for (int j = 0; j < 4; ++j) { v[j] = *(const float4*)(x + j * 256 + lane * 4); ss += v[j].x * v[j].x + v[j].y * v[j].y + v[j].z * v[j].z + v[j].w * v[j].w; }
        const float rstd = rsqrtf(wsum64(ss) * (1.f / 1024.f) + EPS);
#pragma unroll
        for (int j = 0; j < 4; ++j) { *(float4*)(X + (size_t)row * DM + j * 256 + lane * 4) = v[j]; const float4 w = *(const float4*)(nw1 + j * 256 + lane * 4);
            u32x2 o; o.x = pkbf(v[j].x * rstd * w.x, v[j].y * rstd * w.y); o.y = pkbf(v[j].z * rstd * w.z, v[j].w * rstd * w.w); *(u32x2*)(H + (size_t)row * DM + j * 256 + lane * 4) = o; } } }
}

__device__ __forceinline__ void p2_post(const Params& P, int l, bf16_t* Z, int gw, int nw, int lane) {
    const float* qn = P.in[10] + l * 384; const float* kn = P.in[11] + l * 384; float* out = P.out;
    const int sub = lane >> 4, li = lane & 15;
    const float angl = P.ang[lane];
    for (int row = gw; row < NR; row += nw) {
        const bool smp = row >= NP; const int b = smp ? row - NP : row >> 13, t = smp ? 0 : row & 8191; const float pos = smp ? 16384.f : (float)t;
        bf16_t* zr = Z + (size_t)row * INC;
        float* kvd[3];
#pragma unroll
        for (int g = 0; g < 3; ++g) { const int keep = 128 << (2 * g); const size_t ob = g == 0 ? O_KV1P : (g == 1 ? O_KV4P : O_KV16P), os = g == 0 ? O_KV1S : (g == 1 ? O_KV4S : O_KV16S);
            if (smp) kvd[g] = out + os + (size_t)(l * 32 + b) * 1024; else { const int tt = t - (8192 - keep); kvd[g] = tt >= 0 ? out + ob + ((size_t)(l * 2 + b) * keep + tt) * 1024 : nullptr; } }
#pragma unroll
        for (int it = 0; it < 6; ++it) {
            const int hh = it * 4 + sub; const bool isk = it >= 3; const int hq = isk ? hh - 12 : hh, g = hq >> 2, j = hq & 3;
            const u32x4 raw = *(const u32x4*)(zr + hh * 128 + li * 8);
            float f[8] = {bflo(raw.x), bfhi(raw.x), bflo(raw.y), bfhi(raw.y), bflo(raw.z), bfhi(raw.z), bflo(raw.w), bfhi(raw.w)};
            float ss = 0.f;
#pragma unroll
            for (int i = 0; i < 8; ++i) ss += f[i] * f[i];
            ss += __shfl_xor(ss, 1); ss += __shfl_xor(ss, 2); ss += __shfl_xor(ss, 4); ss += __shfl_xor(ss, 8);
            const float rstd = rsqrtf(ss * (1.f / 128.f) + EPS) * (isk ? 1.f : 0.08838834764831845f);
            const float* wp = (isk ? kn : qn) + g * 128 + li * 8; const float4 w0 = *(const float4*)wp, w1 = *(const float4*)(wp + 4);
            f[0] *= rstd * w0.x; f[1] *= rstd * w0.y; f[2] *= rstd * w0.z; f[3] *= rstd * w0.w; f[4] *= rstd * w1.x; f[5] *= rstd * w1.y; f[6] *= rstd * w1.z; f[7] *= rstd * w1.w;
            u32x4 o; o.x = pkbf(f[0], f[1]); o.y = pkbf(f[2], f[3]); o.z = pkbf(f[4], f[5]); o.w = pkbf(f[6], f[7]);
            *(u32x4*)(zr + hh * 128 + li * 8) = o;
            if (isk) { float* d = g == 0 ? kvd[0] : (g == 1 ? kvd[1] : kvd[2]);
                if (d) { *(float4*)(d + j * 128 + li * 8) = make_float4(f[0], f[1], f[2], f[3]); *(float4*)(d + j * 128 + li * 8 + 4) = make_float4(f[4], f[5], f[6], f[7]); } }
        }
#pragma unroll
        for (int it = 0; it < 3; ++it) {
            const int hh = it * 4 + sub, g = it, j = sub; float* d = kvd[it];
            if (d) { const u32x4 raw = *(const u32x4*)(zr + C_VA + hh * 128 + li * 8);
                *(float4*)(d + 512 + j * 128 + li * 8) = make_float4(bflo(raw.x), bfhi(raw.x), bflo(raw.y), bfhi(raw.y));
                *(float4*)(d + 512 + j * 128 + li * 8 + 4) = make_float4(bflo(raw.z), bfhi(raw.z), bflo(raw.w), bfhi(raw.w)); }
            (void)g;
        }
        { const float th = pos * angl; const double td = (double)th; const double kq = rint(td * 0.15915494309189535); const float rf = (float)(td - kq * 6.283185307179586);
          const float c = cosf(rf), s = sinf(rf);
#pragma unroll
          for (int tq = 0; tq < 2; ++tq) { const float sc = tq ? 0.08838834764831845f : 1.f;
#pragma unroll
            for (int h = 0; h < 4; ++h) { bf16_t* p = zr + (tq ? C_KR : C_QR) + h * 128 + lane; const float x1 = bf1(p[0]), x2 = bf1(p[64]);
                p[0] = tobf1((x1 * c - x2 * s) * sc); p[64] = tobf1((x1 * s + x2 * c) * sc); } } }
    }
}

__device__ __forceinline__ void attn_unit(const Params& P, const bf16_t* Z, bf16_t* OG, float* LSE, int u, LAS unsigned char* lds, int tid) {
    const int lane = tid & 63, w = __builtin_amdgcn_readfirstlane(tid >> 6), fr = lane & 15, fq = lane >> 4, q4 = fr >> 2, p4 = fr & 3;
    const int g = u >> 9, rem = u & 511, j = rem & 3, sb = rem >> 2, b = sb >> 6, x = sb & 63;
    const int dsh = 2 * g, d = 1 << dsh, r = x >> (6 - dsh), blk = x & ((64 >> dsh) - 1);
    const size_t rowbase = (size_t)b * 8192 + r; const int i0 = blk * 128;
    LAS unsigned char* Ks = lds; LAS unsigned char* Vs = lds + 65536; LAS float* biasv = (LAS float*)(lds + 131072);
    const int kcol = C_KA + g * 512 + j * 128, vcol = C_VA + g * 512 + j * 128;
    { u32x4 kr[8], vr[8];
#pragma unroll
      for (int c = 0; c < 8; ++c) { const int id = tid + 512 * c, kk = id >> 4, ch = id & 15; int i = i0 - 128 + kk; i = i < 0 ? 0 : i;
          const bf16_t* p = Z + (rowbase + (size_t)d * i) * INC; kr[c] = *(const u32x4*)(p + kcol + ch * 8); vr[c] = *(const u32x4*)(p + vcol + ch * 8); }
#pragma unroll
      for (int c = 0; c < 8; ++c) { const int id = tid + 512 * c, kk = id >> 4, ch = id & 15; *(LAS u32x4*)(Ks + offb(kk, ch)) = kr[c]; *(LAS u32x4*)(Vs + offb(kk, ch)) = vr[c]; } }
    if (tid < 129) biasv[tid] = P.in[6][(int)P.bucket[g][tid] * 12 + g * 4 + j];
    const size_t qrow = rowbase + (size_t)d * (i0 + 16 * w + fr);
    bf16x8 Qf[4];
    { const bf16_t* qp = Z + qrow * INC + C_QA + g * 512 + j * 128 + fq * 8;
#pragma unroll
      for (int s = 0; s < 4; ++s) Qf[s] = *(const bf16x8*)(qp + 32 * s); }
    __syncthreads();
    f32x4 sa[9];
#pragma unroll
    for (int ti = 0; ti < 9; ++ti) { sa[ti] = (f32x4){0.f, 0.f, 0.f, 0.f}; const int kt = w + ti;
#pragma unroll
        for (int s = 0; s < 4; ++s) { const bf16x8 kf = *(const LAS bf16x8*)(Ks + offb(16 * kt + fr, 4 * s + fq)); sa[ti] = mfma16(kf, Qf[s], sa[ti]); } }
    float mx = -3.0e38f;
#pragma unroll
    for (int ti = 0; ti < 9; ++ti)
#pragma unroll
        for (int e = 0; e < 4; ++e) { const int kk = 16 * (w + ti) + 4 * fq + e, m = 128 + fr - 16 * ti - 4 * fq - e; const bool ok = (m >= 0) && (m <= 128) && (blk > 0 || kk >= 128);
            const int mc = m < 0 ? 0 : (m > 128 ? 128 : m); const float sv = ok ? sa[ti][e] + biasv[mc] : -1.0e30f; sa[ti][e] = sv; mx = fmaxf(mx, sv); }
    mx = fmaxf(mx, __shfl_xor(mx, 16)); mx = fmaxf(mx, __shfl_xor(mx, 32));
    float sum = 0.f;
#pragma unroll
    for (int ti = 0; ti < 9; ++ti)
#pragma unroll
        for (int e = 0; e < 4; ++e) { const float pe = __expf(sa[ti][e] - mx); sa[ti][e] = pe; sum += pe; }
    sum += __shfl_xor(sum, 16); sum += __shfl_xor(sum, 32);
    f32x4 oa[8];
#pragma unroll
    for (int c = 0; c < 8; ++c) oa[c] = (f32x4){0.f, 0.f, 0.f, 0.f};
#pragma unroll
    for (int ks = 0; ks < 5; ++ks) { const int T0 = 2 * ks, T1 = 2 * ks + 1;
        const f32x4 z4 = {0.f, 0.f, 0.f, 0.f}; const bf16x8 Pb = pack8(sa[T0], T1 < 9 ? sa[T1] : z4);
        const int rb0 = 16 * (w + T0) + 4 * fq; int rb1 = 16 * (w + T1) + 4 * fq; rb1 = rb1 > 252 ? 252 : rb1;
#pragma unroll
        for (int c = 0; c < 8; ++c) { const s16x4 a0 = trr(Vs + offb(rb0 + q4, 2 * c + (p4 >> 1)) + 8 * (p4 & 1)); const s16x4 a1 = trr(Vs + offb(rb1 + q4, 2 * c + (p4 >> 1)) + 8 * (p4 & 1));
            oa[c] = mfma16(cat4(a0, a1), Pb, oa[c]); } }
    const float inv = 1.f / sum; bf16_t* orow = OG + ((size_t)g * NR + qrow) * 512 + j * 128;
#pragma unroll
    for (int c = 0; c < 8; ++c) { u32x2 o; o.x = pkbf(oa[c][0] * inv, oa[c][1] * inv); o.y = pkbf(oa[c][2] * inv, oa[c][3] * inv); *(u32x2*)(orow + 16 * c + 4 * fq) = o; }
    if (fq == 0) LSE[((size_t)g * NR + qrow) * 4 + j] = mx + __logf(sum);
    __syncthreads();
}

__device__ __forceinline__ void sattn_unit(const Params& P, int l, const bf16_t* Z, bf16_t* OG, float* LSE, int u, LAS unsigned char* lds, int tid) {
    const int lane = tid & 63, w = __builtin_amdgcn_readfirstlane(tid >> 6);
    const int b = u / 3, g = u - b * 3, d = 1 << (2 * g), lg = 128 * d;
    const float* cache = P.in[2 + g] + ((size_t)(l * 32 + b) * lg) * 1024;
    const bf16_t* zr = Z + (size_t)(NP + b) * INC;
    LAS float* sc = (LAS float*)lds;
    LAS float* st = (LAS float*)(lds + 2112);
    LAS float* part = (LAS float*)(lds + 4096);
    float q[8];
    { const u32x2 a = *(const u32x2*)(zr + C_QA + g * 512 + lane * 4), c = *(const u32x2*)(zr + C_QA + g * 512 + 256 + lane * 4);
      q[0] = bflo(a.x); q[1] = bfhi(a.x); q[2] = bflo(a.y); q[3] = bfhi(a.y); q[4] = bflo(c.x); q[5] = bfhi(c.x); q[6] = bflo(c.y); q[7] = bfhi(c.y); }
    for (int jj = w; jj < 129; jj += 8) {
        float k[8];
        if (jj == 0) { const u32x2 a = *(const u32x2*)(zr + C_KA + g * 512 + lane * 4), c = *(const u32x2*)(zr + C_KA + g * 512 + 256 + lane * 4);
            k[0] = bflo(a.x); k[1] = bfhi(a.x); k[2] = bflo(a.y); k[3] = bfhi(a.y); k[4] = bflo(c.x); k[5] = bfhi(c.x); k[6] = bflo(c.y); k[7] = bfhi(c.y); }
        else { const float* kp = cache + (size_t)(lg - jj * d) * 1024; const float4 a = *(const float4*)(kp + lane * 4), c = *(const float4*)(kp + 256 + lane * 4);
            k[0] = a.x; k[1] = a.y; k[2] = a.z; k[3] = a.w; k[4] = c.x; k[5] = c.y; k[6] = c.z; k[7] = c.w; }
        float s1 = q[0] * k[0] + q[1] * k[1] + q[2] * k[2] + q[3] * k[3], s2 = q[4] * k[4] + q[5] * k[5] + q[6] * k[6] + q[7] * k[7];
#pragma unroll
        for (int o = 1; o < 32; o <<= 1) { s1 += __shfl_xor(s1, o); s2 += __shfl_xor(s2, o); }
        if ((lane & 31) == 0) { const int h0 = lane >> 5; const float* bt = P.in[6] + (int)P.bucket[g][jj] * 12 + g * 4; sc[h0 * 132 + jj] = s1 + bt[h0]; sc[(2 + h0) * 132 + jj] = s2 + bt[2 + h0]; }
    }
    __syncthreads();
    if (w < 4) { const float v0 = sc[w * 132 + lane], v1 = sc[w * 132 + 64 + lane], v2 = lane == 0 ? sc[w * 132 + 128] : -3.0e38f;
        float mx = fmaxf(fmaxf(v0, v1), v2);
#pragma unroll
        for (int o = 1; o < 64; o <<= 1) mx = fmaxf(mx, __shfl_xor(mx, o));
        const float e0 = __expf(v0 - mx), e1 = __expf(v1 - mx), e2 = lane == 0 ? __expf(v2 - mx) : 0.f;
        sc[w * 132 + lane] = e0; sc[w * 132 + 64 + lane] = e1; if (lane == 0) sc[w * 132 + 128] = e2;
        const float sm = wsum64(e0 + e1 + e2);
        if (lane == 0) { st[w] = mx; st[4 + w] = sm; } }
    __syncthreads();
    float acc[8];
#pragma unroll
    for (int i = 0; i < 8; ++i) acc[i] = 0.f;
    for (int jj = w; jj < 129; jj += 8) {
        float v[8];
        if (jj == 0) { const u32x2 a = *(const u32x2*)(zr + C_VA + g * 512 + lane * 4), c = *(const u32x2*)(zr + C_VA + g * 512 + 256 + lane * 4);
            v[0] = bflo(a.x); v[1] = bfhi(a.x); v[2] = bflo(a.y); v[3] = bfhi(a.y); v[4] = bflo(c.x); v[5] = bfhi(c.x); v[6] = bflo(c.y); v[7] = bfhi(c.y); }
        else { const float* vp = cache + (size_t)(lg - jj * d) * 1024 + 512; const float4 a = *(const float4*)(vp + lane * 4), c = *(const float4*)(vp + 256 + lane * 4);
            v[0] = a.x; v[1] = a.y; v[2] = a.z; v[3] = a.w; v[4] = c.x; v[5] = c.y; v[6] = c.z; v[7] = c.w; }
        const float p1 = sc[(lane >> 5) * 132 + jj], p2 = sc[(2 + (lane >> 5)) * 132 + jj];
        acc[0] += p1 * v[0]; acc[1] += p1 * v[1]; acc[2] += p1 * v[2]; acc[3] += p1 * v[3]; acc[4] += p2 * v[4]; acc[5] += p2 * v[5]; acc[6] += p2 * v[6]; acc[7] += p2 * v[7];
    }
    *(LAS f32x4*)(part + w * 512 + lane * 4) = (f32x4){acc[0], acc[1], acc[2], acc[3]};
    *(LAS f32x4*)(part + w * 512 + 256 + lane * 4) = (f32x4){acc[4], acc[5], acc[6], acc[7]};
    __syncthreads();
    { float s = 0.f;
#pragma unroll
      for (int ww = 0; ww < 8; ++ww) s += part[ww * 512 + tid];
      const int j = tid >> 7; OG[((size_t)g * NR + NP + b) * 512 + tid] = tobf1(s / st[4 + j]);
      if (tid < 4) LSE[((size_t)g * NR + NP + b) * 4 + tid] = st[tid] + __logf(st[4 + tid]); }
    __syncthreads();
}

template <bool ZETA> __device__ __forceinline__ void ret_stage(const bf16_t* Z, size_t row0, int h, float lgh, LAS unsigned char* lds, int tid) {
#pragma unroll
    for (int c = 0; c < 4; ++c) { const int id = tid + 512 * c, tok = id >> 4, ch = id & 15; u32x4 raw = *(const u32x4*)(Z + (row0 + tok) * INC + C_KR + h * 128 + ch * 8);
        if (ZETA) { const float z = __expf((float)(127 - tok) * lgh);
            raw.x = pkbf(bflo(raw.x) * z, bfhi(raw.x) * z); raw.y = pkbf(bflo(raw.y) * z, bfhi(raw.y) * z); raw.z = pkbf(bflo(raw.z) * z, bfhi(raw.z) * z); raw.w = pkbf(bflo(raw.w) * z, bfhi(raw.w) * z); }
        *(LAS u32x4*)(lds + offb(tok, ch)) = raw; }
#pragma unroll
    for (int c = 0; c < 8; ++c) { const int id = tid + 512 * c, tok = id >> 5, c32 = id & 31; const u32x4 raw = *(const u32x4*)(Z + (row0 + tok) * INC + C_VR + h * 256 + c32 * 8);
        *(LAS u32x4*)(lds + 32768 + (c32 >> 4) * 32768 + offb(tok, c32 & 15)) = raw; }
}
__device__ __forceinline__ void ret1_unit(const Params& P, const bf16_t* Z, float* RU, int u, LAS unsigned char* lds, int tid) {
    const int lane = tid & 63, w = __builtin_amdgcn_readfirstlane(tid >> 6), fr = lane & 15, fq = lane >> 4, q4 = fr >> 2, p4 = fr & 3;
    const int h = u & 3, bc = u >> 2;
    ret_stage<true>(Z, (size_t)bc * 128, h, P.logg[h], lds, tid);
    __syncthreads();
    f32x4 acc[8][2];
#pragma unroll
    for (int mt = 0; mt < 8; ++mt) { acc[mt][0] = (f32x4){0.f, 0.f, 0.f, 0.f}; acc[mt][1] = (f32x4){0.f, 0.f, 0.f, 0.f}; }
#pragma unroll
    for (int ks = 0; ks < 4; ++ks) {
        const int r0 = 32 * ks + 8 * fq + q4;
        bf16x8 Bf[2];
#pragma unroll
        for (int nt = 0; nt < 2; ++nt) { const int dvt = 2 * w + nt; LAS unsigned char* vb = lds + 32768 + (dvt >> 3) * 32768; const int c = dvt & 7;
            Bf[nt] = cat4(trr(vb + offb(r0, 2 * c + (p4 >> 1)) + 8 * (p4 & 1)), trr(vb + offb(r0 + 4, 2 * c + (p4 >> 1)) + 8 * (p4 & 1))); }
#pragma unroll
        for (int mt = 0; mt < 8; ++mt) { const bf16x8 Af = cat4(trr(lds + offb(r0, 2 * mt + (p4 >> 1)) + 8 * (p4 & 1)), trr(lds + offb(r0 + 4, 2 * mt + (p4 >> 1)) + 8 * (p4 & 1)));
            acc[mt][0] = mfma16(Af, Bf[0], acc[mt][0]); acc[mt][1] = mfma16(Af, Bf[1], acc[mt][1]); }
    }
    float* Up = RU + ((size_t)bc * 4 + h) * 32768;
#pragma unroll
    for (int mt = 0; mt < 8; ++mt)
#pragma unroll
        for (int nt = 0; nt < 2; ++nt) *(f32x4*)(Up + (size_t)(32 * w + 16 * nt + fr) * 128 + 16 * mt + 4 * fq) = acc[mt][nt];
    __syncthreads();
}
__device__ __forceinline__ void sret_unit(const Params& P, int l, const bf16_t* Z, bf16_t* ORET, int u, LAS unsigned char* lds, int tid) {
    const int b = u >> 2, h = u & 3; const bf16_t* zr = Z + (size_t)(NP + b) * INC;
    LAS float* qf = (LAS float*)lds; LAS float* kf = qf + 128; LAS float* part = kf + 128; LAS float* red = part + 512;
    if (tid < 128) { qf[tid] = bf1(zr[C_QR + h * 128 + tid]); kf[tid] = bf1(zr[C_KR + h * 128 + tid]); }
    __syncthreads();
    const int e = tid & 255, half = tid >> 8; const float ve = bf1(zr[C_VR + h * 256 + e]); const float gamma = __expf(P.logg[h]);
    float qk = 0.f;
#pragma unroll 4
    for (int dk = 0; dk < 128; ++dk) qk += qf[dk] * kf[dk];
    const float* r0 = P.in[5] + ((size_t)(l * 32 + b) * 4 + h) * 32768; float* rn = P.out + O_RETS + ((size_t)(l * 32 + b) * 4 + h) * 32768;
    float acc = 0.f;
#pragma unroll 4
    for (int dk = half * 64; dk < half * 64 + 64; ++dk) { const float r = r0[dk * 256 + e]; rn[dk * 256 + e] = gamma * r + kf[dk] * ve; acc += qf[dk] * r; }
    part[half * 256 + e] = acc;
    __syncthreads();
    float o = 0.f;
    if (tid < 256) { o = qk * ve + gamma * (part[e] + part[256 + e]); const float s = wsum64(o * o); if ((tid & 63) == 0) red[tid >> 6] = s; }
    __syncthreads();
    if (tid < 256) { const float ss = red[0] + red[1] + red[2] + red[3]; const float rstd = rsqrtf(ss * (1.f / 256.f) + EPS); const float gr = bf1(zr[C_GR + h * 256 + e]);
        ORET[(size_t)(NP + b) * DM + h * 256 + e] = tobf1(o * rstd * gr * sigmoidf_(gr)); }
    __syncthreads();
}

__device__ __forceinline__ void p4_scan_combine(const Params& P, int l, const float* RU, bf16_t* RS, const bf16_t* OG, const float* LSE, bf16_t* AO, int tid, int bid, int G) {
    const int gt = bid * 512 + tid;
    if (gt < 65536) { const int bh = gt >> 13, b = bh >> 2, h = bh & 3, e4 = gt & 8191; const float g128 = __expf(128.f * P.logg[h]);
        f32x4 S = {0.f, 0.f, 0.f, 0.f};
#pragma unroll 8
        for (int c = 0; c < 64; ++c) { const size_t idx = ((size_t)(b * 64 + c) * 4 + h) * 32768 + (size_t)e4 * 4;
            u32x2 o; o.x = pkbf(S[0], S[1]); o.y = pkbf(S[2], S[3]); *(u32x2*)(RS + idx) = o;
            const f32x4 uv = *(const f32x4*)(RU + idx); S = S * g128 + uv; }
        const int dv = (e4 * 4) >> 7, dk = (e4 * 4) & 127; float* o = P.out + O_RETP + ((size_t)(l * 2 + b) * 4 + h) * 32768;
#pragma unroll
        for (int i = 0; i < 4; ++i) o[(size_t)(dk + i) * 256 + dv] = S[i]; }
    const int lane = tid & 63, gw = bid * 8 + (tid >> 6), nw = G * 8, j = lane >> 4;
    for (int row = gw; row < NR; row += nw) {
        const float l0 = LSE[((size_t)0 * NR + row) * 4 + j], l1 = LSE[((size_t)1 * NR + row) * 4 + j], l2 = LSE[((size_t)2 * NR + row) * 4 + j];
        const float m = fmaxf(l0, fmaxf(l1, l2)); float w0 = __expf(l0 - m), w1 = __expf(l1 - m), w2 = __expf(l2 - m); const float inv = 1.f / (w0 + w1 + w2); w0 *= inv; w1 *= inv; w2 *= inv;
        const u32x4 a = *(const u32x4*)(OG + ((size_t)0 * NR + row) * 512 + lane * 8), bq = *(const u32x4*)(OG + ((size_t)1 * NR + row) * 512 + lane * 8), c = *(const u32x4*)(OG + ((size_t)2 * NR + row) * 512 + lane * 8);
        u32x4 o;
        o.x = pkbf(w0 * bflo(a.x) + w1 * bflo(bq.x) + w2 * bflo(c.x), w0 * bfhi(a.x) + w1 * bfhi(bq.x) + w2 * bfhi(c.x));
        o.y = pkbf(w0 * bflo(a.y) + w1 * bflo(bq.y) + w2 * bflo(c.y), w0 * bfhi(a.y) + w1 * bfhi(bq.y) + w2 * bfhi(c.y));
        o.z = pkbf(w0 * bflo(a.z) + w1 * bflo(bq.z) + w2 * bflo(c.z), w0 * bfhi(a.z) + w1 * bfhi(bq.z) + w2 * bfhi(c.z));
        o.w = pkbf(w0 * bflo(a.w) + w1 * bflo(bq.w) + w2 * bflo(c.w), w0 * bfhi(a.w) + w1 * bfhi(bq.w) + w2 * bfhi(c.w));
        *(u32x4*)(AO + (size_t)row * 512 + lane * 8) = o;
    }
}

__device__ __forceinline__ void ret3_unit(const Params& P, const bf16_t* Z, const bf16_t* RS, bf16_t* ORET, int u, LAS unsigned char* lds, int tid) {
    const int lane = tid & 63, w = __builtin_amdgcn_readfirstlane(tid >> 6), fr = lane & 15, fq = lane >> 4, q4 = fr >> 2, p4 = fr & 3;
    const int h = u & 3, bc = u >> 2; const float lgh = P.logg[h];
    ret_stage<false>(Z, (size_t)bc * 128, h, lgh, lds, tid);
    const size_t row = (size_t)bc * 128 + 16 * w + fr;
    bf16x8 Qf[4];
    { const bf16_t* qp = Z + row * INC + C_QR + h * 128 + fq * 8;
#pragma unroll
      for (int s = 0; s < 4; ++s) Qf[s] = *(const bf16x8*)(qp + 32 * s); }
    __syncthreads();
    f32x4 Pm[8];
#pragma unroll
    for (int mt = 0; mt < 8; ++mt) { Pm[mt] = (f32x4){0.f, 0.f, 0.f, 0.f};
        if (mt <= w) {
#pragma unroll
            for (int s = 0; s < 4; ++s) { const bf16x8 kf = *(const LAS bf16x8*)(lds + offb(16 * mt + fr, 4 * s + fq)); Pm[mt] = mfma16(kf, Qf[s], Pm[mt]); }
#pragma unroll
            for (int e = 0; e < 4; ++e) { const int diff = 16 * w + fr - (16 * mt + 4 * fq + e); Pm[mt][e] = diff >= 0 ? Pm[mt][e] * __expf((float)diff * lgh) : 0.f; } } }
    f32x4 acc[16];
#pragma unroll
    for (int dt = 0; dt < 16; ++dt) acc[dt] = (f32x4){0.f, 0.f, 0.f, 0.f};
#pragma unroll
    for (int ks = 0; ks < 4; ++ks) if (2 * ks <= w) { const bf16x8 Pb = pack8(Pm[2 * ks], Pm[2 * ks + 1]); const int r0 = 32 * ks + 4 * fq + q4;
#pragma unroll
        for (int dt = 0; dt < 16; ++dt) { LAS unsigned char* vb = lds + 32768 + (dt >> 3) * 32768; const int c = dt & 7;
            acc[dt] = mfma16(cat4(trr(vb + offb(r0, 2 * c + (p4 >> 1)) + 8 * (p4 & 1)), trr(vb + offb(r0 + 16, 2 * c + (p4 >> 1)) + 8 * (p4 & 1))), Pb, acc[dt]); } }
    { const float xi = __expf((float)(16 * w + fr + 1) * lgh); bf16x8 Qx[4];
#pragma unroll
      for (int s = 0; s < 4; ++s) { const u32x4 r = __builtin_bit_cast(u32x4, Qf[s]); u32x4 o; o.x = pkbf(bflo(r.x) * xi, bfhi(r.x) * xi); o.y = pkbf(bflo(r.y) * xi, bfhi(r.y) * xi); o.z = pkbf(bflo(r.z) * xi, bfhi(r.z) * xi); o.w = pkbf(bflo(r.w) * xi, bfhi(r.w) * xi); Qx[s] = __builtin_bit_cast(bf16x8, o); }
      const bf16_t* Rp = RS + ((size_t)bc * 4 + h) * 32768 + (size_t)fr * 128 + fq * 8;
#pragma unroll
      for (int dt = 0; dt < 16; ++dt) {
#pragma unroll
          for (int s = 0; s < 4; ++s) { const bf16x8 rf = *(const bf16x8*)(Rp + (size_t)dt * 2048 + 32 * s); acc[dt] = mfma16(rf, Qx[s], acc[dt]); } } }
    float ss = 0.f;
#pragma unroll
    for (int dt = 0; dt < 16; ++dt) ss += acc[dt][0] * acc[dt][0] + acc[dt][1] * acc[dt][1] + acc[dt][2] * acc[dt][2] + acc[dt][3] * acc[dt][3];
    ss += __shfl_xor(ss, 16); ss += __shfl_xor(ss, 32);
    const float rstd = rsqrtf(ss * (1.f / 256.f) + EPS);
    const bf16_t* gp = Z + row * INC + C_GR + h * 256 + 4 * fq; bf16_t* op = ORET + row * DM + h * 256 + 4 * fq;
#pragma unroll
    for (int dt = 0; dt < 16; ++dt) { const u32x2 g = *(const u32x2*)(gp + 16 * dt); const float g0 = bflo(g.x), g1 = bfhi(g.x), g2 = bflo(g.y), g3 = bfhi(g.y);
        u32x2 o; o.x = pkbf(acc[dt][0] * rstd * g0 * sigmoidf_(g0), acc[dt][1] * rstd * g1 * sigmoidf_(g1)); o.y = pkbf(acc[dt][2] * rstd * g2 * sigmoidf_(g2), acc[dt][3] * rstd * g3 * sigmoidf_(g3));
        *(u32x2*)(op + 16 * dt) = o; }
    __syncthreads();
}

__device__ __forceinline__ void p8_rms(const float* X, const float* nw, bf16_t* H2, int gw, int nwv, int lane) {
    for (int row = gw; row < NR; row += nwv) { const float* x = X + (size_t)row * DM; float4 v[4]; float ss = 0.f;
#pragma unroll
        for (int j = 0; j < 4; ++j) { v[j] = *(const float4*)(x + j * 256 + lane * 4); ss += v[j].x * v[j].x + v[j].y * v[j].y + v[j].z * v[j].z + v[j].w * v[j].w; }
        const float rstd = rsqrtf(wsum64(ss) * (1.f / 1024.f) + EPS);
#pragma unroll
        for (int j = 0; j < 4; ++j) { const float4 w = *(const float4*)(nw + j * 256 + lane * 4);
            u32x2 o; o.x = pkbf(v[j].x * rstd * w.x, v[j].y * rstd * w.y); o.y = pkbf(v[j].z * rstd * w.z, v[j].w * rstd * w.w); *(u32x2*)(H2 + (size_t)row * DM + j * 256 + lane * 4) = o; } }
}

constexpr int PT_CAP = 65;
constexpr int PL_SVL = 0;
constexpr int PL_EL = PT_CAP * 16 * 20 * 4;
constexpr int PL_GL = PL_EL + PT_CAP * 128 * 4;
constexpr int PL_ACT = PL_GL + PT_CAP * 128 * 4;
static_assert(PL_ACT + 8 * 128 * 4 <= LDS_BAR, "PEER LDS map");

struct RowBuf { u32x4 a[8], b[8]; };
__device__ __forceinline__ void peer_issue(RowBuf& B, const unsigned char* tab, const LAS int* el, int bt, int lane) {
    const int ev = el[(bt >> 1) * 16 + (lane & 15)];
#pragma unroll
    for (int k = 0; k < 8; ++k) { const int e = __builtin_amdgcn_readlane(ev, (bt & 1) * 8 + k); const unsigned char* rp = tab + (size_t)e * 2048 + lane * 16;
        B.a[k] = *(const u32x4*)rp; B.b[k] = *(const u32x4*)(rp + 1024); }
}
__device__ __forceinline__ void peer_udot(const RowBuf& B, const u32x4& hA, const u32x4& hB, LAS float* act, int bt, int lane) {
    float p[8];
#pragma unroll
    for (int k = 0; k < 8; ++k) { float s = dot2bf(B.a[k].x, hA.x, 0.f); s = dot2bf(B.a[k].y, hA.y, s); s = dot2bf(B.a[k].z, hA.z, s); s = dot2bf(B.a[k].w, hA.w, s);
        s = dot2bf(B.b[k].x, hB.x, s); s = dot2bf(B.b[k].y, hB.y, s); s = dot2bf(B.b[k].z, hB.z, s); s = dot2bf(B.b[k].w, hB.w, s); p[k] = s; }
    const bool h5 = lane & 32, h4 = lane & 16, h3 = lane & 8;
    float q[4];
#pragma unroll
    for (int i = 0; i < 4; ++i) { const float snd = h5 ? p[i] : p[i + 4], keep = h5 ? p[i + 4] : p[i]; q[i] = keep + __shfl_xor(snd, 32); }
    float r[2];
#pragma unroll
    for (int i = 0; i < 2; ++i) { const float snd = h4 ? q[i] : q[i + 2], keep = h4 ? q[i + 2] : q[i]; r[i] = keep + __shfl_xor(snd, 16); }
    float s; { const float snd = h3 ? r[0] : r[1], keep = h3 ? r[1] : r[0]; s = keep + __shfl_xor(snd, 8); }
    s += __shfl_xor(s, 4); s += __shfl_xor(s, 2); s += __shfl_xor(s, 1);
    if ((lane & 7) == 0) act[bt * 8 + ((lane >> 5) & 1) * 4 + ((lane >> 4) & 1) * 2 + ((lane >> 3) & 1)] = s;
}
__device__ __forceinline__ void peer_vacc(const RowBuf& B, const LAS float* coef, int bt, float (&oA)[8], float (&oB)[8]) {
#pragma unroll
    for (int pp = 0; pp < 4; ++pp) { const float c0 = coef[bt * 8 + 2 * pp], c1 = coef[bt * 8 + 2 * pp + 1]; const unsigned cp = pkbf(c0, c1);
        const u32x4 ra = B.a[2 * pp], rb = B.a[2 * pp + 1], sa = B.b[2 * pp], sb = B.b[2 * pp + 1];
#define MK_VSTEP(o, i, x, y) o[2 * i] = dot2bf(__builtin_amdgcn_perm(y, x, 0x05040100u), cp, o[2 * i]); o[2 * i + 1] = dot2bf(__builtin_amdgcn_perm(y, x, 0x07060302u), cp, o[2 * i + 1]);
        MK_VSTEP(oA, 0, ra.x, rb.x) MK_VSTEP(oA, 1, ra.y, rb.y) MK_VSTEP(oA, 2, ra.z, rb.z) MK_VSTEP(oA, 3, ra.w, rb.w)
        MK_VSTEP(oB, 0, sa.x, sb.x) MK_VSTEP(oB, 1, sa.y, sb.y) MK_VSTEP(oB, 2, sa.z, sb.z) MK_VSTEP(oB, 3, sa.w, sb.w)
#undef MK_VSTEP
    }
}
__device__ __forceinline__ void p10_peer(const Params& P, int l, const int* SC, const bf16_t* H2, float* X, bf16_t* Hn, LAS unsigned char* lds, int tid, int bid, int G) {
    const int lane = tid & 63, w = __builtin_amdgcn_readfirstlane(tid >> 6);
    const int t0 = (int)(((long)bid * NR) / G), t1 = (int)(((long)(bid + 1) * NR) / G);
    LAS int* svl = (LAS int*)(lds + PL_SVL); LAS int* elist = (LAS int*)(lds + PL_EL); LAS float* glist = (LAS float*)(lds + PL_GL); LAS float* act = (LAS float*)(lds + PL_ACT) + w * 128;
    const unsigned char* Ub = P.ws + WS_UBF + (size_t)l * SZ_TAB; const unsigned char* Vb = P.ws + WS_VBF + (size_t)l * SZ_TAB;
    const bool last = (l == NLAYER - 1); const float* nwn = P.in[7] + (last ? 0 : (l + 1) * DM);
    for (int c0 = t0; c0 < t1; c0 += PT_CAP) {
        const int nt = (t1 - c0) < PT_CAP ? (t1 - c0) : PT_CAP;
#ifndef MK_P10MASK
#define MK_P10MASK 7
#endif
        if (MK_P10MASK & 1) { const int ngrp = (nt + 15) >> 4;
          for (int it = w; it < ngrp * 4; it += 8) { const int tg = it >> 2, hq = it & 3, ti = tg * 16 + (lane & 15), hpi = hq * 4 + (lane >> 4); const bool ok = ti < nt; const int row = c0 + (ok ? ti : nt - 1);
            const int* sp = SC + ((size_t)(row >> 4) * 512 + hpi * 32) * 64 + (row & 15) * 4;
            int sv[16];
#pragma unroll
            for (int i = 0; i < 16; ++i) sv[i] = (int)0x80000000;
#pragma unroll 2
            for (int kq = 0; kq < 32; ++kq) { const i32x4 v = *(const i32x4*)(sp + (size_t)kq * 64); ins16(sv, v[0]); ins16(sv, v[1]); ins16(sv, v[2]); ins16(sv, v[3]); }
            if (ok) { LAS int* d = svl + (ti * 16 + hpi) * 20;
#pragma unroll
                for (int i = 0; i < 4; ++i) *(LAS i32x4*)(d + 4 * i) = (i32x4){sv[4 * i], sv[4 * i + 1], sv[4 * i + 2], sv[4 * i + 3]}; } } }
        __syncthreads();
        if (MK_P10MASK & 2) for (int it = tid; it < nt * 8; it += 512) { const int ti = it >> 3, h = it & 7; const LAS int* pa = svl + (ti * 16 + 2 * h) * 20; const LAS int* pb = pa + 20;
            float fa[16], fb[16];
#pragma unroll
            for (int i = 0; i < 4; ++i) { const i32x4 va = *(const LAS i32x4*)(pa + 4 * i), vb = *(const LAS i32x4*)(pb + 4 * i);
#pragma unroll
                for (int e = 0; e < 4; ++e) { fa[4 * i + e] = unsortable(va[e] & ~127); fb[4 * i + e] = unsortable(vb[e] & ~127); } }
            int top[16];
#pragma unroll
            for (int i = 0; i < 16; ++i) top[i] = (int)0x80000000;
#pragma unroll
            for (int i = 0; i < 16; ++i)
#pragma unroll
                for (int j = 0; j < 16; ++j) if ((i + 1) * (j + 1) <= 16) ins16(top, (sortable(fa[i] + fb[j]) & ~255) | (255 - (i * 16 + j)));
            float ev[16]; float sum = 0.f; const float mxv = unsortable(top[0] & ~255);
#pragma unroll
            for (int k = 0; k < 16; ++k) { ev[k] = __expf(unsortable(top[k] & ~255) - mxv); sum += ev[k]; }
            const float inv = 1.f / sum;
#pragma unroll
            for (int k = 0; k < 16; ++k) { const int cidx = 255 - (top[k] & 255), ia = 127 - (pa[cidx >> 4] & 127), ib = 127 - (pb[cidx & 15] & 127);
                elist[ti * 128 + h * 16 + k] = ia * 128 + ib; glist[ti * 128 + h * 16 + k] = ev[k] * inv; } }
        __syncthreads();
        if (MK_P10MASK & 4) for (int ti = w; ti < nt; ti += 8) {
            const int row = c0 + ti; const LAS int* el = elist + ti * 128; const LAS float* gl = glist + ti * 128;
            const u32x4 hA = *(const u32x4*)(H2 + (size_t)row * DM + lane * 8), hB = *(const u32x4*)(H2 + (size_t)row * DM + 512 + lane * 8);
            RowBuf B0, B1;
            peer_issue(B0, Ub, el, 0, lane);
#pragma unroll 1
            for (int bb = 0; bb < 16; bb += 2) {
                peer_issue(B1, Ub, el, bb + 1, lane);
                peer_udot(B0, hA, hB, act, bb, lane);
                if (bb + 2 < 16) peer_issue(B0, Ub, el, bb + 2, lane); else peer_issue(B0, Vb, el, 0, lane);
                peer_udot(B1, hA, hB, act, bb + 1, lane);
            }
            { const float a0 = act[lane], a1 = act[64 + lane]; const float g0 = gl[lane], g1 = gl[64 + lane];
              const float c0v = g0 * 0.5f * a0 * (1.f + erff(a0 * 0.70710678118654752f)), c1v = g1 * 0.5f * a1 * (1.f + erff(a1 * 0.70710678118654752f));
              act[lane] = c0v; act[64 + lane] = c1v; }
            float oA[8], oB[8];
#pragma unroll
            for (int i = 0; i < 8; ++i) { oA[i] = 0.f; oB[i] = 0.f; }
#pragma unroll 1
            for (int bb = 0; bb < 16; bb += 2) {
                peer_issue(B1, Vb, el, bb + 1, lane);
                peer_vacc(B0, act, bb, oA, oB);
                if (bb + 2 < 16) peer_issue(B0, Vb, el, bb + 2, lane);
                peer_vacc(B1, act, bb + 1, oA, oB);
            }
            asm volatile("" ::: "memory");
            float* xr = X + (size_t)row * DM; float y[16];
            { const float4 x0 = *(const float4*)(xr + lane * 8), x1 = *(const float4*)(xr + lane * 8 + 4), x2 = *(const float4*)(xr + 512 + lane * 8), x3 = *(const float4*)(xr + 512 + lane * 8 + 4);
              y[0] = x0.x + oA[0]; y[1] = x0.y + oA[1]; y[2] = x0.z + oA[2]; y[3] = x0.w + oA[3]; y[4] = x1.x + oA[4]; y[5] = x1.y + oA[5]; y[6] = x1.z + oA[6]; y[7] = x1.w + oA[7];
              y[8] = x2.x + oB[0]; y[9] = x2.y + oB[1]; y[10] = x2.z + oB[2]; y[11] = x2.w + oB[3]; y[12] = x3.x + oB[4]; y[13] = x3.y + oB[5]; y[14] = x3.z + oB[6]; y[15] = x3.w + oB[7]; }
            float* dst = last ? (row < NP ? P.out + O_YP + (size_t)row * DM : P.out + O_YS + (size_t)(row - NP) * DM) : xr;
            *(float4*)(dst + lane * 8) = make_float4(y[0], y[1], y[2], y[3]); *(float4*)(dst + lane * 8 + 4) = make_float4(y[4], y[5], y[6], y[7]);
            *(float4*)(dst + 512 + lane * 8) = make_float4(y[8], y[9], y[10], y[11]); *(float4*)(dst + 512 + lane * 8 + 4) = make_float4(y[12], y[13], y[14], y[15]);
            if (!last) { float ss = 0.f;
#pragma unroll
                for (int i = 0; i < 16; ++i) ss += y[i] * y[i];
                const float rstd = rsqrtf(wsum64(ss) * (1.f / 1024.f) + EPS);
                const float4 w0 = *(const float4*)(nwn + lane * 8), w1 = *(const float4*)(nwn + lane * 8 + 4), w2 = *(const float4*)(nwn + 512 + lane * 8), w3 = *(const float4*)(nwn + 512 + lane * 8 + 4);
                u32x4 o0, o1; o0.x = pkbf(y[0] * rstd * w0.x, y[1] * rstd * w0.y); o0.y = pkbf(y[2] * rstd * w0.z, y[3] * rstd * w0.w); o0.z = pkbf(y[4] * rstd * w1.x, y[5] * rstd * w1.y); o0.w = pkbf(y[6] * rstd * w1.z, y[7] * rstd * w1.w);
                o1.x = pkbf(y[8] * rstd * w2.x, y[9] * rstd * w2.y); o1.y = pkbf(y[10] * rstd * w2.z, y[11] * rstd * w2.w); o1.z = pkbf(y[12] * rstd * w3.x, y[13] * rstd * w3.y); o1.w = pkbf(y[14] * rstd * w3.z, y[15] * rstd * w3.w);
                *(u32x4*)(Hn + (size_t)row * DM + lane * 8) = o0; *(u32x4*)(Hn + (size_t)row * DM + 512 + lane * 8) = o1; }
        }
        __syncthreads();
    }
}

constexpr int NPH = 1 + 10 * NLAYER;
__global__ void __launch_bounds__(512, 2) mk_fwd(Params P) {
    extern __shared__ __attribute__((aligned(16))) unsigned char lds_raw[];
    LAS unsigned char* lds = (LAS unsigned char*)lds_raw;
    const int wave = __builtin_amdgcn_readfirstlane((int)threadIdx.x >> 6), bid = blockIdx.x, G = gridDim.x;
    const int nw = G * 8;
    unsigned char* ws = P.ws;
    XcdBarrier bar; bar.wv = wave; bar.bar = (unsigned*)(ws + WS_CTL); bar.x = 0; bar.st = (volatile LAS unsigned*)(lds + LDS_BAR);
    if (P.use_bar) {
        if (wave == 0 && xb_lane() == 0u) *(LAS u32x4*)(lds + LDS_BAR) = (u32x4){0u, 0u, 0u, 0u};
        __syncthreads();
        bar = xcd_barrier_post((unsigned*)(ws + WS_CTL), (volatile LAS unsigned*)(lds + LDS_BAR), wave);
    }
    const int lo = P.ph_lo, hi = P.ph_hi;
#define IN(k) (lo <= (k) && (k) < hi)
#ifndef MK_PHMASK
#define MK_PHMASK 0xffff
#endif
#define PHM(k) ((MK_PHMASK >> (k)) & 1)
#ifndef MK_P3MASK
#define MK_P3MASK 0xf
#endif
#define P3M(k) ((MK_P3MASK >> (k)) & 1)
#define SEAM(k) do { if (IN(k) && IN((k) + 1)) xcd_barrier(bar); } while (0)
    bf16_t* const H = (bf16_t*)(ws + WS_H); bf16_t* const H2 = (bf16_t*)(ws + WS_H2); bf16_t* const Z = (bf16_t*)(ws + WS_Z); float* const X = (float*)(ws + WS_XRES);
    bf16_t* const OG = (bf16_t*)(ws + WS_OG); float* const LSE = (float*)(ws + WS_LSE); bf16_t* const AO = (bf16_t*)(ws + WS_AO);
    float* const RU = (float*)(ws + WS_RU); bf16_t* const RS = (bf16_t*)(ws + WS_RS); bf16_t* const ORET = (bf16_t*)(ws + WS_ORET);
    float* const MIX1 = (float*)(ws + WS_MIX1); bf16_t* const MIXED = (bf16_t*)(ws + WS_MIXED); int* const SC = (int*)(ws + WS_SC);

#define PH_T() int t_; asm volatile("v_mbcnt_lo_u32_b32 %0, -1, 0\n\tv_mbcnt_hi_u32_b32 %0, -1, %0" : "=v"(t_)); t_ += wave * 64; const int l_ = t_ & 63, w_ = __builtin_amdgcn_readfirstlane(t_ >> 6), gw_ = bid * 8 + w_; (void)l_; (void)gw_;
    if (PHM(0) && IN(0)) { PH_T(); p0_prologue(P, lds, t_, bid, G); }
    SEAM(0);
    for (int l = 0; l < NLAYER; ++l) {
        const int pb = 1 + 10 * l;
        const bf16_t* WtIn = (const bf16_t*)(ws + WS_WTIN + l * SZ_WTIN); const bf16_t* WtOa = (const bf16_t*)(ws + WS_WTOA + l * SZ_WTOA); const bf16_t* WtOr = (const bf16_t*)(ws + WS_WTOR + l * SZ_WSQ);
        const bf16_t* WtOut = (const bf16_t*)(ws + WS_WTOUT + l * SZ_WSQ); const bf16_t* WtS = (const bf16_t*)(ws + WS_WTS + l * SZ_WTS);
        if (PHM(1) && IN(pb + 0)) { PH_T(); pg8::Gemm g{H, WtIn, NP, INC, DM}; pg8::StaticOrder S; S.init(NP, INC, G, bid); const float* bg = P.in[9] + (size_t)l * 2048; EpiQuad<QZ> E{QZ{Z, bg}};
            pg8::gemm_phase<EpiQuad<QZ>, pg8::StaticOrder, false>(lds, g, S, E, nullptr, t_);
            skinny<QZ>(H + (size_t)NP * DM, WtIn, INC, DM, QZ{Z, bg}, gw_, nw, l_); }
        SEAM(pb + 0);
        if (PHM(2) && IN(pb + 1)) { PH_T(); p2_post(P, l, Z, gw_, nw, l_); }
        SEAM(pb + 1);
        if (PHM(3) && IN(pb + 2)) { PH_T();
            if (P3M(0)) for (int u = bid; u < 1536; u += G) attn_unit(P, Z, OG, LSE, u, lds, t_);
            if (P3M(1)) for (int u = bid; u < 512; u += G) ret1_unit(P, Z, RU, u, lds, t_);
            if (P3M(2)) for (int u = bid; u < 96; u += G) sattn_unit(P, l, Z, OG, LSE, u, lds, t_);
            if (P3M(3)) for (int u = bid; u < 96 + 128; u += G) { if (u >= 96) sret_unit(P, l, Z, ORET, u - 96, lds, t_); } }
        SEAM(pb + 2);
        if (PHM(4) && IN(pb + 3)) { PH_T(); p4_scan_combine(P, l, RU, RS, OG, LSE, AO, t_, bid, G); }
        SEAM(pb + 3);
        if (PHM(5) && IN(pb + 4)) { PH_T(); for (int u = bid; u < 512; u += G) ret3_unit(P, Z, RS, ORET, u, lds, t_); }
        SEAM(pb + 4);
        if (PHM(6) && IN(pb + 5)) { PH_T();
            { pg8::Gemm g{AO, WtOa, NP, DM, 512}; pg8::StaticOrder S; S.init(NP, DM, G, bid); EpiQuad<QGateA> E{QGateA{Z, MIX1}};
              pg8::gemm_phase<EpiQuad<QGateA>, pg8::StaticOrder, false>(lds, g, S, E, nullptr, t_);
              skinny<QGateA>(AO + (size_t)NP * 512, WtOa, DM, 512, QGateA{Z, MIX1}, gw_, nw, l_); }
            { pg8::Gemm g{ORET, WtOr, NP, DM, DM}; pg8::StaticOrder S; S.init(NP, DM, G, bid); EpiQuad<QGateB> E{QGateB{Z, MIX1, MIXED}};
              pg8::gemm_phase<EpiQuad<QGateB>, pg8::StaticOrder, false>(lds, g, S, E, nullptr, t_);
              skinny<QGateB>(ORET + (size_t)NP * DM, WtOr, DM, DM, QGateB{Z, MIX1, MIXED}, gw_, nw, l_); } }
        SEAM(pb + 5);
        if (PHM(7) && IN(pb + 6)) { PH_T(); pg8::Gemm g{MIXED, WtOut, NP, DM, DM}; pg8::StaticOrder S; S.init(NP, DM, G, bid); EpiQuad<QRes> E{QRes{X}};
            pg8::gemm_phase<EpiQuad<QRes>, pg8::StaticOrder, false>(lds, g, S, E, nullptr, t_);
            skinny<QRes>(MIXED + (size_t)NP * DM, WtOut, DM, DM, QRes{X}, gw_, nw, l_); }
        SEAM(pb + 6);
        if (PHM(8) && IN(pb + 7)) { PH_T(); p8_rms(X, P.in[15] + (size_t)l * DM, H2, gw_, nw, l_); }
        SEAM(pb + 7);
        if (PHM(9) && IN(pb + 8)) { PH_T(); pg8::Gemm g{H2, WtS, NP, 2048, DM}; pg8::StaticOrder S; S.init(NP, 2048, G, bid); EpiQuad<QKey> E{QKey{SC}};
            pg8::gemm_phase<EpiQuad<QKey>, pg8::StaticOrder, false>(lds, g, S, E, nullptr, t_);
            skinny<QKey>(H2 + (size_t)NP * DM, WtS, 2048, DM, QKey{SC}, gw_, nw, l_); }
        SEAM(pb + 8);
        if (PHM(10) && IN(pb + 9)) { PH_T(); p10_peer(P, l, SC, H2, X, H, lds, t_, bid, G); }
        SEAM(pb + 9);
    }
#undef IN
#undef SEAM
}
}

#ifndef MK_ONE_LAUNCH
#define MK_ONE_LAUNCH 0
#endif
static int t5_bucket(long dist) {
    const int max_exact = 16;
    if (dist < max_exact) return (int)dist;
    const double ratio = log((double)(dist < 1 ? 1 : dist) / max_exact) / log(2048.0 / max_exact);
    long large = max_exact + (long)(ratio * (32 - max_exact));
    return (int)(large < 31 ? large : 31);
}
extern "C" void kernel_launch(void* const* d_in, const int* in_sizes, int n_in, void* d_out, int out_size, void* d_ws, size_t ws_size, hipStream_t stream) {
    using namespace mk;
    static int grid = 0;
    if (grid == 0) {
        if (n_in != 20 || (size_t)out_size != O_END || ws_size < WS_END) { fprintf(stderr, "kernel_launch: unexpected shapes (n_in %d out %d ws %zu need %zu)\n", n_in, out_size, ws_size, (size_t)WS_END); grid = -1; return; }
        int dev = 0, cus = 0, per_cu = 0;
        if (hipGetDevice(&dev) != hipSuccess || hipDeviceGetAttribute(&cus, hipDeviceAttributeMultiprocessorCount, dev) != hipSuccess) { grid = -1; return; }
        if (hipFuncSetAttribute((const void*)mk_fwd, hipFuncAttributeMaxDynamicSharedMemorySize, LDS_BYTES) != hipSuccess) { fprintf(stderr, "kernel_launch: hipFuncSetAttribute failed\n"); grid = -1; return; }
        if (hipOccupancyMaxActiveBlocksPerMultiprocessor(&per_cu, (const void*)mk_fwd, 512, LDS_BYTES) != hipSuccess || per_cu < 1) { fprintf(stderr, "kernel_launch: occupancy query says %d\n", per_cu); (void)hipGetLastError(); }
        grid = cus;
    }
    if (grid < 0) return;
    Params p; memset(&p, 0, sizeof(p));
    for (int i = 0; i < 20; ++i) p.in[i] = (const float*)d_in[i];
    p.out = (float*)d_out; p.ws = (unsigned char*)d_ws;
    for (int i = 0; i < 64; ++i) { const double lin = (i == 63) ? 1.0 : i * (1.0 / 63.0); p.ang[i] = (float)(1.0 / pow(10000.0, lin)); }
    for (int h = 0; h < 4; ++h) p.logg[h] = (float)log(1.0 - pow(2.0, -5.0 - h));
    for (int g = 0; g < 3; ++g) for (int m = 0; m <= 128; ++m) p.bucket[g][m] = (unsigned char)t5_bucket((long)m << (2 * g));
    (void)hipMemsetAsync(d_ws, 0, CTL_BYTES, stream);
#if MK_ONE_LAUNCH
    p.ph_lo = 0; p.ph_hi = NPH; p.use_bar = 1;
    hipLaunchKernelGGL(mk_fwd, dim3(grid), dim3(512), LDS_BYTES, stream, p);
#else
    for (int ph = 0; ph < NPH; ++ph) { p.ph_lo = ph; p.ph_hi = ph + 1; p.use_bar = 0; hipLaunchKernelGGL(mk_fwd, dim3(grid), dim3(512), LDS_BYTES, stream, p); }
#endif
}
```

```cpp
#include <hip/hip_runtime.h>
#include <math.h>
#include <stdio.h>
#include <string.h>
namespace pg8 {
#define PG8_LAS __attribute__((address_space(3)))
typedef unsigned short bf16_t;
typedef short bf16x8 __attribute__((ext_vector_type(8)));
typedef float f32x4 __attribute__((ext_vector_type(4)));
typedef unsigned u32x4 __attribute__((ext_vector_type(4)));
constexpr int BM = 256, BK = 64, HALF = 128, HTB = HALF * BK * 2  , STAGE_BYTES = 8 * HTB, NXCD = 8, WGM = 8;

__host__ __device__ __forceinline__ int lds_byte(int r, int c) { const int st = (r >> 4) * 2 + (c >> 5), rr = r & 15, cc = c & 31, ob = rr * 64 + cc * 2; return st * 1024 + (ob ^ (((ob >> 9) & 1) << 5)); }
__host__ __device__ __forceinline__ void stage_rc(int b, int& R, int& C) { const int st = b / 1024, sb = b % 1024, swz = sb ^ (((sb >> 9) & 1) << 5); R = (st >> 1) * 16 + swz / 64; C = (st & 1) * 32 + (swz % 64) / 2; }
__host__ __device__ __forceinline__ int perm32(int rho) { const int n = rho >> 4, i = rho & 15; return 8 * (i >> 2) + 4 * n + (i & 3); }

struct Unit { int pm, pn; };
struct Gemm { const bf16_t* A; const bf16_t* Bt; int M, N, K; };

struct StaticOrder {
    int nM, nN, nwg, G, c;
    __host__ __device__ void init(int M, int N, int G_, int c_) { nM = M / BM; nN = N / BM; nwg = nM * nN; G = G_; c = c_; }
    __host__ __device__ bool next(int i, Unit& u) const {
        const long L = (long)i * G + c; if (L >= nwg) return false;
        int wgid = (int)L; { const int q = nwg / NXCD, r = nwg % NXCD, xcd = wgid % NXCD, off = wgid / NXCD; wgid = (xcd < r ? xcd * (q + 1) : r * (q + 1) + (xcd - r) * q) + off; }
        const int nig = WGM * nN, gid = wgid / nig, fm = gid * WGM, gsz = (nM - fm) < WGM ? (nM - fm) : WGM;
        u.pm = fm + ((wgid % nig) % gsz); u.pn = (wgid % nig) / gsz; return true;
    }
    __device__ __forceinline__ void a_ready(const Unit&) const {}
    __device__ __forceinline__ void done(const Unit&) const {}
};
__device__ __forceinline__ unsigned cvt_pk_bf16(float lo, float hi) { unsigned r; asm volatile("v_cvt_pk_bf16_f32 %0, %1, %2" : "=v"(r) : "v"(lo), "v"(hi)); return r; }
template <class Epi, class Sched, bool STAMP = false>
__device__ __forceinline__ void gemm_phase(PG8_LAS unsigned char* lds, const Gemm g, const Sched& S, const Epi& E, unsigned long long* stamps, int tid_in) {
    int tid_ = tid_in; asm volatile("" : "+v"(tid_));
    const int tid = tid_, wid = __builtin_amdgcn_readfirstlane(tid >> 6), lane = tid & 63, wr = wid >> 2, wc = wid & 3, fr = lane & 15, fq = lane >> 4;
    const int K = g.K, nt = K / BK;
    int ts_lo = 0, ts_hi = 0, nts = 0; const unsigned long long rt_entry = STAMP ? (unsigned long long)wall_clock64() : 0ull;
#define PG8_STAMP() do { if (STAMP && wid == 0 && nts < 64) { const unsigned long long _c = (unsigned long long)clock64(); \
        ts_lo = (lane == nts) ? (int)(unsigned)_c : ts_lo; ts_hi = (lane == nts) ? (int)(unsigned)(_c >> 32) : ts_hi; ++nts; } } while (0)
    PG8_STAMP();
    unsigned voffA[2], voffB[2];
#pragma unroll
    for (int i = 0; i < 2; ++i) { int R, C; stage_rc(tid * 16 + i * 8192, R, C); const int Rb = Epi::PERM ? ((R & ~31) + perm32(R & 31)) : R;
        voffA[i] = (unsigned)(R * K + C) * 2u; voffB[i] = (unsigned)(Rb * K + C) * 2u; }
    const size_t kstep = (size_t)(BK * 2);
    const size_t hstep = (size_t)HALF * K * 2;
    const size_t tstep = 2 * hstep;
    const unsigned ldsw = (unsigned)wid * 1024u;
    const int aoff = lds_byte(wr * 64 + fr, fq * 8), boff = lds_byte(wc * 32 + fr, fq * 8);
#define PG8_SA(b, h) (((b) * 2 + (h)) * HTB)
#define PG8_SB(b, h) ((4 + (b) * 2 + (h)) * HTB)
#define PG8_STAGE(bufoff, gbase, voff) do { _Pragma("unroll") for (int _i = 0; _i < 2; ++_i) \
        __builtin_amdgcn_global_load_lds((const unsigned*)((const char*)(gbase) + (voff)[_i]), (PG8_LAS unsigned*)(lds + (bufoff) + ldsw + _i * 8192), 16, 0, 0); } while (0)
#define PG8_LDA(dst, b, h) do { _Pragma("unroll") for (int m = 0; m < 4; ++m) _Pragma("unroll") for (int k = 0; k < 2; ++k) dst[m][k] = *(const PG8_LAS bf16x8*)(lds + PG8_SA(b, h) + aoff + m * 2048 + k * 1024); } while (0)
#define PG8_LDB(dst, b, h) do { _Pragma("unroll") for (int n = 0; n < 2; ++n) _Pragma("unroll") for (int k = 0; k < 2; ++k) dst[n][k] = *(const PG8_LAS bf16x8*)(lds + PG8_SB(b, h) + boff + n * 2048 + k * 1024); } while (0)
#define PG8_MMA(ai, bj, At, Bt) do { __builtin_amdgcn_s_setprio(1); _Pragma("unroll") for (int m = 0; m < 4; ++m) _Pragma("unroll") for (int n = 0; n < 2; ++n) _Pragma("unroll") for (int k = 0; k < 2; ++k) \
        acc[ai][bj][m][n] = __builtin_amdgcn_mfma_f32_16x16x32_bf16(Bt[n][k], At[m][k], acc[ai][bj][m][n], 0, 0, 0); __builtin_amdgcn_s_setprio(0); } while (0)
#define PG8_WAIT_V(n) asm volatile("s_waitcnt vmcnt(" #n ")" ::: "memory")
#define PG8_WAIT_L(n) asm volatile("s_waitcnt lgkmcnt(" #n ")" ::: "memory")
#define PG8_BAR __builtin_amdgcn_s_barrier()
#define PG8_SCHED __builtin_amdgcn_sched_barrier(0)
    Unit cur, nxt; int ui = 0;
    if (!S.next(0, cur)) return;
    f32x4 acc[2][2][4][2];
#pragma unroll
    for (int a = 0; a < 2; ++a)
#pragma unroll
        for (int b = 0; b < 2; ++b)
#pragma unroll
            for (int m = 0; m < 4; ++m)
#pragma unroll
                for (int n = 0; n < 2; ++n) acc[a][b][m][n] = (f32x4){0.f, 0.f, 0.f, 0.f};
    bf16x8 At[4][2], B0[2][2], B1[2][2];
    const char* cA = (const char*)g.A + (size_t)cur.pm * tstep; const char* cB = (const char*)g.Bt + (size_t)cur.pn * tstep;
    S.a_ready(cur);
    PG8_STAGE(PG8_SB(0, 0), cB, voffB); PG8_STAGE(PG8_SA(0, 0), cA, voffA); PG8_STAGE(PG8_SB(0, 1), cB + hstep, voffB); PG8_STAGE(PG8_SA(0, 1), cA + hstep, voffA);
    if (wr == 1) PG8_BAR;
    PG8_WAIT_V(4); PG8_BAR;
    PG8_STAGE(PG8_SB(1, 0), cB + kstep, voffB); PG8_STAGE(PG8_SA(1, 0), cA + kstep, voffA); PG8_STAGE(PG8_SB(1, 1), cB + hstep + kstep, voffB);
    PG8_WAIT_V(6); PG8_BAR;
    PG8_STAMP();
    for (;;) {
        const bool has_next = S.next(ui + 1, nxt);
        const char* nA = has_next ? (const char*)g.A + (size_t)nxt.pm * tstep : cA; const char* nB = has_next ? (const char*)g.Bt + (size_t)nxt.pn * tstep : cB;
        for (int t = 0; t < nt; t += 2) {
            const bool last = (t == nt - 2);
            const char* a1 = cA + (size_t)(t + 1) * kstep;
            const char* a2 = last ? nA : cA + (size_t)(t + 2) * kstep; const char* b2 = last ? nB : cB + (size_t)(t + 2) * kstep;
            const char* a3 = a2 + kstep; const char* b3 = b2 + kstep;
            if (last && has_next) S.a_ready(nxt);
            PG8_LDB(B0, 0, 0); PG8_SCHED; PG8_LDA(At, 0, 0); PG8_STAGE(PG8_SA(1, 1), a1 + hstep, voffA);
            PG8_WAIT_L(8); PG8_BAR; PG8_WAIT_L(0); PG8_MMA(0, 0, At, B0); PG8_BAR; PG8_SCHED;
            PG8_LDB(B1, 0, 1); PG8_STAGE(PG8_SB(0, 0), b2, voffB);
            PG8_BAR; PG8_WAIT_L(0); PG8_MMA(0, 1, At, B1); PG8_BAR;
            PG8_LDA(At, 0, 1); PG8_STAGE(PG8_SA(0, 0), a2, voffA);
            PG8_BAR; PG8_WAIT_L(0); PG8_MMA(1, 0, At, B0); PG8_BAR; PG8_SCHED;
            PG8_STAGE(PG8_SB(0, 1), b2 + hstep, voffB);
            PG8_WAIT_V(6); PG8_BAR; PG8_MMA(1, 1, At, B1); PG8_BAR;
            PG8_LDB(B0, 1, 0); PG8_SCHED; PG8_LDA(At, 1, 0); PG8_STAGE(PG8_SA(0, 1), a2 + hstep, voffA);
            PG8_WAIT_L(8); PG8_BAR; PG8_WAIT_L(0); PG8_MMA(0, 0, At, B0); PG8_BAR; PG8_SCHED;
            PG8_LDB(B1, 1, 1); PG8_STAGE(PG8_SB(1, 0), b3, voffB);
            PG8_BAR; PG8_WAIT_L(0); PG8_MMA(0, 1, At, B1); PG8_BAR;
            PG8_LDA(At, 1, 1); PG8_STAGE(PG8_SA(1, 0), a3, voffA);
            PG8_BAR; PG8_WAIT_L(0); PG8_MMA(1, 0, At, B0); PG8_BAR; PG8_SCHED;
            PG8_STAGE(PG8_SB(1, 1), b3 + hstep, voffB);
            PG8_WAIT_V(6); PG8_BAR; PG8_MMA(1, 1, At, B1); PG8_BAR;
        }
        PG8_STAMP();
        if constexpr (!Epi::AFTER_DRAIN) { E(acc, cur, wr, wc, fr, fq); S.done(cur); }
        PG8_STAMP();
        if (!has_next) break;
#pragma unroll
        for (int a = 0; a < 2; ++a)
#pragma unroll
            for (int b = 0; b < 2; ++b)
#pragma unroll
                for (int m = 0; m < 4; ++m)
#pragma unroll
                    for (int n = 0; n < 2; ++n) acc[a][b][m][n] = (f32x4){0.f, 0.f, 0.f, 0.f};
        cur = nxt; cA = nA; cB = nB; ++ui;
    }
    PG8_WAIT_V(0);
    if (wr == 0) PG8_BAR;
    PG8_BAR;
    if constexpr (Epi::AFTER_DRAIN) { E.fused(acc, cur, wr, wc, fr, fq, lds, wid, lane); S.done(cur); }
    PG8_STAMP();
    if (STAMP && wid == 0) { stamps[lane] = lane < nts ? (((unsigned long long)(unsigned)ts_hi << 32) | (unsigned)ts_lo) : 0ull;
        if (lane == 62) stamps[62] = rt_entry; if (lane == 63) stamps[63] = (unsigned long long)wall_clock64(); }
#undef PG8_STAMP
#undef PG8_SA
#undef PG8_SB
#undef PG8_STAGE
#undef PG8_LDA
#undef PG8_LDB
#undef PG8_MMA
#undef PG8_WAIT_V
#undef PG8_WAIT_L
#undef PG8_BAR
#undef PG8_SCHED
}
}

#define XB_TMO      128
#define XB_XCNT(j)  (256  + 64 * (j))
#define XB_XSUB(j)  (1280 + 64 * (j))
#define XB_XGEN(j)  (2304 + 64 * (j))
#define XB_TOP      3328
#define XB_TOPGEN   3392
#define XCD_BAR_WORDS 3456
#define XB_SPIN_CAP (1u << 18)
#define LAS __attribute__((address_space(3)))

__device__ __forceinline__ unsigned xb_ld(unsigned* p)              { return __hip_atomic_load(p, __ATOMIC_RELAXED, __HIP_MEMORY_SCOPE_AGENT); }
__device__ __forceinline__ unsigned xb_add(unsigned* p, unsigned v) { return __hip_atomic_fetch_add(p, v, __ATOMIC_RELAXED, __HIP_MEMORY_SCOPE_AGENT); }
__device__ __forceinline__ unsigned xb_xcc_id() { return (unsigned)__builtin_amdgcn_s_getreg((3 << 11) | 20) & 0xFu; }
#define XB_SPIN(cond, bar) do { unsigned _sp = 0; while (cond) { __builtin_amdgcn_s_sleep(1); \
    if ((++_sp & 255u) == 0u) { if (xb_ld(&(bar)[XB_TMO])) break; if (_sp > XB_SPIN_CAP) { atomicAdd(&(bar)[XB_TMO], 1u); break; } } } } while (0)

struct XcdBarrier {
    int wv;
    unsigned* bar; unsigned x;
    volatile LAS unsigned* st;
};

__device__ __forceinline__ unsigned xb_lane() { unsigned l; asm volatile("v_mbcnt_lo_u32_b32 %0, -1, 0\n\tv_mbcnt_hi_u32_b32 %0, -1, %0" : "=v"(l)); return l; }
__device__ __forceinline__ XcdBarrier xcd_barrier_post(unsigned* bar, volatile LAS unsigned* st, int wv) {
    XcdBarrier b; b.wv = wv; b.bar = bar; b.x = xb_xcc_id(); b.st = st;
    if (wv == 0 && xb_lane() == 0u) (void)xb_add(&bar[XB_XCNT(b.x)], 1u);
    return b;
}
__device__ __forceinline__ void xcd_barrier_complete(unsigned* bar, unsigned x, unsigned& nloc, unsigned& nx) {
    const unsigned G = gridDim.x * gridDim.y * gridDim.z;
    unsigned sum, cnt, mine, sp = 0u;
    for (;;) {
        sum = 0u; cnt = 0u; mine = 0u;
#pragma unroll
        for (unsigned j = 0; j < 16; ++j) { const unsigned c = xb_ld(&bar[XB_XCNT(j)]); sum += c; cnt += (c > 0u) ? 1u : 0u; mine = (j == x) ? c : mine; }
        if (sum == G) break;
        __builtin_amdgcn_s_sleep(1);
        if ((++sp & 255u) == 0u) { if (xb_ld(&bar[XB_TMO])) break; if (sp > XB_SPIN_CAP) { atomicAdd(&bar[XB_TMO], 1u); break; } }
    }
    nloc = mine > 0u ? mine : 1u; nx = cnt > 0u ? cnt : 1u;
}

__device__ __forceinline__ void xcd_barrier(const XcdBarrier& b) {
    asm volatile("s_waitcnt vmcnt(0)" ::: "memory");
    __syncthreads();
    if (b.wv == 0 && xb_lane() == 0u) {
        unsigned* bar = b.bar;
        __builtin_amdgcn_s_waitcnt(0);
        unsigned nloc = b.st[0], nx = b.st[1];
        if (nloc == 0u) { xcd_barrier_complete(bar, b.x, nloc, nx); b.st[0] = nloc; b.st[1] = nx; }
        const unsigned old = xb_add(&bar[XB_XSUB(b.x)], 1u);
        const unsigned gen = old / nloc;
        if (old + 1u == (gen + 1u) * nloc) {
            __builtin_amdgcn_fence(__ATOMIC_RELEASE, "agent");
            asm volatile("s_waitcnt vmcnt(0)" ::: "memory");
            const unsigned og = xb_add(&bar[XB_TOP], 1u);
            const unsigned tg = og / nx;
            if (og + 1u == (tg + 1u) * nx) xb_add(&bar[XB_TOPGEN], 1u);
            else XB_SPIN(xb_ld(&bar[XB_TOPGEN]) == tg, bar);
            __builtin_amdgcn_fence(__ATOMIC_ACQUIRE, "agent");
            xb_add(&bar[XB_XGEN(b.x)], 1u);
            asm volatile("s_waitcnt vmcnt(0)" ::: "memory");
        } else {
            XB_SPIN(xb_ld(&bar[XB_XGEN(b.x)]) == gen, bar);
            __builtin_amdgcn_fence(__ATOMIC_ACQUIRE, "agent");
            asm volatile("s_waitcnt vmcnt(0)" ::: "memory");
        }
    }
    __syncthreads();
}


namespace mk {
using pg8::bf16_t; using pg8::bf16x8; using pg8::f32x4; using pg8::u32x4;
typedef unsigned u32x2 __attribute__((ext_vector_type(2)));
typedef short s16x4 __attribute__((ext_vector_type(4)));
typedef int i32x4 __attribute__((ext_vector_type(4)));
typedef __bf16 bf2_t __attribute__((ext_vector_type(2)));
typedef float f32x2 __attribute__((ext_vector_type(2)));
typedef float f32x16 __attribute__((ext_vector_type(16)));
typedef float f32x32 __attribute__((ext_vector_type(32)));
typedef unsigned u32x6 __attribute__((ext_vector_type(6)));

constexpr int DM = 1024, NP = 16384, NSMP = 32, NR = NP + NSMP, INC = 9728, NLAYER = 2;
constexpr int C_QA = 0, C_KA = 1536, C_VA = 3072, C_QR = 4608, C_KR = 5120, C_VR = 5632, C_GR = 6656, C_GA = 7680, C_GB = 8704;
constexpr float EPS = 1e-6f;
constexpr int LDS_BYTES = 162816, LDS_BAR = 162800;

constexpr size_t al256(size_t x) { return (x + 255) & ~(size_t)255; }
constexpr size_t WS_CTL = 0, CTL_BYTES = 65536;
constexpr size_t SZ_WTIN = (size_t)INC * DM * 2, SZ_WTOA = (size_t)DM * 512 * 2, SZ_WSQ = (size_t)DM * DM * 2, SZ_WTS = (size_t)2048 * DM * 2, SZ_TAB = (size_t)16384 * DM * 2;
constexpr size_t WS_WTIN = WS_CTL + CTL_BYTES;
constexpr size_t WS_WTOA = WS_WTIN + NLAYER * SZ_WTIN;
constexpr size_t WS_WTOR = WS_WTOA + NLAYER * SZ_WTOA;
constexpr size_t WS_WTOUT = WS_WTOR + NLAYER * SZ_WSQ;
constexpr size_t WS_WTS = WS_WTOUT + NLAYER * SZ_WSQ;
constexpr size_t WS_UBF = WS_WTS + NLAYER * SZ_WTS;
constexpr size_t WS_VBF = WS_UBF + NLAYER * SZ_TAB;
constexpr size_t WS_XRES = WS_VBF + NLAYER * SZ_TAB;
constexpr size_t WS_H = WS_XRES + al256((size_t)NR * DM * 4);
constexpr size_t WS_H2 = WS_H + al256((size_t)NR * DM * 2);
constexpr size_t WS_Z = WS_H2 + al256((size_t)NR * DM * 2);
constexpr size_t ZO_A = 0;
constexpr size_t ZO_RQ = ZO_A + (size_t)NP * 4608;
constexpr size_t ZO_RK = ZO_RQ + (size_t)NP * 512;
constexpr size_t ZO_RV = ZO_RK + (size_t)NP * 512;
constexpr size_t ZO_GR = ZO_RV + (size_t)NP * 1024;
constexpr size_t ZO_GA = ZO_GR + (size_t)NP * 1024;
constexpr size_t ZO_GB = ZO_GA + (size_t)NP * 1024;
static_assert(ZO_GB + (size_t)NP * 1024 == (size_t)NP * INC, "compact layouts fill the prompt part of Z exactly");
constexpr size_t WS_OG = WS_Z + al256((size_t)NR * INC * 2);
constexpr size_t WS_LSE = WS_OG + al256((size_t)3 * NR * 512 * 2);
constexpr size_t WS_AO = WS_LSE + al256((size_t)3 * NR * 4 * 4);
constexpr size_t WS_RU = WS_AO + al256((size_t)NR * 512 * 2);
constexpr size_t WS_RS = WS_RU + (size_t)2 * 64 * 4 * 32768 * 4;
constexpr size_t WS_ORET = WS_RS + (size_t)2 * 64 * 4 * 32768 * 2;
constexpr size_t WS_MIX1 = WS_ORET + al256((size_t)NR * DM * 2);
constexpr size_t WS_MIXED = WS_MIX1 + al256((size_t)NR * DM * 4);
constexpr size_t WS_SC = WS_MIXED + al256((size_t)NR * DM * 2);
constexpr size_t WS_TSC = WS_SC + al256((size_t)NR * 2048 * 4);
constexpr size_t WS_CS = WS_TSC + (size_t)4 * 16384 * 4;
constexpr size_t WS_BT = WS_CS + al256((size_t)8193 * 64 * 8);
constexpr size_t WS_END = WS_BT + al256((size_t)12 * 132 * 4);
constexpr size_t SZ_TAB8 = (size_t)16384 * DM;
constexpr size_t SZ_TAB6 = (size_t)16384 * 768;

constexpr size_t O_YP = 0, O_YS = O_YP + (size_t)NP * DM, O_KV1P = O_YS + (size_t)NSMP * DM;
constexpr size_t O_KV4P = O_KV1P + (size_t)2 * 2 * 128 * 1024, O_KV16P = O_KV4P + (size_t)2 * 2 * 512 * 1024, O_RETP = O_KV16P + (size_t)2 * 2 * 2048 * 1024;
constexpr size_t O_KV1S = O_RETP + (size_t)2 * 2 * 4 * 32768, O_KV4S = O_KV1S + 65536, O_KV16S = O_KV4S + 65536, O_RETS = O_KV16S + 65536;
constexpr size_t O_END = O_RETS + (size_t)2 * 32 * 4 * 32768;

struct Params {
    const float* in[20]; float* out; unsigned char* ws;
    float ang[64]; float logg[4];
    unsigned char bucket[3][132]; unsigned char padb[4];
    int ph_lo, ph_hi, use_bar; float rsq128;
};
static_assert(sizeof(Params) == 20 * 8 + 16 + 256 + 16 + 400 + 16, "Params has holes");

__device__ __forceinline__ unsigned pkbf(float lo, float hi) { unsigned r; asm("v_cvt_pk_bf16_f32 %0, %1, %2" : "=v"(r) : "v"(lo), "v"(hi)); return r; }
__device__ __forceinline__ float bflo(unsigned u) { return __uint_as_float(u << 16); }
__device__ __forceinline__ float bfhi(unsigned u) { return __uint_as_float(u & 0xffff0000u); }
__device__ __forceinline__ float bf1(bf16_t u) { return __uint_as_float(((unsigned)u) << 16); }
__device__ __forceinline__ bf16_t tobf1(float f) { return (bf16_t)(pkbf(f, 0.f) & 0xffffu); }
__device__ __forceinline__ float tobf1f(float f) { return __uint_as_float(pkbf(f, 0.f) << 16); }
__device__ __forceinline__ unsigned offb(unsigned row, unsigned ch) { return 256u * row + 16u * (ch ^ (((row & 3u) << 2) | ((row >> 2) & 3u))); }
__device__ __forceinline__ s16x4 trr(LAS unsigned char* p) { return __builtin_amdgcn_ds_read_tr16_b64_v4i16((LAS s16x4*)p); }
__device__ __forceinline__ bf16x8 cat4(s16x4 a, s16x4 b) { bf16x8 r; r[0] = a[0]; r[1] = a[1]; r[2] = a[2]; r[3] = a[3]; r[4] = b[0]; r[5] = b[1]; r[6] = b[2]; r[7] = b[3]; return r; }
__device__ __forceinline__ bf16x8 pack8(f32x4 a, f32x4 b) { u32x4 w; w.x = pkbf(a[0], a[1]); w.y = pkbf(a[2], a[3]); w.z = pkbf(b[0], b[1]); w.w = pkbf(b[2], b[3]); return __builtin_bit_cast(bf16x8, w); }
__device__ __forceinline__ f32x4 mfma16(bf16x8 a, bf16x8 b, f32x4 c) { return __builtin_amdgcn_mfma_f32_16x16x32_bf16(a, b, c, 0, 0, 0); }
__device__ __forceinline__ float shx(float v, int m) {
    const int x = __float_as_int(v); int r;
    switch (m) {
        case 1: r = __builtin_amdgcn_ds_swizzle(x, (1 << 10) | 0x1f); break;
        case 2: r = __builtin_amdgcn_ds_swizzle(x, (2 << 10) | 0x1f); break;
        case 4: r = __builtin_amdgcn_ds_swizzle(x, (4 << 10) | 0x1f); break;
        case 8: r = __builtin_amdgcn_ds_swizzle(x, (8 << 10) | 0x1f); break;
        case 16: r = __builtin_amdgcn_ds_swizzle(x, (16 << 10) | 0x1f); break;
        default: { const u32x2 p = __builtin_amdgcn_permlane32_swap((unsigned)x, (unsigned)x, false, false); r = (int)(xb_lane() < 32u ? p.y : p.x); } break;
    }
    return __int_as_float(r);
}
__device__ __forceinline__ float wsum64(float v) { v += shx(v, 32); v += shx(v, 16); v += shx(v, 8); v += shx(v, 4); v += shx(v, 2); v += shx(v, 1); return v; }
__device__ __forceinline__ float sigmoidf_(float x) { return 1.f / (1.f + __expf(-x)); }
__device__ __forceinline__ int med3i(int a, int b, int c) { int r; asm("v_med3_i32 %0, %1, %2, %3" : "=v"(r) : "v"(a), "v"(b), "v"(c)); return r; }
__device__ __forceinline__ int sortable(float x) { const int b = __float_as_int(x); return b ^ ((b >> 31) & 0x7fffffff); }
__device__ __forceinline__ float unsortable(int s) { return __int_as_float(s ^ ((s >> 31) & 0x7fffffff)); }
__device__ __forceinline__ void ins16(int (&sv)[16], int x) {
#pragma unroll
    for (int i = 15; i >= 1; --i) sv[i] = med3i(sv[i - 1], sv[i], x);
    sv[0] = sv[0] > x ? sv[0] : x;
}
__device__ __forceinline__ float dot2bf(unsigned a, unsigned b, float c) { return __builtin_amdgcn_fdot2_f32_bf16(__builtin_bit_cast(bf2_t, a), __builtin_bit_cast(bf2_t, b), c, false); }

template <class Q> struct EpiQuad {
    static constexpr bool PERM = false, AFTER_DRAIN = false;
    Q q;
    __device__ __forceinline__ void operator()(const f32x4 (&acc)[2][2][4][2], const pg8::Unit& u, int wr, int wc, int fr, int fq) const {
        const int row0 = u.pm * 256 + wr * 64 + fr, col0 = u.pn * 256 + wc * 32 + 4 * fq;
#pragma unroll
        for (int ai = 0; ai < 2; ++ai)
#pragma unroll
            for (int m = 0; m < 4; ++m)
#pragma unroll
                for (int bj = 0; bj < 2; ++bj)
#pragma unroll
                    for (int n = 0; n < 2; ++n) { q.quad(row0 + ai * 128 + m * 16, col0 + bj * 128 + n * 16, acc[ai][bj][m][n]); if (Q::FENCE) asm volatile("" ::: "memory"); }
    }
};
template <class Q, int MB  > struct EpiQuadB {
    static constexpr bool PERM = false, AFTER_DRAIN = false;
    Q q;
    __device__ __forceinline__ void operator()(const f32x4 (&acc)[2][2][4][2], const pg8::Unit& u, int wr, int wc, int fr, int fq) const {
        const int row0 = u.pm * 256 + wr * 64 + fr, col0 = u.pn * 256 + wc * 32 + 4 * fq;
#pragma unroll
        for (int ai = 0; ai < 2; ++ai)
#pragma unroll
            for (int mp = 0; mp < 4 / MB; ++mp) { typename Q::L ld[MB][2][2];
#pragma unroll
                for (int mm = 0; mm < MB; ++mm)
#pragma unroll
                    for (int bj = 0; bj < 2; ++bj)
#pragma unroll
                        for (int n = 0; n < 2; ++n) ld[mm][bj][n] = q.load(row0 + ai * 128 + (MB * mp + mm) * 16, col0 + bj * 128 + n * 16);
                __builtin_amdgcn_sched_barrier(0);
#pragma unroll
                for (int mm = 0; mm < MB; ++mm)
#pragma unroll
                    for (int bj = 0; bj < 2; ++bj)
#pragma unroll
                        for (int n = 0; n < 2; ++n) q.fin(row0 + ai * 128 + (MB * mp + mm) * 16, col0 + bj * 128 + n * 16, acc[ai][bj][MB * mp + mm][n], ld[mm][bj][n]);
                asm volatile("" ::: "memory"); }
    }
};
struct QZ { static constexpr bool FENCE = false; bf16_t* Z; const float* bg;
    __device__ __forceinline__ void quad(int row, int col, f32x4 v) const {
        if (col >= C_GA) { const f32x4 b = *(const f32x4*)(bg + (col - C_GA)); v[0] = sigmoidf_(v[0] + b[0]); v[1] = sigmoidf_(v[1] + b[1]); v[2] = sigmoidf_(v[2] + b[2]); v[3] = sigmoidf_(v[3] + b[3]); }
        u32x2 w; w.x = pkbf(v[0], v[1]); w.y = pkbf(v[2], v[3]); *(u32x2*)(Z + (size_t)row * INC + col) = w; } };
struct EpiZ {
    static constexpr bool PERM = true, AFTER_DRAIN = false;
    bf16_t* Z; const float* bg;
    __device__ __forceinline__ void operator()(const f32x4 (&acc)[2][2][4][2], const pg8::Unit& u, int wr, int wc, int fr, int fq) const {
        const int pn = u.pn; const bool gate = pn >= 30;
        size_t base; int rs, bjs, dsh = 0;
        if (pn < 18) { const int which = pn / 6, g = (pn % 6) >> 1; dsh = 2 * g; base = ZO_A + (size_t)(((which * 3 + g) * 4 + 2 * (pn & 1)) * 2) * 8192 * 128; rs = 128; bjs = 2 * 8192 * 128; }
        else if (pn < 22) { base = (pn < 20 ? ZO_RQ : ZO_RK) + (size_t)(2 * (pn & 1)) * NP * 128; rs = 128; bjs = NP * 128; }
        else if (pn < 30) { base = (pn < 26 ? ZO_RV + (size_t)(pn - 22) * NP * 256 : ZO_GR + (size_t)(pn - 26) * NP * 256); rs = 256; bjs = 128; }
        else { base = (pn < 34 ? ZO_GA + (size_t)(pn - 30) * 256 : ZO_GB + (size_t)(pn - 34) * 256); rs = 1024; bjs = 128; }
        const int row0 = u.pm * 256 + wr * 64 + fr, dim = wc * 32 + 8 * fq, col0 = pn * 256 + dim;
#pragma unroll
        for (int bj = 0; bj < 2; ++bj) {
            f32x4 b0 = {0.f, 0.f, 0.f, 0.f}, b1 = {0.f, 0.f, 0.f, 0.f};
            if (gate) { b0 = *(const f32x4*)(bg + (col0 + bj * 128 - C_GA)); b1 = *(const f32x4*)(bg + (col0 + bj * 128 - C_GA) + 4); }
#pragma unroll
            for (int ai = 0; ai < 2; ++ai)
#pragma unroll
                for (int m = 0; m < 4; ++m) { f32x4 v0 = acc[ai][bj][m][0], v1 = acc[ai][bj][m][1];
                    if (gate) { v0[0] = sigmoidf_(v0[0] + b0[0]); v0[1] = sigmoidf_(v0[1] + b0[1]); v0[2] = sigmoidf_(v0[2] + b0[2]); v0[3] = sigmoidf_(v0[3] + b0[3]);
                                v1[0] = sigmoidf_(v1[0] + b1[0]); v1[1] = sigmoidf_(v1[1] + b1[1]); v1[2] = sigmoidf_(v1[2] + b1[2]); v1[3] = sigmoidf_(v1[3] + b1[3]); }
                    u32x4 w; w.x = pkbf(v0[0], v0[1]); w.y = pkbf(v0[2], v0[3]); w.z = pkbf(v1[0], v1[1]); w.w = pkbf(v1[2], v1[3]);
                    const int row = row0 + ai * 128 + m * 16, t = row & 8191, rt = (row & ~8191) + ((t & ((1 << dsh) - 1)) << (13 - dsh)) + (t >> dsh);
                    *(u32x4*)(Z + base + (size_t)rt * rs + bj * bjs + dim) = w; } }
    }
};
struct QGateA { static constexpr bool FENCE = true; const bf16_t* Z; float* M1;
    typedef u32x2 L;
    __device__ __forceinline__ L load(int row, int col) const { return *(const u32x2*)(row < NP ? Z + ZO_GA + (size_t)row * 1024 + col : Z + (size_t)row * INC + C_GA + col); }
    __device__ __forceinline__ void fin(int row, int col, f32x4 v, L g) const { u32x2 o; o.x = pkbf(bflo(g.x) * v[0], bfhi(g.x) * v[1]); o.y = pkbf(bflo(g.y) * v[2], bfhi(g.y) * v[3]); *(u32x2*)((bf16_t*)M1 + (size_t)row * DM + col) = o; }
    __device__ __forceinline__ void quad(int row, int col, f32x4 v) const { fin(row, col, v, load(row, col)); } };
struct QGateB { static constexpr bool FENCE = true; const bf16_t* Z; const float* M1; bf16_t* MX;
    struct L { u32x2 g; u32x2 m; };
    __device__ __forceinline__ L load(int row, int col) const { L l; l.g = *(const u32x2*)(row < NP ? Z + ZO_GB + (size_t)row * 1024 + col : Z + (size_t)row * INC + C_GB + col); l.m = *(const u32x2*)((const bf16_t*)M1 + (size_t)row * DM + col); return l; }
    __device__ __forceinline__ void fin(int row, int col, f32x4 v, L l) const { u32x2 w; w.x = pkbf(bflo(l.m.x) + bflo(l.g.x) * v[0], bfhi(l.m.x) + bfhi(l.g.x) * v[1]); w.y = pkbf(bflo(l.m.y) + bflo(l.g.y) * v[2], bfhi(l.m.y) + bfhi(l.g.y) * v[3]); *(u32x2*)(MX + (size_t)row * DM + col) = w; }
    __device__ __forceinline__ void quad(int row, int col, f32x4 v) const { fin(row, col, v, load(row, col)); } };
struct QRes { static constexpr bool FENCE = true; const float* Xp; const float* Xs; float* X;
    typedef f32x4 L;
    __device__ __forceinline__ L load(int row, int col) const { return *(const f32x4*)(row < NP ? Xp + (size_t)row * DM + col : Xs + (size_t)(row - NP) * DM + col); }
    __device__ __forceinline__ void fin(int row, int col, f32x4 v, L x) const { *(f32x4*)(X + (size_t)row * DM + col) = x + v; }
    __device__ __forceinline__ void quad(int row, int col, f32x4 v) const { fin(row, col, v, load(row, col)); } };
struct QKey { static constexpr bool FENCE = false; int* SC;
    __device__ __forceinline__ void quad(int row, int col, f32x4 v) const {
        i32x4 k; const int kb = 127 - (col & 127);
        k[0] = (sortable(v[0]) & ~127) | kb; k[1] = (sortable(v[1]) & ~127) | (kb - 1); k[2] = (sortable(v[2]) & ~127) | (kb - 2); k[3] = (sortable(v[3]) & ~127) | (kb - 3);
        *(i32x4*)(SC + ((size_t)(row >> 4) * 512 + (col >> 2)) * 64 + (row & 15) * 4) = k; } };

template <class Q> __device__ __forceinline__ void skinny(const bf16_t* Hs, const bf16_t* Bt, int N, int K, const Q& q, int gw, int nw, int lane_) {
    int lane = lane_; asm volatile("" : "+v"(lane));
    const int fr = lane & 15, fq = lane >> 4;
    for (int t = gw; t < (N >> 3); t += nw) { const int ct = t >> 1, rh = t & 1;
        f32x4 a0 = {0.f, 0.f, 0.f, 0.f};
        const bf16_t* bp = Bt + (size_t)(ct * 16 + fr) * K + fq * 8; const bf16_t* h0 = Hs + (size_t)(rh * 16 + fr) * K + fq * 8;
        bf16x8 wa[8], xa[8], wb[8], xb[8];
#pragma unroll
        for (int j = 0; j < 8; ++j) { wa[j] = *(const bf16x8*)(bp + 32 * j); xa[j] = *(const bf16x8*)(h0 + 32 * j); }
#pragma unroll
        for (int c = 0; c < K / 256; ++c) {
            if (c + 1 < K / 256) {
#pragma unroll
                for (int j = 0; j < 8; ++j) { const bf16x8 tw = *(const bf16x8*)(bp + 256 * (c + 1) + 32 * j), tx = *(const bf16x8*)(h0 + 256 * (c + 1) + 32 * j); if (c & 1) { wa[j] = tw; xa[j] = tx; } else { wb[j] = tw; xb[j] = tx; } } }
            __builtin_amdgcn_sched_barrier(0);
#pragma unroll
            for (int j = 0; j < 8; ++j) a0 = (c & 1) ? mfma16(wb[j], xb[j], a0) : mfma16(wa[j], xa[j], a0);
            __builtin_amdgcn_sched_barrier(0);
        }
        q.quad(NP + rh * 16 + fr, ct * 16 + 4 * fq, a0);
    }
}
template <class Q> __device__ __forceinline__ void skinny8(const bf16_t* Hs, const bf16_t* Bt, int N, int K, const Q& q, int ublk, int nblk, int w, int lane_, LAS unsigned char* lds) {
    int lane = lane_; asm volatile("" : "+v"(lane));
    const int fr = lane & 15, fq = lane >> 4; LAS f32x4* part = (LAS f32x4*)lds;
    for (int t = ublk; t < (N >> 3); t += nblk) { const int ct = t >> 1, rh = t & 1, ks = K >> 3;
        const bf16_t* bp = Bt + (size_t)(ct * 16 + fr) * K + w * ks + fq * 8; const bf16_t* h0 = Hs + (size_t)(rh * 16 + fr) * K + w * ks + fq * 8;
        bf16x8 wv[4], xv[4];
#pragma unroll
        for (int j = 0; j < 4; ++j) if (j < K / 256) { wv[j] = *(const bf16x8*)(bp + 32 * j); xv[j] = *(const bf16x8*)(h0 + 32 * j); }
        __builtin_amdgcn_sched_barrier(0);
        f32x4 a0 = {0.f, 0.f, 0.f, 0.f};
#pragma unroll
        for (int j = 0; j < 4; ++j) if (j < K / 256) a0 = mfma16(wv[j], xv[j], a0);
        __syncthreads();
        part[w * 64 + lane] = a0;
        __syncthreads();
        if (w == 0) { f32x4 a = part[lane];
#pragma unroll
            for (int ww = 1; ww < 8; ++ww) a += part[ww * 64 + lane];
            q.quad(NP + rh * 16 + fr, ct * 16 + 4 * fq, a); }
        __syncthreads();
    }
}

__device__ __forceinline__ void tconv_tile(const float* src, int K, int N, bf16_t* dst, int tile, LAS float* T, int tid) {
    const int ntn = N >> 6, tk = tile / ntn, tn = tile - tk * ntn, k0 = tk * 64, n0 = tn * 64;
#pragma unroll
    for (int i = 0; i < 2; ++i) { const int idx = tid + 512 * i, kr = idx >> 4, c4 = idx & 15; const float4 v = *(const float4*)(src + (size_t)(k0 + kr) * N + n0 + c4 * 4);
        LAS float* t = T + kr * 65 + c4 * 4; t[0] = v.x; t[1] = v.y; t[2] = v.z; t[3] = v.w; }
    __syncthreads();
    { const int n = tid >> 3, kq = tid & 7; float f[8];
#pragma unroll
      for (int i = 0; i < 8; ++i) f[i] = T[(kq * 8 + i) * 65 + n];
      u32x4 w; w.x = pkbf(f[0], f[1]); w.y = pkbf(f[2], f[3]); w.z = pkbf(f[4], f[5]); w.w = pkbf(f[6], f[7]);
      *(u32x4*)(dst + (size_t)(n0 + n) * K + k0 + kq * 8) = w; }
    __syncthreads();
}
__device__ __forceinline__ void wts_unit(const float* pwq, const float* sk, bf16_t* WtS, int hp, int dt, LAS float* skc, LAS float* pwc, int tid) {
    const int p = hp & 1, d0 = dt * 64;
#pragma unroll
    for (int i = 0; i < 8; ++i) { const int idx = tid + 512 * i, k = idx >> 5, c4 = idx & 31; const float4 v = *(const float4*)(sk + (size_t)(p * 128 + k) * 128 + c4 * 4);
        skc[(c4 * 4 + 0) * 132 + k] = v.x; skc[(c4 * 4 + 1) * 132 + k] = v.y; skc[(c4 * 4 + 2) * 132 + k] = v.z; skc[(c4 * 4 + 3) * 132 + k] = v.w; }
#pragma unroll
    for (int i = 0; i < 4; ++i) { const int idx = tid + 512 * i, d = idx >> 5, c4 = idx & 31; const float4 v = *(const float4*)(pwq + (size_t)(d0 + d) * 2048 + hp * 128 + c4 * 4);
        pwc[(c4 * 4 + 0) * 68 + d] = v.x; pwc[(c4 * 4 + 1) * 68 + d] = v.y; pwc[(c4 * 4 + 2) * 68 + d] = v.z; pwc[(c4 * 4 + 3) * 68 + d] = v.w; }
    __syncthreads();
    const int tk = tid & 31, td = tid >> 5;
    float acc[4][4];
#pragma unroll
    for (int i = 0; i < 4; ++i)
#pragma unroll
        for (int j = 0; j < 4; ++j) acc[i][j] = 0.f;
#pragma unroll 4
    for (int c = 0; c < 128; ++c) { const f32x4 a = *(const LAS f32x4*)(skc + c * 132 + tk * 4); const f32x4 b = *(const LAS f32x4*)(pwc + c * 68 + td * 4);
#pragma unroll
        for (int i = 0; i < 4; ++i)
#pragma unroll
            for (int j = 0; j < 4; ++j) acc[i][j] += a[i] * b[j]; }
#pragma unroll
    for (int i = 0; i < 4; ++i) { u32x2 w; w.x = pkbf(acc[i][0], acc[i][1]); w.y = pkbf(acc[i][2], acc[i][3]); *(u32x2*)(WtS + (size_t)(hp * 128 + tk * 4 + i) * DM + d0 + td * 4) = w; }
    __syncthreads();
}
#ifndef MK_FP6_IL
#define MK_FP6_IL 1
#endif
__device__ __forceinline__ void conv_tables(const Params& P, int layer, int gw, int nw, int lane) {
    unsigned char* ws = P.ws; const int hl = lane & 31, up = lane >> 5; float* tsc = (float*)(ws + WS_TSC);
    for (int r0 = gw * 4; r0 < 2 * 16384; r0 += nw * 4) {
        float4 v[2][8];
#pragma unroll
        for (int k = 0; k < 2; ++k) { const int q = r0 + 2 * k + up, tb = q >> 14, rr = layer * 16384 + (q & 16383); const float* src = P.in[18 + tb] + (size_t)rr * DM + hl * 32;
#pragma unroll
            for (int j = 0; j < 8; ++j) v[k][j] = *(const float4*)(src + 4 * j); }
#pragma unroll
        for (int k = 0; k < 2; ++k) { const int q = r0 + 2 * k + up, tb = q >> 14, rr = layer * 16384 + (q & 16383), r = tb * 32768 + rr; float m = 0.f;
#pragma unroll
            for (int j = 0; j < 8; ++j) m = fmaxf(m, fmaxf(fmaxf(fabsf(v[k][j].x), fabsf(v[k][j].y)), fmaxf(fabsf(v[k][j].z), fabsf(v[k][j].w))));
#pragma unroll
            for (int o = 1; o < 32; o <<= 1) m = fmaxf(m, shx(m, o));
            float s = 1.f; if (m > 1e-30f) s = __uint_as_float(__float_as_uint(7.5f / m) & 0x7f800000u);
            float e[32];
#pragma unroll
            for (int j = 0; j < 8; ++j) { e[4 * j] = v[k][j].x * s; e[4 * j + 1] = v[k][j].y * s; e[4 * j + 2] = v[k][j].z * s; e[4 * j + 3] = v[k][j].w * s; }
            f32x16 xa, xb;
#pragma unroll
            for (int i = 0; i < 16; ++i) { xa[i] = MK_FP6_IL ? e[2 * i] : e[i]; xb[i] = MK_FP6_IL ? e[2 * i + 1] : e[16 + i]; }
            u32x6 p = __builtin_amdgcn_cvt_scalef32_2xpk16_fp6_f32(xa, xb, 1.0f);
            unsigned char* dst = ws + (tb ? WS_VBF : WS_UBF) + (size_t)rr * 768;
            *(u32x4*)(dst + hl * 16) = (u32x4){p[0], p[1], p[2], p[3]}; *(u32x2*)(dst + 512 + hl * 8) = (u32x2){p[4], p[5]};
            if (hl == 0) tsc[r] = 1.f / s; } }
}
__device__ __forceinline__ void p0_prologue(const Params& P, LAS unsigned char* lds, int tid, int bid, int G) {
    unsigned char* ws = P.ws;
    for (int u = bid; u < NLAYER * 3072; u += G) {
        const int l = u / 3072, t = u - l * 3072;
        if (t < 2432) tconv_tile(P.in[8] + (size_t)l * DM * INC, DM, INC, (bf16_t*)(ws + WS_WTIN + l * SZ_WTIN), t, (LAS float*)lds, tid);
        else if (t < 2560) tconv_tile(P.in[12] + (size_t)l * 512 * DM, 512, DM, (bf16_t*)(ws + WS_WTOA + l * SZ_WTOA), t - 2432, (LAS float*)lds, tid);
        else if (t < 2816) tconv_tile(P.in[13] + (size_t)l * DM * DM, DM, DM, (bf16_t*)(ws + WS_WTOR + l * SZ_WSQ), t - 2560, (LAS float*)lds, tid);
        else tconv_tile(P.in[14] + (size_t)l * DM * DM, DM, DM, (bf16_t*)(ws + WS_WTOUT + l * SZ_WSQ), t - 2816, (LAS float*)lds, tid);
    }
    for (int u = bid; u < NLAYER * 256; u += G) {
        const int l = u >> 8, r = u & 255, hp = r >> 4, dt = r & 15;
        wts_unit(P.in[16] + (size_t)l * DM * 2048, P.in[17] + (size_t)l * 2 * 128 * 128, (bf16_t*)(ws + WS_WTS + l * SZ_WTS), hp, dt, (LAS float*)lds, (LAS float*)(lds + 128 * 132 * 4), tid);
    }
    if (bid == 0) { float* bt = (float*)(ws + WS_BT); for (int idx = tid; idx < 12 * 132; idx += 512) { const int gj = idx / 132, m = idx - gj * 132, g = gj >> 2, j = gj & 3;
        bt[idx] = m <= 128 ? P.in[6][(int)P.bucket[g][m] * 12 + g * 4 + j] : 0.f; } }
    { float2* cs = (float2*)(ws + WS_CS);
      for (int idx = bid * 512 + tid; idx < 8193 * 64; idx += G * 512) { const int pi = idx >> 6, i = idx & 63; const float pos = pi == 8192 ? 16384.f : (float)pi;
        const float th = pos * P.ang[i]; const double td = (double)th; const double kq = rint(td * 0.15915494309189535); const float rf = (float)(td - kq * 6.283185307179586);
        cs[idx] = make_float2(cosf(rf), sinf(rf)); } }
    { const int lane = tid & 63, gw = bid * 8 + (tid >> 6), nw = G * 8; bf16_t* H = (bf16_t*)(ws + WS_H); const float* nw1 = P.in[7];
      float4 wv[4];
#pragma unroll
      for (int j = 0; j < 4; ++j) wv[j] = *(const float4*)(nw1 + j * 256 + lane * 4);
      for (int row0 = gw * 2; row0 < NR; row0 += nw * 2) {
        float4 v[2][4];
#pragma unroll
        for (int k = 0; k < 2; ++k) { const int row = row0 + k; const float* x = row < NP ? P.in[0] + (size_t)row * DM : P.in[1] + (size_t)(row - NP) * DM;
#pragma unroll
            for (int j = 0; j < 4; ++j) v[k][j] = *(const float4*)(x + j * 256 + lane * 4); }
        __builtin_amdgcn_sched_barrier(0);
#pragma unroll
        for (int k = 0; k < 2; ++k) { const int row = row0 + k; float ss = 0.f;
#pragma unroll
            for (int j = 0; j < 4; ++j) ss += v[k][j].x * v[k][j].x + v[k][j].y * v[k][j].y + v[k][j].z * v[k][j].z + v[k][j].w * v[k][j].w;
            const float rstd = rsqrtf(wsum64(ss) * (1.f / 1024.f) + EPS);
#pragma unroll
            for (int j = 0; j < 4; ++j) { const float4 w = wv[j];
                u32x2 o; o.x = pkbf(v[k][j].x * rstd * w.x, v[k][j].y * rstd * w.y); o.y = pkbf(v[k][j].z * rstd * w.z, v[k][j].w * rstd * w.w); *(u32x2*)(H + (size_t)row * DM + j * 256 + lane * 4) = o; } } } }
}

struct AttnRaw { u32x4 kr[8], vr[8]; bf16x8 q[4]; float4 kw0, kw1; float bias, qw; };
struct AttnIdx { int g, j, b, d, r, blk, i0; size_t rowbase; };
__device__ __forceinline__ AttnIdx attn_decode(int u) { AttnIdx a; a.g = u >> 9; const int rem = u & 511; a.j = rem & 3; const int sb = rem >> 2; a.b = sb >> 6; const int x = sb & 63, dsh = 2 * a.g;
    a.d = 1 << dsh; a.r = x >> (6 - dsh); a.blk = x & ((64 >> dsh) - 1); a.rowbase = (size_t)a.b * 8192 + a.r; a.i0 = a.blk * 128; return a; }
__device__ __forceinline__ void attn_load(const __amdgpu_buffer_rsrc_t Zr, const float* qn, const float* kn, const float* BT, const AttnIdx& a, AttnRaw& R, int tid, int w, int fr, int fq) {
    const int dsh = 2 * a.g, sub0 = (a.r << (13 - dsh)) + a.i0;
    const int hk = ((((1 * 3 + a.g) * 4 + a.j) * 2 + a.b) * 8192) * 128, hv = ((((2 * 3 + a.g) * 4 + a.j) * 2 + a.b) * 8192) * 128, hq = ((((0 * 3 + a.g) * 4 + a.j) * 2 + a.b) * 8192) * 128;
#pragma unroll
    for (int c = 0; c < 8; ++c) { const int id = tid + 512 * c, kk = id >> 4, ch = id & 15; int i = a.i0 - 128 + kk; i = i < 0 ? 0 : i;
        const int ro = (((a.r << (13 - dsh)) + i) * 128 + ch * 8); R.kr[c] = __builtin_amdgcn_raw_buffer_load_b128(Zr, (hk + ro) * 2, 0, 0); R.vr[c] = __builtin_amdgcn_raw_buffer_load_b128(Zr, (hv + ro) * 2, 0, 0); }
    { const float* kwp = kn + a.g * 128 + (tid & 15) * 8; R.kw0 = *(const float4*)kwp; R.kw1 = *(const float4*)(kwp + 4); R.bias = BT[(a.g * 4 + a.j) * 132 + (tid < 132 ? tid : 0)]; R.qw = qn[a.g * 128 + (tid & 127)]; }
    const int qoff = (hq + (sub0 + 16 * w + fr) * 128 + fq * 8) * 2;
#pragma unroll
    for (int s = 0; s < 4; ++s) R.q[s] = __builtin_bit_cast(bf16x8, __builtin_amdgcn_raw_buffer_load_b128(Zr, qoff + 64 * s, 0, 0));
}
__device__ __forceinline__ int attn_map(int d) { return (d & 7) * 192 + (d >> 3); }
__device__ __forceinline__ void attn_phase(const Params& P, int l, const bf16_t* Z, bf16_t* OG, float* LSE, LAS unsigned char* lds, int tid_in, int bid, int G) {
    const int w = __builtin_amdgcn_readfirstlane(tid_in >> 6);
    LAS unsigned char* Ks = lds; LAS unsigned char* Vs = lds + 65536; LAS float* biasv = (LAS float*)(lds + 131072);
    const __amdgpu_buffer_rsrc_t Zr = __builtin_amdgcn_make_buffer_rsrc((void*)Z, 0, (int)((size_t)NR * INC * 2), 0x00020000);
    AttnRaw R; int u = bid;
    const float* qn = P.in[10] + l * 384; const float* kn = P.in[11] + l * 384; const float* BT = (const float*)(P.ws + WS_BT); LAS float* qwl = (LAS float*)(lds + 131072 + 1024);
    if (u < 1536) { const int l0 = tid_in & 63; attn_load(Zr, qn, kn, BT, attn_decode(attn_map(u)), R, tid_in, w, l0 & 15, l0 >> 4); }
    for (; u < 1536; u += G) {
        int lane; asm volatile("v_mbcnt_lo_u32_b32 %0, -1, 0\n\tv_mbcnt_hi_u32_b32 %0, -1, %0" : "=v"(lane));
        const int tid = w * 64 + lane, fr = lane & 15, fq = lane >> 4, q4 = fr >> 2, p4 = fr & 3;
        const AttnIdx a = attn_decode(attn_map(u)); const int g = a.g, j = a.j, blk = a.blk;
        { const int ch = tid & 15; const float4 kw0 = R.kw0, kw1 = R.kw1;
          const int keep = 128 << (2 * g); float* kvb = P.out + (g == 0 ? O_KV1P : (g == 1 ? O_KV4P : O_KV16P)) + (size_t)(l * 2 + a.b) * keep * 1024 + j * 128 + ch * 8;
#pragma unroll
          for (int c = 0; c < 8; ++c) { const int id = tid + 512 * c, kk = id >> 4; const u32x4 raw = R.kr[c];
            float f[8] = {bflo(raw.x), bfhi(raw.x), bflo(raw.y), bfhi(raw.y), bflo(raw.z), bfhi(raw.z), bflo(raw.w), bfhi(raw.w)};
            float ss = 0.f;
#pragma unroll
            for (int i = 0; i < 8; ++i) ss += f[i] * f[i];
            ss += shx(ss, 1); ss += shx(ss, 2); ss += shx(ss, 4); ss += shx(ss, 8);
            const float rstd = rsqrtf(ss * (1.f / 128.f) + EPS);
            f[0] *= rstd * kw0.x; f[1] *= rstd * kw0.y; f[2] *= rstd * kw0.z; f[3] *= rstd * kw0.w; f[4] *= rstd * kw1.x; f[5] *= rstd * kw1.y; f[6] *= rstd * kw1.z; f[7] *= rstd * kw1.w;
            u32x4 o; o.x = pkbf(f[0], f[1]); o.y = pkbf(f[2], f[3]); o.z = pkbf(f[4], f[5]); o.w = pkbf(f[6], f[7]);
            *(LAS u32x4*)(Ks + offb(kk, ch)) = o; *(LAS u32x4*)(Vs + offb(kk, ch)) = R.vr[c];
            if (c >= 4) { const int tt = a.r + a.d * (a.i0 - 128 + kk) - (8192 - keep);
                if (tt >= 0) { float* d = kvb + (size_t)tt * 1024; const u32x4 vr = R.vr[c];
                    *(float4*)d = make_float4(f[0], f[1], f[2], f[3]); *(float4*)(d + 4) = make_float4(f[4], f[5], f[6], f[7]);
                    *(float4*)(d + 512) = make_float4(bflo(vr.x), bfhi(vr.x), bflo(vr.y), bfhi(vr.y)); *(float4*)(d + 516) = make_float4(bflo(vr.z), bfhi(vr.z), bflo(vr.w), bfhi(vr.w)); } }
            __builtin_amdgcn_sched_barrier(0); } }
        if (tid < 132) biasv[tid] = R.bias;
        if (tid < 128) qwl[tid] = R.qw;
        const size_t qrow = a.rowbase + (size_t)a.d * (a.i0 + 16 * w + fr);
        __syncthreads();
        bf16x8 Qf[4];
        { float ss = 0.f; float qf[4][8];
#pragma unroll
          for (int s = 0; s < 4; ++s) { const u32x4 r4 = __builtin_bit_cast(u32x4, R.q[s]); qf[s][0] = bflo(r4.x); qf[s][1] = bfhi(r4.x); qf[s][2] = bflo(r4.y); qf[s][3] = bfhi(r4.y); qf[s][4] = bflo(r4.z); qf[s][5] = bfhi(r4.z); qf[s][6] = bflo(r4.w); qf[s][7] = bfhi(r4.w);
#pragma unroll
              for (int i = 0; i < 8; ++i) ss += qf[s][i] * qf[s][i]; }
          ss += shx(ss, 16); ss += shx(ss, 32);
          const float rstd = rsqrtf(ss * (1.f / 128.f) + EPS) * P.rsq128; const LAS float* qwp = qwl + fq * 8;
#pragma unroll
          for (int s = 0; s < 4; ++s) { const f32x4 w0 = *(const LAS f32x4*)(qwp + 32 * s), w1 = *(const LAS f32x4*)(qwp + 32 * s + 4); u32x4 o;
              o.x = pkbf(qf[s][0] * rstd * w0[0], qf[s][1] * rstd * w0[1]); o.y = pkbf(qf[s][2] * rstd * w0[2], qf[s][3] * rstd * w0[3]); o.z = pkbf(qf[s][4] * rstd * w1[0], qf[s][5] * rstd * w1[1]); o.w = pkbf(qf[s][6] * rstd * w1[2], qf[s][7] * rstd * w1[3]);
              Qf[s] = __builtin_bit_cast(bf16x8, o); } }
        { int un = u + G; asm volatile("" : "+s"(un));
          if (un < 1536) attn_load(Zr, qn, kn, BT, attn_decode(attn_map(un)), R, tid, w, fr, fq); }
        f32x4 sa[9];
#pragma unroll
        for (int ti = 0; ti < 9; ++ti) { sa[ti] = (f32x4){0.f, 0.f, 0.f, 0.f}; const int kt = w + ti;
#pragma unroll
            for (int s = 0; s < 4; ++s) { const bf16x8 kf = *(const LAS bf16x8*)(Ks + offb(16 * kt + fr, 4 * s + fq)); sa[ti] = mfma16(kf, Qf[s], sa[ti]); }
            if (ti & 1) __builtin_amdgcn_sched_barrier(0); }
        float mx = -3.0e38f;
#pragma unroll
        for (int ti = 0; ti < 9; ++ti)
#pragma unroll
            for (int e = 0; e < 4; ++e) { const int kk = 16 * (w + ti) + 4 * fq + e, m = 128 + fr - 16 * ti - 4 * fq - e; const bool ok = (m >= 0) && (m <= 128) && (blk > 0 || kk >= 128);
                const int mc = m < 0 ? 0 : (m > 128 ? 128 : m); const float bv = biasv[mc]; float sv = sa[ti][e] + bv; sv = ok ? sv : -1.0e30f; sa[ti][e] = sv; mx = fmaxf(mx, sv); }
        mx = fmaxf(mx, shx(mx, 16)); mx = fmaxf(mx, shx(mx, 32));
        float sum = 0.f;
#pragma unroll
        for (int ti = 0; ti < 9; ++ti)
#pragma unroll
            for (int e = 0; e < 4; ++e) { const float pe = __expf(sa[ti][e] - mx); sa[ti][e] = pe; sum += pe; }
        sum += shx(sum, 16); sum += shx(sum, 32);
        f32x4 oa[8];
#pragma unroll
        for (int c = 0; c < 8; ++c) oa[c] = (f32x4){0.f, 0.f, 0.f, 0.f};
#pragma unroll
        for (int ks = 0; ks < 5; ++ks) { const int T0 = 2 * ks, T1 = 2 * ks + 1;
            const f32x4 z4 = {0.f, 0.f, 0.f, 0.f}; const bf16x8 Pb = pack8(sa[T0], T1 < 9 ? sa[T1] : z4);
            const int rb0 = 16 * (w + T0) + 4 * fq; int rb1 = 16 * (w + T1) + 4 * fq; rb1 = rb1 > 252 ? 252 : rb1;
#pragma unroll
            for (int c = 0; c < 8; ++c) { const s16x4 a0 = trr(Vs + offb(rb0 + q4, 2 * c + (p4 >> 1)) + 8 * (p4 & 1)); const s16x4 a1 = trr(Vs + offb(rb1 + q4, 2 * c + (p4 >> 1)) + 8 * (p4 & 1));
                oa[c] = mfma16(cat4(a0, a1), Pb, oa[c]); }
            __builtin_amdgcn_sched_barrier(0); }
        const float inv = 1.f / sum; bf16_t* orow = OG + ((size_t)g * NR + qrow) * 512 + j * 128;
#pragma unroll
        for (int c = 0; c < 8; ++c) { u32x2 o; o.x = pkbf(oa[c][0] * inv, oa[c][1] * inv); o.y = pkbf(oa[c][2] * inv, oa[c][3] * inv); *(u32x2*)(orow + 16 * c + 4 * fq) = o; }
        if (fq == 0) LSE[((size_t)g * NR + qrow) * 4 + j] = mx + __logf(sum);
        __syncthreads();
    }
}

__device__ __forceinline__ void sattn_unit(const Params& P, int l, const bf16_t* Z, bf16_t* OG, float* LSE, int u, LAS unsigned char* lds, int tid) {
    const int lane = tid & 63, w = __builtin_amdgcn_readfirstlane(tid >> 6);
    const int b = u / 3, g = u - b * 3, d = 1 << (2 * g), lg = 128 * d;
    const float* cache = P.in[2 + g] + ((size_t)(l * 32 + b) * lg) * 1024;
    const bf16_t* zr = Z + (size_t)(NP + b) * INC;
    LAS float* sc = (LAS float*)lds;
    LAS float* st = (LAS float*)(lds + 2112);
    LAS float* part = (LAS float*)(lds + 4096);
    float q[8];
    { const u32x2 a = *(const u32x2*)(zr + C_QA + g * 512 + lane * 4), c = *(const u32x2*)(zr + C_QA + g * 512 + 256 + lane * 4);
      q[0] = bflo(a.x); q[1] = bfhi(a.x); q[2] = bflo(a.y); q[3] = bfhi(a.y); q[4] = bflo(c.x); q[5] = bfhi(c.x); q[6] = bflo(c.y); q[7] = bfhi(c.y);
      float s1 = q[0] * q[0] + q[1] * q[1] + q[2] * q[2] + q[3] * q[3], s2 = q[4] * q[4] + q[5] * q[5] + q[6] * q[6] + q[7] * q[7];
#pragma unroll
      for (int o = 1; o < 32; o <<= 1) { s1 += shx(s1, o); s2 += shx(s2, o); }
      const float r1 = rsqrtf(s1 * (1.f / 128.f) + EPS) * P.rsq128, r2 = rsqrtf(s2 * (1.f / 128.f) + EPS) * P.rsq128;
      const float4 wq = *(const float4*)(P.in[10] + (l * 3 + g) * 128 + (lane & 31) * 4);
      q[0] = tobf1f(q[0] * r1 * wq.x); q[1] = tobf1f(q[1] * r1 * wq.y); q[2] = tobf1f(q[2] * r1 * wq.z); q[3] = tobf1f(q[3] * r1 * wq.w);
      q[4] = tobf1f(q[4] * r2 * wq.x); q[5] = tobf1f(q[5] * r2 * wq.y); q[6] = tobf1f(q[6] * r2 * wq.z); q[7] = tobf1f(q[7] * r2 * wq.w); }
    if (w == 0) {
        float k[8];
        { const u32x2 a = *(const u32x2*)(zr + C_KA + g * 512 + lane * 4), c = *(const u32x2*)(zr + C_KA + g * 512 + 256 + lane * 4);
            k[0] = bflo(a.x); k[1] = bfhi(a.x); k[2] = bflo(a.y); k[3] = bfhi(a.y); k[4] = bflo(c.x); k[5] = bfhi(c.x); k[6] = bflo(c.y); k[7] = bfhi(c.y);
            float t1 = k[0] * k[0] + k[1] * k[1] + k[2] * k[2] + k[3] * k[3], t2 = k[4] * k[4] + k[5] * k[5] + k[6] * k[6] + k[7] * k[7];
#pragma unroll
            for (int o = 1; o < 32; o <<= 1) { t1 += shx(t1, o); t2 += shx(t2, o); }
            const float r1 = rsqrtf(t1 * (1.f / 128.f) + EPS), r2 = rsqrtf(t2 * (1.f / 128.f) + EPS); const float4 wk = *(const float4*)(P.in[11] + (l * 3 + g) * 128 + (lane & 31) * 4);
            k[0] *= r1 * wk.x; k[1] *= r1 * wk.y; k[2] *= r1 * wk.z; k[3] *= r1 * wk.w; k[4] *= r2 * wk.x; k[5] *= r2 * wk.y; k[6] *= r2 * wk.z; k[7] *= r2 * wk.w;
            float* kvd = P.out + (g == 0 ? O_KV1S : (g == 1 ? O_KV4S : O_KV16S)) + (size_t)(l * 32 + b) * 1024;
            *(float4*)(kvd + lane * 4) = make_float4(k[0], k[1], k[2], k[3]); *(float4*)(kvd + 256 + lane * 4) = make_float4(k[4], k[5], k[6], k[7]);
            const u32x2 va = *(const u32x2*)(zr + C_VA + g * 512 + lane * 4), vc = *(const u32x2*)(zr + C_VA + g * 512 + 256 + lane * 4);
            *(float4*)(kvd + 512 + lane * 4) = make_float4(bflo(va.x), bfhi(va.x), bflo(va.y), bfhi(va.y)); *(float4*)(kvd + 768 + lane * 4) = make_float4(bflo(vc.x), bfhi(vc.x), bflo(vc.y), bfhi(vc.y));
#pragma unroll
            for (int i = 0; i < 8; ++i) k[i] = tobf1f(k[i]); }
        float s1 = q[0] * k[0] + q[1] * k[1] + q[2] * k[2] + q[3] * k[3], s2 = q[4] * k[4] + q[5] * k[5] + q[6] * k[6] + q[7] * k[7];
#pragma unroll
        for (int o = 1; o < 32; o <<= 1) { s1 += shx(s1, o); s2 += shx(s2, o); }
        if ((lane & 31) == 0) { const int h0 = lane >> 5; sc[h0 * 132] = s1; sc[(2 + h0) * 132] = s2; }
    }
#pragma unroll 1
    for (int half = 0; half < 2; ++half) {
        float4 ka[8], kb[8];
#pragma unroll
        for (int i = 0; i < 8; ++i) { const int jj = 1 + w + 8 * (half * 8 + i); const float* kp = cache + (size_t)(lg - jj * d) * 1024; ka[i] = *(const float4*)(kp + lane * 4); kb[i] = *(const float4*)(kp + 256 + lane * 4); }
#pragma unroll
        for (int i = 0; i < 8; ++i) { const int jj = 1 + w + 8 * (half * 8 + i);
            float s1 = q[0] * ka[i].x + q[1] * ka[i].y + q[2] * ka[i].z + q[3] * ka[i].w, s2 = q[4] * kb[i].x + q[5] * kb[i].y + q[6] * kb[i].z + q[7] * kb[i].w;
#pragma unroll
            for (int o = 1; o < 32; o <<= 1) { s1 += shx(s1, o); s2 += shx(s2, o); }
            if ((lane & 31) == 0) { const int h0 = lane >> 5; sc[h0 * 132 + jj] = s1; sc[(2 + h0) * 132 + jj] = s2; } }
    }
    __syncthreads();
    if (w < 4) { const float* btg = (const float*)(P.ws + WS_BT) + (g * 4 + w) * 132;
        const float v0 = sc[w * 132 + lane] + btg[lane], v1 = sc[w * 132 + 64 + lane] + btg[64 + lane], v2 = lane == 0 ? sc[w * 132 + 128] + btg[128] : -3.0e38f;
        float mx = fmaxf(fmaxf(v0, v1), v2);
#pragma unroll
        for (int o = 1; o < 64; o <<= 1) mx = fmaxf(mx, shx(mx, o));
        const float e0 = __expf(v0 - mx), e1 = __expf(v1 - mx), e2 = lane == 0 ? __expf(v2 - mx) : 0.f;
        sc[w * 132 + lane] = e0; sc[w * 132 + 64 + lane] = e1; if (lane == 0) sc[w * 132 + 128] = e2;
        const float sm = wsum64(e0 + e1 + e2);
        if (lane == 0) { st[w] = mx; st[4 + w] = sm; } }
    __syncthreads();
    float acc[8];
#pragma unroll
    for (int i = 0; i < 8; ++i) acc[i] = 0.f;
    if (w == 0) { const u32x2 a = *(const u32x2*)(zr + C_VA + g * 512 + lane * 4), c = *(const u32x2*)(zr + C_VA + g * 512 + 256 + lane * 4);
        const float p1 = sc[(lane >> 5) * 132], p2 = sc[(2 + (lane >> 5)) * 132];
        acc[0] += p1 * bflo(a.x); acc[1] += p1 * bfhi(a.x); acc[2] += p1 * bflo(a.y); acc[3] += p1 * bfhi(a.y); acc[4] += p2 * bflo(c.x); acc[5] += p2 * bfhi(c.x); acc[6] += p2 * bflo(c.y); acc[7] += p2 * bfhi(c.y); }
#pragma unroll 1
    for (int half = 0; half < 2; ++half) {
        float4 va[8], vb[8];
#pragma unroll
        for (int i = 0; i < 8; ++i) { const int jj = 1 + w + 8 * (half * 8 + i); const float* vp = cache + (size_t)(lg - jj * d) * 1024 + 512; va[i] = *(const float4*)(vp + lane * 4); vb[i] = *(const float4*)(vp + 256 + lane * 4); }
#pragma unroll
        for (int i = 0; i < 8; ++i) { const int jj = 1 + w + 8 * (half * 8 + i); const float p1 = sc[(lane >> 5) * 132 + jj], p2 = sc[(2 + (lane >> 5)) * 132 + jj];
            acc[0] += p1 * va[i].x; acc[1] += p1 * va[i].y; acc[2] += p1 * va[i].z; acc[3] += p1 * va[i].w; acc[4] += p2 * vb[i].x; acc[5] += p2 * vb[i].y; acc[6] += p2 * vb[i].z; acc[7] += p2 * vb[i].w; }
    }
    *(LAS f32x4*)(part + w * 512 + lane * 4) = (f32x4){acc[0], acc[1], acc[2], acc[3]};
    *(LAS f32x4*)(part + w * 512 + 256 + lane * 4) = (f32x4){acc[4], acc[5], acc[6], acc[7]};
    __syncthreads();
    { float s = 0.f;
#pragma unroll
      for (int ww = 0; ww < 8; ++ww) s += part[ww * 512 + tid];
      const int j = tid >> 7; OG[((size_t)g * NR + NP + b) * 512 + tid] = tobf1(s / st[4 + j]);
      if (tid < 4) LSE[((size_t)g * NR + NP + b) * 4 + tid] = st[tid] + __logf(st[4 + tid]); }
    __syncthreads();
}

template <bool ZETA> __device__ __forceinline__ void ret_stage(const bf16_t* Z, const float2* CS, size_t row0, int pos0, int h, float lgh, float rsq128, LAS unsigned char* lds, int tid) {
    u32x4 vraw[8];
#pragma unroll
    for (int c = 0; c < 8; ++c) { const int id = tid + 512 * c, tok = id >> 5, c32 = id & 31; vraw[c] = *(const u32x4*)(Z + ZO_RV + ((size_t)h * NP + row0 + tok) * 256 + c32 * 8); }
    __builtin_amdgcn_sched_barrier(0);
#pragma unroll
    for (int c = 0; c < 2; ++c) { const int id = tid + 512 * c, tok = id >> 3, c8 = id & 7; const bf16_t* kp = Z + ZO_RK + ((size_t)h * NP + row0 + tok) * 128 + c8 * 8;
        const u32x4 a = *(const u32x4*)kp, bq = *(const u32x4*)(kp + 64); const float4* cp = (const float4*)(CS + (size_t)(pos0 + tok) * 64 + c8 * 8);
        const float4 c0 = cp[0], c1 = cp[1], c2 = cp[2], c3 = cp[3];
        float sc = rsq128; if (ZETA) sc *= __expf((float)(127 - tok) * lgh);
        const float x1[8] = {bflo(a.x), bfhi(a.x), bflo(a.y), bfhi(a.y), bflo(a.z), bfhi(a.z), bflo(a.w), bfhi(a.w)}, x2[8] = {bflo(bq.x), bfhi(bq.x), bflo(bq.y), bfhi(bq.y), bflo(bq.z), bfhi(bq.z), bflo(bq.w), bfhi(bq.w)};
        const float cs[8] = {c0.x, c0.z, c1.x, c1.z, c2.x, c2.z, c3.x, c3.z}, sn[8] = {c0.y, c0.w, c1.y, c1.w, c2.y, c2.w, c3.y, c3.w};
        float o1[8], o2[8];
#pragma unroll
        for (int i = 0; i < 8; ++i) { o1[i] = (x1[i] * cs[i] - x2[i] * sn[i]) * sc; o2[i] = (x1[i] * sn[i] + x2[i] * cs[i]) * sc; }
        u32x4 w1, w2; w1.x = pkbf(o1[0], o1[1]); w1.y = pkbf(o1[2], o1[3]); w1.z = pkbf(o1[4], o1[5]); w1.w = pkbf(o1[6], o1[7]); w2.x = pkbf(o2[0], o2[1]); w2.y = pkbf(o2[2], o2[3]); w2.z = pkbf(o2[4], o2[5]); w2.w = pkbf(o2[6], o2[7]);
        *(LAS u32x4*)(lds + offb(tok, c8)) = w1; *(LAS u32x4*)(lds + offb(tok, c8 + 8)) = w2; }
#pragma unroll
    for (int c = 0; c < 8; ++c) { const int id = tid + 512 * c, tok = id >> 5, c32 = id & 31; *(LAS u32x4*)(lds + 32768 + (c32 >> 4) * 32768 + offb(tok, c32 & 15)) = vraw[c]; }
}
__device__ __forceinline__ void ret1_unit(const Params& P, const bf16_t* Z, float* RU, int u, LAS unsigned char* lds, int tid) {
    const int lane = tid & 63, w = __builtin_amdgcn_readfirstlane(tid >> 6), fr = lane & 15, fq = lane >> 4, q4 = fr >> 2, p4 = fr & 3;
    const int h = u & 3, bc = u >> 2;
    ret_stage<true>(Z, (const float2*)(P.ws + WS_CS), (size_t)bc * 128, (bc & 63) * 128, h, P.logg[h], P.rsq128, lds, tid);
    __syncthreads();
    f32x4 acc[8][2];
#pragma unroll
    for (int mt = 0; mt < 8; ++mt) { acc[mt][0] = (f32x4){0.f, 0.f, 0.f, 0.f}; acc[mt][1] = (f32x4){0.f, 0.f, 0.f, 0.f}; }
#pragma unroll
    for (int ks = 0; ks < 4; ++ks) {
        const int r0 = 32 * ks + 8 * fq + q4;
        bf16x8 Bf[2];
#pragma unroll
        for (int nt = 0; nt < 2; ++nt) { const int dvt = 2 * w + nt; LAS unsigned char* vb = lds + 32768 + (dvt >> 3) * 32768; const int c = dvt & 7;
            Bf[nt] = cat4(trr(vb + offb(r0, 2 * c + (p4 >> 1)) + 8 * (p4 & 1)), trr(vb + offb(r0 + 4, 2 * c + (p4 >> 1)) + 8 * (p4 & 1))); }
#pragma unroll
        for (int mt = 0; mt < 8; ++mt) { const bf16x8 Af = cat4(trr(lds + offb(r0, 2 * mt + (p4 >> 1)) + 8 * (p4 & 1)), trr(lds + offb(r0 + 4, 2 * mt + (p4 >> 1)) + 8 * (p4 & 1)));
            acc[mt][0] = mfma16(Af, Bf[0], acc[mt][0]); acc[mt][1] = mfma16(Af, Bf[1], acc[mt][1]); }
    }
    bf16_t* Up = (bf16_t*)RU + ((size_t)bc * 4 + h) * 32768;
#pragma unroll
    for (int mt = 0; mt < 8; ++mt)
#pragma unroll
        for (int nt = 0; nt < 2; ++nt) { u32x2 o; o.x = pkbf(acc[mt][nt][0], acc[mt][nt][1]); o.y = pkbf(acc[mt][nt][2], acc[mt][nt][3]); *(u32x2*)(Up + (size_t)(32 * w + 16 * nt + fr) * 128 + 16 * mt + 4 * fq) = o; }
    __syncthreads();
}
__device__ __forceinline__ void sret_unit(const Params& P, int l, const bf16_t* Z, bf16_t* ORET, int u, LAS unsigned char* lds, int tid) {
    const int b = u >> 2, h = u & 3; const bf16_t* zr = Z + (size_t)(NP + b) * INC;
    LAS float* qf = (LAS float*)lds; LAS float* kf = qf + 128; LAS float* part = kf + 128; LAS float* red = part + 512;
    if (tid < 64) { const float2 cs = ((const float2*)(P.ws + WS_CS))[(size_t)8192 * 64 + tid];
        const float q1 = bf1(zr[C_QR + h * 128 + tid]), q2 = bf1(zr[C_QR + h * 128 + 64 + tid]), k1 = bf1(zr[C_KR + h * 128 + tid]), k2 = bf1(zr[C_KR + h * 128 + 64 + tid]);
        qf[tid] = tobf1f(q1 * cs.x - q2 * cs.y); qf[64 + tid] = tobf1f(q1 * cs.y + q2 * cs.x);
        kf[tid] = tobf1f((k1 * cs.x - k2 * cs.y) * P.rsq128); kf[64 + tid] = tobf1f((k1 * cs.y + k2 * cs.x) * P.rsq128); }
    __syncthreads();
    const int e = tid & 255, half = tid >> 8; const float ve = bf1(zr[C_VR + h * 256 + e]); const float gamma = __expf(P.logg[h]);
    float qk = 0.f;
#pragma unroll 4
    for (int dk = 0; dk < 128; ++dk) qk += qf[dk] * kf[dk];
    const float* r0 = P.in[5] + ((size_t)(l * 32 + b) * 4 + h) * 32768; float* rn = P.out + O_RETS + ((size_t)(l * 32 + b) * 4 + h) * 32768;
    float acc = 0.f;
#pragma unroll
    for (int q = 0; q < 2; ++q) { float rv[32];
#pragma unroll
        for (int i = 0; i < 32; ++i) rv[i] = r0[(half * 64 + q * 32 + i) * 256 + e];
        __builtin_amdgcn_sched_barrier(0);
#pragma unroll
        for (int i = 0; i < 32; ++i) { const int dk = half * 64 + q * 32 + i; const float r = rv[i]; rn[dk * 256 + e] = gamma * r + kf[dk] * ve; acc += qf[dk] * r; }
        __builtin_amdgcn_sched_barrier(0); }
    part[half * 256 + e] = acc;
    __syncthreads();
    float o = 0.f;
    if (tid < 256) { o = qk * ve + gamma * (part[e] + part[256 + e]); const float s = wsum64(o * o); if ((tid & 63) == 0) red[tid >> 6] = s; }
    __syncthreads();
    if (tid < 256) { const float ss = red[0] + red[1] + red[2] + red[3]; const float rstd = rsqrtf(ss * (1.f / 256.f) + EPS); const float gr = bf1(zr[C_GR + h * 256 + e]);
        ORET[(size_t)(NP + b) * DM + h * 256 + e] = tobf1(o * rstd * gr * sigmoidf_(gr)); }
    __syncthreads();
}

struct CombIn { float l0, l1, l2; u32x4 a, bq, c; };
__device__ __forceinline__ void comb_load(const bf16_t* OG, const float* LSE, int row, int lane, CombIn& I) {
    const int j = lane >> 4;
    I.l0 = LSE[((size_t)0 * NR + row) * 4 + j]; I.l1 = LSE[((size_t)1 * NR + row) * 4 + j]; I.l2 = LSE[((size_t)2 * NR + row) * 4 + j];
    I.a = *(const u32x4*)(OG + ((size_t)0 * NR + row) * 512 + lane * 8); I.bq = *(const u32x4*)(OG + ((size_t)1 * NR + row) * 512 + lane * 8); I.c = *(const u32x4*)(OG + ((size_t)2 * NR + row) * 512 + lane * 8);
}
__device__ __forceinline__ void comb_fin(const CombIn& I, bf16_t* AO, int row, int lane) {
        const float l0 = I.l0, l1 = I.l1, l2 = I.l2; const u32x4 a = I.a, bq = I.bq, c = I.c;
        const float m = fmaxf(l0, fmaxf(l1, l2)); float w0 = __expf(l0 - m), w1 = __expf(l1 - m), w2 = __expf(l2 - m); const float inv = 1.f / (w0 + w1 + w2); w0 *= inv; w1 *= inv; w2 *= inv;
        u32x4 o;
        o.x = pkbf(w0 * bflo(a.x) + w1 * bflo(bq.x) + w2 * bflo(c.x), w0 * bfhi(a.x) + w1 * bfhi(bq.x) + w2 * bfhi(c.x));
        o.y = pkbf(w0 * bflo(a.y) + w1 * bflo(bq.y) + w2 * bflo(c.y), w0 * bfhi(a.y) + w1 * bfhi(bq.y) + w2 * bfhi(c.y));
        o.z = pkbf(w0 * bflo(a.z) + w1 * bflo(bq.z) + w2 * bflo(c.z), w0 * bfhi(a.z) + w1 * bfhi(bq.z) + w2 * bfhi(c.z));
        o.w = pkbf(w0 * bflo(a.w) + w1 * bflo(bq.w) + w2 * bflo(c.w), w0 * bfhi(a.w) + w1 * bfhi(bq.w) + w2 * bfhi(c.w));
        *(u32x4*)(AO + (size_t)row * 512 + lane * 8) = o;
}
__device__ __forceinline__ void combine_row(const bf16_t* OG, const float* LSE, bf16_t* AO, int row, int lane) { CombIn I; comb_load(OG, LSE, row, lane, I); comb_fin(I, AO, row, lane); }
__device__ __forceinline__ void p4_scan_combine(const Params& P, int l, const float* RU, bf16_t* RS, const bf16_t* OG, const float* LSE, bf16_t* AO, int tid, int bid, int G) {
    const int gt = bid * 512 + tid;
    if (gt < 65536) { const int bh = gt >> 13, b = bh >> 2, h = bh & 3, e4 = gt & 8191; const float g128 = __expf(128.f * P.logg[h]);
        f32x4 S = {0.f, 0.f, 0.f, 0.f};
        f32x4 ua[8], ub[8];
#pragma unroll
        for (int j = 0; j < 8; ++j) { const u32x2 t = *(const u32x2*)((const bf16_t*)RU + ((size_t)(b * 64 + j) * 4 + h) * 32768 + (size_t)e4 * 4); ua[j] = (f32x4){bflo(t.x), bfhi(t.x), bflo(t.y), bfhi(t.y)}; }
#pragma unroll
        for (int cb = 0; cb < 8; ++cb) {
            if (cb < 7) {
#pragma unroll
                for (int j = 0; j < 8; ++j) { const u32x2 q = *(const u32x2*)((const bf16_t*)RU + ((size_t)(b * 64 + (cb + 1) * 8 + j) * 4 + h) * 32768 + (size_t)e4 * 4); const f32x4 t = {bflo(q.x), bfhi(q.x), bflo(q.y), bfhi(q.y)}; if (cb & 1) ua[j] = t; else ub[j] = t; } }
            __builtin_amdgcn_sched_barrier(0);
#pragma unroll
            for (int j = 0; j < 8; ++j) { const size_t idx = ((size_t)(b * 64 + cb * 8 + j) * 4 + h) * 32768 + (size_t)e4 * 4;
                u32x2 o; o.x = pkbf(S[0], S[1]); o.y = pkbf(S[2], S[3]); *(u32x2*)(RS + idx) = o;
                const f32x4 uv = (cb & 1) ? ub[j] : ua[j]; S = S * g128 + uv; }
            __builtin_amdgcn_sched_barrier(0);
        }
        const int dv = (e4 * 4) >> 7, dk = (e4 * 4) & 127; float* o = P.out + O_RETP + ((size_t)(l * 2 + b) * 4 + h) * 32768;
#pragma unroll
        for (int i = 0; i < 4; ++i) o[(size_t)(dk + i) * 256 + dv] = S[i]; }
    const int lane = tid & 63, gw = bid * 8 + (tid >> 6), nw = G * 8;
    for (int row = gw; row < NP; row += 4 * nw) {
        if (row + 3 * nw < NP) { CombIn I[4];
#pragma unroll
            for (int k = 0; k < 4; ++k) comb_load(OG, LSE, row + k * nw, lane, I[k]);
            __builtin_amdgcn_sched_barrier(0);
#pragma unroll
            for (int k = 0; k < 4; ++k) comb_fin(I[k], AO, row + k * nw, lane); }
        else for (int r2 = row; r2 < NP; r2 += nw) combine_row(OG, LSE, AO, r2, lane); }
}

__device__ __forceinline__ void ret3_unit(const Params& P, const bf16_t* Z, const bf16_t* RS, bf16_t* ORET, int u, LAS unsigned char* lds, int tid) {
    const int lane = tid & 63, w = __builtin_amdgcn_readfirstlane(tid >> 6), fr = lane & 15, fq = lane >> 4, q4 = fr >> 2, p4 = fr & 3;
    const int h = u & 3, bc = u >> 2; const float lgh = P.logg[h];
    ret_stage<false>(Z, (const float2*)(P.ws + WS_CS), (size_t)bc * 128, (bc & 63) * 128, h, lgh, P.rsq128, lds, tid);
    const size_t row = (size_t)bc * 128 + 16 * w + fr;
    bf16x8 Qf[4];
    { const bf16_t* qp = Z + ZO_RQ + ((size_t)h * NP + row) * 128 + fq * 8;
#pragma unroll
      for (int s = 0; s < 4; ++s) Qf[s] = *(const bf16x8*)(qp + 32 * s);
      const float2* cp = (const float2*)(P.ws + WS_CS) + (size_t)((bc & 63) * 128 + 16 * w + fr) * 64 + fq * 8;
#pragma unroll
      for (int s = 0; s < 2; ++s) { const u32x4 a = __builtin_bit_cast(u32x4, Qf[s]), bq = __builtin_bit_cast(u32x4, Qf[s + 2]); const float4* c4 = (const float4*)(cp + 32 * s); const float4 c0 = c4[0], c1 = c4[1], c2 = c4[2], c3 = c4[3];
          const float x1[8] = {bflo(a.x), bfhi(a.x), bflo(a.y), bfhi(a.y), bflo(a.z), bfhi(a.z), bflo(a.w), bfhi(a.w)}, x2[8] = {bflo(bq.x), bfhi(bq.x), bflo(bq.y), bfhi(bq.y), bflo(bq.z), bfhi(bq.z), bflo(bq.w), bfhi(bq.w)};
          const float cs[8] = {c0.x, c0.z, c1.x, c1.z, c2.x, c2.z, c3.x, c3.z}, sn[8] = {c0.y, c0.w, c1.y, c1.w, c2.y, c2.w, c3.y, c3.w};
          float o1[8], o2[8];
#pragma unroll
          for (int i = 0; i < 8; ++i) { o1[i] = x1[i] * cs[i] - x2[i] * sn[i]; o2[i] = x1[i] * sn[i] + x2[i] * cs[i]; }
          u32x4 w1, w2; w1.x = pkbf(o1[0], o1[1]); w1.y = pkbf(o1[2], o1[3]); w1.z = pkbf(o1[4], o1[5]); w1.w = pkbf(o1[6], o1[7]); w2.x = pkbf(o2[0], o2[1]); w2.y = pkbf(o2[2], o2[3]); w2.z = pkbf(o2[4], o2[5]); w2.w = pkbf(o2[6], o2[7]);
          Qf[s] = __builtin_bit_cast(bf16x8, w1); Qf[s + 2] = __builtin_bit_cast(bf16x8, w2); } }
    u32x4 rr[8];
    { const bf16_t* Rp = RS + ((size_t)bc * 4 + h) * 32768;
#pragma unroll
      for (int c = 0; c < 8; ++c) rr[c] = *(const u32x4*)(Rp + (size_t)(tid + 512 * c) * 8); }
    __syncthreads();
    f32x4 Pm[8];
#pragma unroll
    for (int mt = 0; mt < 8; ++mt) { Pm[mt] = (f32x4){0.f, 0.f, 0.f, 0.f};
        if (mt <= w) {
#pragma unroll
            for (int s = 0; s < 4; ++s) { const bf16x8 kf = *(const LAS bf16x8*)(lds + offb(16 * mt + fr, 4 * s + fq)); Pm[mt] = mfma16(kf, Qf[s], Pm[mt]); }
#pragma unroll
            for (int e = 0; e < 4; ++e) { const int diff = 16 * w + fr - (16 * mt + 4 * fq + e); Pm[mt][e] = diff >= 0 ? Pm[mt][e] * __expf((float)diff * lgh) : 0.f; } } }
    __syncthreads();
#pragma unroll
    for (int c = 0; c < 8; ++c) { const int id = tid + 512 * c, dv = id >> 4, ch = id & 15;
        *(LAS u32x4*)(lds + (dv < 128 ? 98304 : 0) + offb(dv & 127, ch)) = rr[c]; }
    f32x4 acc[16];
#pragma unroll
    for (int dt = 0; dt < 16; ++dt) acc[dt] = (f32x4){0.f, 0.f, 0.f, 0.f};
#pragma unroll
    for (int ks = 0; ks < 4; ++ks) if (2 * ks <= w) { const bf16x8 Pb = pack8(Pm[2 * ks], Pm[2 * ks + 1]); const int r0 = 32 * ks + 4 * fq + q4;
#pragma unroll
        for (int dt = 0; dt < 16; ++dt) { LAS unsigned char* vb = lds + 32768 + (dt >> 3) * 32768; const int c = dt & 7;
            acc[dt] = mfma16(cat4(trr(vb + offb(r0, 2 * c + (p4 >> 1)) + 8 * (p4 & 1)), trr(vb + offb(r0 + 16, 2 * c + (p4 >> 1)) + 8 * (p4 & 1))), Pb, acc[dt]); } }
    __syncthreads();
    { const float xi = __expf((float)(16 * w + fr + 1) * lgh); bf16x8 Qx[4];
#pragma unroll
      for (int s = 0; s < 4; ++s) { const u32x4 r = __builtin_bit_cast(u32x4, Qf[s]); u32x4 o; o.x = pkbf(bflo(r.x) * xi, bfhi(r.x) * xi); o.y = pkbf(bflo(r.y) * xi, bfhi(r.y) * xi); o.z = pkbf(bflo(r.z) * xi, bfhi(r.z) * xi); o.w = pkbf(bflo(r.w) * xi, bfhi(r.w) * xi); Qx[s] = __builtin_bit_cast(bf16x8, o); }
#pragma unroll
      for (int dt = 0; dt < 16; ++dt) { LAS unsigned char* rb = lds + (dt < 8 ? 98304 : 0);
#pragma unroll
          for (int s = 0; s < 4; ++s) { const bf16x8 rf = *(const LAS bf16x8*)(rb + offb(16 * (dt & 7) + fr, 4 * s + fq)); acc[dt] = mfma16(rf, Qx[s], acc[dt]); } } }
    u32x2 gg[16];
    { const bf16_t* gp = Z + ZO_GR + ((size_t)h * NP + row) * 256 + 4 * fq;
#pragma unroll
      for (int dt = 0; dt < 16; ++dt) gg[dt] = *(const u32x2*)(gp + 16 * dt); }
    __builtin_amdgcn_sched_barrier(0);
    float ss = 0.f;
#pragma unroll
    for (int dt = 0; dt < 16; ++dt) ss += acc[dt][0] * acc[dt][0] + acc[dt][1] * acc[dt][1] + acc[dt][2] * acc[dt][2] + acc[dt][3] * acc[dt][3];
    ss += shx(ss, 16); ss += shx(ss, 32);
    const float rstd = rsqrtf(ss * (1.f / 256.f) + EPS);
    bf16_t* op = ORET + row * DM + h * 256 + 4 * fq;
#pragma unroll
    for (int dt = 0; dt < 16; ++dt) { const u32x2 g = gg[dt]; const float g0 = bflo(g.x), g1 = bfhi(g.x), g2 = bflo(g.y), g3 = bfhi(g.y);
        u32x2 o; o.x = pkbf(acc[dt][0] * rstd * g0 * sigmoidf_(g0), acc[dt][1] * rstd * g1 * sigmoidf_(g1)); o.y = pkbf(acc[dt][2] * rstd * g2 * sigmoidf_(g2), acc[dt][3] * rstd * g3 * sigmoidf_(g3));
        *(u32x2*)(op + 16 * dt) = o; }
    __syncthreads();
}

__device__ __forceinline__ void p8_rms(const float* X, const float* nw, bf16_t* H2, int gw, int nwv, int lane) {
    float4 wv[4];
#pragma unroll
    for (int j = 0; j < 4; ++j) wv[j] = *(const float4*)(nw + j * 256 + lane * 4);
    for (int row0 = gw * 2; row0 < NR; row0 += nwv * 2) { float4 v[2][4];
#pragma unroll
        for (int k = 0; k < 2; ++k)
#pragma unroll
            for (int j = 0; j < 4; ++j) v[k][j] = *(const float4*)(X + (size_t)(row0 + k) * DM + j * 256 + lane * 4);
        __builtin_amdgcn_sched_barrier(0);
#pragma unroll
        for (int k = 0; k < 2; ++k) { float ss = 0.f;
#pragma unroll
            for (int j = 0; j < 4; ++j) ss += v[k][j].x * v[k][j].x + v[k][j].y * v[k][j].y + v[k][j].z * v[k][j].z + v[k][j].w * v[k][j].w;
            const float rstd = rsqrtf(wsum64(ss) * (1.f / 1024.f) + EPS);
#pragma unroll
            for (int j = 0; j < 4; ++j) { const float4 w = wv[j];
                u32x2 o; o.x = pkbf(v[k][j].x * rstd * w.x, v[k][j].y * rstd * w.y); o.y = pkbf(v[k][j].z * rstd * w.z, v[k][j].w * rstd * w.w); *(u32x2*)(H2 + (size_t)(row0 + k) * DM + j * 256 + lane * 4) = o; } } }
}

constexpr int PT_CAP = 65;
constexpr int PL_SVL = 0;
constexpr int PL_EL = PT_CAP * 16 * 20 * 4;
constexpr int PL_GL = PL_EL + PT_CAP * 128 * 4;
constexpr int PL_ACT = PL_GL + PT_CAP * 128 * 4;
static_assert(PL_ACT + 8 * 128 * 4 <= LDS_BAR, "PEER LDS map");

struct RowBuf { u32x4 a[8]; u32x2 b[8]; };
__device__ __forceinline__ f32x32 cv6(const u32x4& a, const u32x2& b) { u32x6 p = {a.x, a.y, a.z, a.w, b.x, b.y};
    f32x32 r = __builtin_amdgcn_cvt_scalef32_pk32_f32_fp6(p, 1.0f);
    return r; }
__device__ __forceinline__ void peer_issue(RowBuf& B, const __amdgpu_buffer_rsrc_t tab, const LAS int* el, int h, int lane) {
    const int ev = el[h * 16 + (lane & 15)]; const int lo = (lane & 31) * 16, lo8 = 512 - (lane & 31) * 8; const bool up = lane & 32;
#pragma unroll
    for (int i = 0; i < 8; ++i) { const int ea = __builtin_amdgcn_readlane(ev, i), eb = __builtin_amdgcn_readlane(ev, 8 + i); const int off = (up ? eb : ea) * 768 + lo;
        B.a[i] = __builtin_amdgcn_raw_buffer_load_b128(tab, off, 0, 0); B.b[i] = __builtin_amdgcn_raw_buffer_load_b64(tab, off + lo8, 0, 0); }
}
__device__ __forceinline__ float peer_dot32(const f32x32& r, const f32x2 (&hf)[16]) {
    f32x2 a = {0.f, 0.f};
#pragma unroll
    for (int j = 0; j < 16; ++j) { f32x2 rr; rr.x = r[2 * j]; rr.y = r[2 * j + 1]; a = __builtin_elementwise_fma(rr, hf[j], a); }
    return a.x + a.y;
}
__device__ __forceinline__ void peer_udot(const RowBuf& B, const f32x2 (&hf)[16], LAS float* act, int h, int lane) {
    const bool h4 = lane & 16, h3 = lane & 8, h2 = lane & 4;
    float p[8];
#pragma unroll
    for (int i = 0; i < 8; ++i) { u32x4 ra = B.a[i]; u32x2 rb = B.b[i]; if (i > 0) asm volatile("" : "+v"(ra), "+v"(rb), "+v"(p[i - 1]));
        p[i] = peer_dot32(cv6(ra, rb), hf); }
    float q[4];
#pragma unroll
    for (int i = 0; i < 4; ++i) { const float snd = h4 ? p[i] : p[i + 4], keep = h4 ? p[i + 4] : p[i]; q[i] = keep + shx(snd, 16); }
    float r[2];
#pragma unroll
    for (int i = 0; i < 2; ++i) { const float snd = h3 ? q[i] : q[i + 2], keep = h3 ? q[i + 2] : q[i]; r[i] = keep + shx(snd, 8); }
    float t; { const float snd = h2 ? r[0] : r[1], keep = h2 ? r[1] : r[0]; t = keep + shx(snd, 4); }
    t += shx(t, 2); t += shx(t, 1);
    if ((lane & 3) == 0) act[h * 16 + ((lane >> 5) & 1) * 8 + ((lane >> 4) & 1) * 4 + ((lane >> 3) & 1) * 2 + ((lane >> 2) & 1)] = t;
}
__device__ __forceinline__ void peer_vacc(const RowBuf& B, const LAS float* coef, int h, int lane, f32x32& o) {
    const LAS float* cp = coef + h * 16 + ((lane >> 5) & 1) * 8;
#pragma unroll
    for (int i = 0; i < 8; ++i) { const float c = cp[i];
        u32x4 ra = B.a[i]; u32x2 rb = B.b[i]; asm volatile("" : "+v"(ra), "+v"(rb), "+v"(o));
        const f32x32 r = cv6(ra, rb);
        o = __builtin_elementwise_fma(r, (f32x32)c, o); }
}
__device__ __forceinline__ void peer_load_h(const bf16_t* H2, int row, int lane, f32x2 (&hf)[16]) {
    const bf16_t* hp = H2 + (size_t)row * DM + (lane & 31) * 32;
#pragma unroll
    for (int k = 0; k < 4; ++k) { const u32x4 v = *(const u32x4*)(hp + 8 * k);
        hf[4 * k] = (f32x2){bflo(v.x), bfhi(v.x)}; hf[4 * k + 1] = (f32x2){bflo(v.y), bfhi(v.y)}; hf[4 * k + 2] = (f32x2){bflo(v.z), bfhi(v.z)}; hf[4 * k + 3] = (f32x2){bflo(v.w), bfhi(v.w)}; }
}
__device__ __forceinline__ void peer_join(const f32x32& o, int lane, f32x2 (&y)[8]) {
    (void)lane;
#pragma unroll
    for (int j = 0; j < 8; ++j) {
        const u32x2 p0 = __builtin_amdgcn_permlane32_swap(__float_as_uint(o[2 * j]), __float_as_uint(o[16 + 2 * j]), false, false);
        const u32x2 p1 = __builtin_amdgcn_permlane32_swap(__float_as_uint(o[2 * j + 1]), __float_as_uint(o[16 + 2 * j + 1]), false, false);
        y[j].x = __uint_as_float(p0.x) + __uint_as_float(p0.y); y[j].y = __uint_as_float(p1.x) + __uint_as_float(p1.y); }
}
#define MK_FRESH_LANE() int lane; asm volatile("v_mbcnt_lo_u32_b32 %0, -1, 0\n\tv_mbcnt_hi_u32_b32 %0, -1, %0" : "=v"(lane));
__device__ __forceinline__ void p10_peer(const Params& P, int l, const int* SC, const bf16_t* H2, float* X, bf16_t* Hn, LAS unsigned char* lds, int w, int bid, int G) {
    const int t0 = (int)(((long)bid * NP) / G), t1 = (int)(((long)(bid + 1) * NP) / G);
    LAS int* svl = (LAS int*)(lds + PL_SVL); LAS int* elist = (LAS int*)(lds + PL_EL); LAS float* glist = (LAS float*)(lds + PL_GL);
    const __amdgpu_buffer_rsrc_t Ub = __builtin_amdgcn_make_buffer_rsrc((void*)(P.ws + WS_UBF + (size_t)l * SZ_TAB6), 0, (int)SZ_TAB6, 0x00020000);
    const __amdgpu_buffer_rsrc_t Vb = __builtin_amdgcn_make_buffer_rsrc((void*)(P.ws + WS_VBF + (size_t)l * SZ_TAB6), 0, (int)SZ_TAB6, 0x00020000);
    const float* USC = (const float*)(P.ws + WS_TSC) + (size_t)l * 16384; const float* VSC = (const float*)(P.ws + WS_TSC) + (size_t)(2 + l) * 16384;
    const bool last = (l == NLAYER - 1); const float* nwn = P.in[7] + (last ? 0 : (l + 1) * DM);
    for (int c0 = t0; c0 < t1; c0 += PT_CAP - 1) {
        const int ntp = (t1 - c0) < PT_CAP - 1 ? (t1 - c0) : PT_CAP - 1; const int smp = (c0 == t0 && bid < NSMP) ? NP + bid : -1; const int nt = ntp + (smp >= 0 ? 1 : 0);
#define MK_ROWOF(ti) ((ti) < ntp ? c0 + (ti) : smp)
#ifndef MK_P10MASK
#define MK_P10MASK 31
#endif
        if (MK_P10MASK & 1) { MK_FRESH_LANE(); const int ngrp = (nt + 15) >> 4;
          for (int it = w; it < ngrp * 4; it += 8) { const int tg = it >> 2, hq = it & 3, ti = tg * 16 + (lane & 15), hpi = hq * 4 + (lane >> 4); const bool ok = ti < nt; const int row = MK_ROWOF(ok ? ti : nt - 1);
            const int* sp = SC + ((size_t)(row >> 4) * 512 + hpi * 32) * 64 + (row & 15) * 4;
            int sv[16];
#pragma unroll
            for (int i = 0; i < 16; ++i) sv[i] = (int)0x80000000;
            i32x4 va[8], vb[8];
#pragma unroll
            for (int j = 0; j < 8; ++j) va[j] = *(const i32x4*)(sp + (size_t)j * 64);
#pragma unroll
            for (int b = 0; b < 4; ++b) {
                if (b < 3) {
#pragma unroll
                    for (int j = 0; j < 8; ++j) { const i32x4 t = *(const i32x4*)(sp + (size_t)((b + 1) * 8 + j) * 64); if (b & 1) va[j] = t; else vb[j] = t; } }
                __builtin_amdgcn_sched_barrier(0);
#pragma unroll
                for (int j = 0; j < 8; ++j) { const i32x4 v = (b & 1) ? vb[j] : va[j]; ins16(sv, v[0]); ins16(sv, v[1]); ins16(sv, v[2]); ins16(sv, v[3]); }
                __builtin_amdgcn_sched_barrier(0);
            }
            if (ok) { LAS int* d = svl + (ti * 16 + hpi) * 20;
#pragma unroll
                for (int i = 0; i < 4; ++i) *(LAS i32x4*)(d + 4 * i) = (i32x4){sv[4 * i], sv[4 * i + 1], sv[4 * i + 2], sv[4 * i + 3]}; } } }
        __syncthreads();
        if (MK_P10MASK & 2) { MK_FRESH_LANE(); const int tid = w * 64 + lane; for (int it = tid; it < nt * 8; it += 512) { const int ti = it >> 3, h = it & 7; const LAS int* pa = svl + (ti * 16 + 2 * h) * 20; const LAS int* pb = pa + 20;
            float fa[16], fb[16];
#pragma unroll
            for (int i = 0; i < 4; ++i) { const i32x4 va = *(const LAS i32x4*)(pa + 4 * i), vb = *(const LAS i32x4*)(pb + 4 * i);
#pragma unroll
                for (int e = 0; e < 4; ++e) { fa[4 * i + e] = unsortable(va[e] & ~127); fb[4 * i + e] = unsortable(vb[e] & ~127); } }
            int top[16];
#pragma unroll
            for (int i = 0; i < 16; ++i) top[i] = (int)0x80000000;
#pragma unroll
            for (int i = 0; i < 16; ++i)
#pragma unroll
                for (int j = 0; j < 16; ++j) if ((i + 1) * (j + 1) <= 16) ins16(top, (sortable(fa[i] + fb[j]) & ~255) | (255 - (i * 16 + j)));
            float ev[16]; float sum = 0.f; const float mxv = unsortable(top[0] & ~255);
#pragma unroll
            for (int k = 0; k < 16; ++k) { ev[k] = __expf(unsortable(top[k] & ~255) - mxv); sum += ev[k]; }
            const float inv = 1.f / sum;
#pragma unroll
            for (int k = 0; k < 16; ++k) { const int cidx = 255 - (top[k] & 255), ia = 127 - (pa[cidx >> 4] & 127), ib = 127 - (pb[cidx & 15] & 127);
                elist[ti * 128 + h * 16 + k] = ia * 128 + ib; glist[ti * 128 + h * 16 + k] = ev[k] * inv; } } }
        __syncthreads();
        if (MK_P10MASK & 4) { LAS float* actl = (LAS float*)(lds + PL_SVL);
          if (MK_P10MASK & 8) { MK_FRESH_LANE(); RowBuf B0, B1;
            for (int ti = w; ti < ntp; ti += 8) {
              const int row = c0 + ti; const LAS int* el = elist + ti * 128; LAS float* act = actl + ti * 128;
              peer_issue(B0, Ub, el, 0, lane);
              f32x2 hf[16]; peer_load_h(H2, row, lane, hf);
#pragma unroll 1
              for (int hh = 0; hh < 6; hh += 2) {
                  peer_issue(B1, Ub, el, hh + 1, lane);
                  peer_udot(B0, hf, act, hh, lane);
                  peer_issue(B0, Ub, el, hh + 2, lane);
                  peer_udot(B1, hf, act, hh + 1, lane);
              }
              peer_issue(B1, Ub, el, 7, lane);
              peer_udot(B0, hf, act, 6, lane);
              peer_udot(B1, hf, act, 7, lane); } }
          if (smp >= 0) { MK_FRESH_LANE(); const int ti = ntp, row = smp; const LAS int* el = elist + ti * 128; LAS float* act = actl + ti * 128;
              RowBuf B; peer_issue(B, Ub, el, w, lane);
              f32x2 hf[16]; peer_load_h(H2, row, lane, hf);
              peer_udot(B, hf, act, w, lane); }
          __syncthreads();
          { MK_FRESH_LANE(); float us0[9], us1[9], vs0[9], vs1[9];
#pragma unroll
            for (int k = 0; k < 9; ++k) { const int ti = w + 8 * k; us0[k] = us1[k] = vs0[k] = vs1[k] = 0.f;
                if (ti < nt) { const LAS int* el = elist + ti * 128; const int e0 = el[lane], e1 = el[64 + lane]; us0[k] = USC[e0]; us1[k] = USC[e1]; vs0[k] = VSC[e0]; vs1[k] = VSC[e1]; } }
            __builtin_amdgcn_sched_barrier(0);
#pragma unroll
            for (int k = 0; k < 9; ++k) { const int ti = w + 8 * k;
                if (ti < nt) { const LAS float* gl = glist + ti * 128; LAS float* act = actl + ti * 128;
                    const float a0 = act[lane] * us0[k], a1 = act[64 + lane] * us1[k]; const float g0 = gl[lane] * vs0[k], g1 = gl[64 + lane] * vs1[k];
                    act[lane] = g0 * 0.5f * a0 * (1.f + erff(a0 * 0.70710678118654752f)); act[64 + lane] = g1 * 0.5f * a1 * (1.f + erff(a1 * 0.70710678118654752f)); } } }
          __syncthreads();
          if (MK_P10MASK & 16) { MK_FRESH_LANE(); RowBuf B0, B1;
            const int dofw = (lane & 31) * 32 + ((lane >> 5) & 1) * 16;
            const float4 w0 = *(const float4*)(nwn + dofw), w1 = *(const float4*)(nwn + dofw + 4), w2 = *(const float4*)(nwn + dofw + 8), w3 = *(const float4*)(nwn + dofw + 12);
            for (int ti = w; ti < ntp; ti += 8) {
              const int row = c0 + ti; const LAS int* el = elist + ti * 128; const LAS float* act = actl + ti * 128;
              peer_issue(B0, Vb, el, 0, lane);
              f32x32 o = (f32x32)0.f;
#pragma unroll 1
              for (int hh = 0; hh < 6; hh += 2) {
                  peer_issue(B1, Vb, el, hh + 1, lane);
                  peer_vacc(B0, act, hh, lane, o);
                  peer_issue(B0, Vb, el, hh + 2, lane);
                  peer_vacc(B1, act, hh + 1, lane, o);
              }
              peer_issue(B1, Vb, el, 7, lane);
              peer_vacc(B0, act, 6, lane, o);
              const int dof = (lane & 31) * 32 + ((lane >> 5) & 1) * 16;
              float* xr = X + (size_t)row * DM + dof;
              const float4 x0 = *(const float4*)(xr), x1 = *(const float4*)(xr + 4), x2 = *(const float4*)(xr + 8), x3 = *(const float4*)(xr + 12);
              __builtin_amdgcn_sched_barrier(0);
              peer_vacc(B1, act, 7, lane, o);
              asm volatile("" ::: "memory"); __builtin_amdgcn_sched_barrier(0);
              f32x2 yo[8]; peer_join(o, lane, yo);
              float y[16];
              {
                y[0] = x0.x + yo[0].x; y[1] = x0.y + yo[0].y; y[2] = x0.z + yo[1].x; y[3] = x0.w + yo[1].y; y[4] = x1.x + yo[2].x; y[5] = x1.y + yo[2].y; y[6] = x1.z + yo[3].x; y[7] = x1.w + yo[3].y;
                y[8] = x2.x + yo[4].x; y[9] = x2.y + yo[4].y; y[10] = x2.z + yo[5].x; y[11] = x2.w + yo[5].y; y[12] = x3.x + yo[6].x; y[13] = x3.y + yo[6].y; y[14] = x3.z + yo[7].x; y[15] = x3.w + yo[7].y; }
              float* dst = last ? (row < NP ? P.out + O_YP + (size_t)row * DM : P.out + O_YS + (size_t)(row - NP) * DM) + dof : xr;
              *(float4*)(dst) = make_float4(y[0], y[1], y[2], y[3]); *(float4*)(dst + 4) = make_float4(y[4], y[5], y[6], y[7]);
              *(float4*)(dst + 8) = make_float4(y[8], y[9], y[10], y[11]); *(float4*)(dst + 12) = make_float4(y[12], y[13], y[14], y[15]);
              if (!last) { float ss = 0.f;
#pragma unroll
                  for (int i = 0; i < 16; ++i) ss += y[i] * y[i];
                  const float rstd = rsqrtf(wsum64(ss) * (1.f / 1024.f) + EPS);
                  u32x4 o0, o1; o0.x = pkbf(y[0] * rstd * w0.x, y[1] * rstd * w0.y); o0.y = pkbf(y[2] * rstd * w0.z, y[3] * rstd * w0.w); o0.z = pkbf(y[4] * rstd * w1.x, y[5] * rstd * w1.y); o0.w = pkbf(y[6] * rstd * w1.z, y[7] * rstd * w1.w);
                  o1.x = pkbf(y[8] * rstd * w2.x, y[9] * rstd * w2.y); o1.y = pkbf(y[10] * rstd * w2.z, y[11] * rstd * w2.w); o1.z = pkbf(y[12] * rstd * w3.x, y[13] * rstd * w3.y); o1.w = pkbf(y[14] * rstd * w3.z, y[15] * rstd * w3.w);
                  *(u32x4*)(Hn + (size_t)row * DM + dof) = o0; *(u32x4*)(Hn + (size_t)row * DM + dof + 8) = o1; }
            } }
          if (smp >= 0) { MK_FRESH_LANE(); const int ti = ntp, row = smp; const LAS int* el = elist + ti * 128; const LAS float* act = actl + ti * 128;
              LAS float* part = (LAS float*)(lds + PL_SVL + 36864); LAS float* red = part + 8192;
              RowBuf B; peer_issue(B, Vb, el, w, lane);
              f32x32 o = (f32x32)0.f;
              peer_vacc(B, act, w, lane, o);
              { f32x2 yo[8]; peer_join(o, lane, yo); const int dof = (lane & 31) * 32 + ((lane >> 5) & 1) * 16;
#pragma unroll
                for (int i = 0; i < 4; ++i) *(LAS f32x4*)(part + w * 1024 + dof + 4 * i) = (f32x4){yo[2 * i].x, yo[2 * i].y, yo[2 * i + 1].x, yo[2 * i + 1].y}; }
              __syncthreads();
              const int tid = w * 64 + lane; float y0 = 0.f, y1 = 0.f;
#pragma unroll
              for (int ww = 0; ww < 8; ++ww) { y0 += part[ww * 1024 + 2 * tid]; y1 += part[ww * 1024 + 2 * tid + 1]; }
              float* xr = X + (size_t)row * DM + 2 * tid; const float2 xv = *(const float2*)xr; y0 += xv.x; y1 += xv.y;
              float* dst = last ? P.out + O_YS + (size_t)(row - NP) * DM + 2 * tid : xr; *(float2*)dst = make_float2(y0, y1);
              if (!last) { const float s = wsum64(y0 * y0 + y1 * y1); if (lane == 0) red[w] = s;
                  __syncthreads();
                  const float ss = red[0] + red[1] + red[2] + red[3] + red[4] + red[5] + red[6] + red[7]; const float rstd = rsqrtf(ss * (1.f / 1024.f) + EPS); const float2 wn = *(const float2*)(nwn + 2 * tid);
                  *(unsigned*)(Hn + (size_t)row * DM + 2 * tid) = pkbf(y0 * rstd * wn.x, y1 * rstd * wn.y); }
          } }
        __syncthreads();
#undef MK_ROWOF
    }
}

constexpr int NPH = 1 + 10 * NLAYER;
__global__ void __launch_bounds__(512, 2) mk_fwd(Params P) {
    extern __shared__ __attribute__((aligned(16))) unsigned char lds_raw[];
    LAS unsigned char* lds = (LAS unsigned char*)lds_raw;
    const int wave = __builtin_amdgcn_readfirstlane((int)threadIdx.x >> 6), bid = blockIdx.x, G = gridDim.x;
    const int nw = G * 8;
    unsigned char* ws = P.ws;
    XcdBarrier bar; bar.wv = wave; bar.bar = (unsigned*)(ws + WS_CTL); bar.x = 0; bar.st = (volatile LAS unsigned*)(lds + LDS_BAR);
    if (P.use_bar) {
        if (wave == 0 && xb_lane() == 0u) *(LAS u32x4*)(lds + LDS_BAR) = (u32x4){0u, 0u, 0u, 0u};
        __syncthreads();
        bar = xcd_barrier_post((unsigned*)(ws + WS_CTL), (volatile LAS unsigned*)(lds + LDS_BAR), wave);
    }
    const int lo = P.ph_lo, hi = P.ph_hi;
#define IN(k) (lo <= (k) && (k) < hi)
#ifndef MK_PHMASK
#define MK_PHMASK 0xffff
#endif
#define PHM(k) ((MK_PHMASK >> (k)) & 1)
#ifndef MK_P3MASK
#define MK_P3MASK 0xf
#endif
#define P3M(k) ((MK_P3MASK >> (k)) & 1)
#ifndef MK_REP
#define MK_REP -1
#endif
#define NREP(k) ((MK_REP == (k) && l == NLAYER - 1) ? 2 : 1)
#ifdef MK_DBLBAR
#define SEAM(k) do { if (IN(k) && IN((k) + 1)) { xcd_barrier(bar); xcd_barrier(bar); } } while (0)
#else
#define SEAM(k) do { if (IN(k) && IN((k) + 1)) xcd_barrier(bar); } while (0)
#endif
#define PH_T() int t_; asm volatile("v_mbcnt_lo_u32_b32 %0, -1, 0\n\tv_mbcnt_hi_u32_b32 %0, -1, %0" : "=v"(t_)); t_ += wave * 64; const int l_ = t_ & 63, w_ = __builtin_amdgcn_readfirstlane(t_ >> 6), gw_ = bid * 8 + w_, gwr_ = (G - 1 - bid) * 8 + w_; (void)l_; (void)gw_; (void)gwr_; \
    unsigned long long wsv_ = (unsigned long long)P.ws; asm volatile("" : "+s"(wsv_)); unsigned char* wsp = (unsigned char*)(__attribute__((address_space(1))) unsigned char*)wsv_;   \
    bf16_t* const H = (bf16_t*)(wsp + WS_H); bf16_t* const H2 = (bf16_t*)(wsp + WS_H2); bf16_t* const Z = (bf16_t*)(wsp + WS_Z); float* const X = (float*)(wsp + WS_XRES); \
    bf16_t* const OG = (bf16_t*)(wsp + WS_OG); float* const LSE = (float*)(wsp + WS_LSE); bf16_t* const AO = (bf16_t*)(wsp + WS_AO); \
    float* const RU = (float*)(wsp + WS_RU); bf16_t* const RS = (bf16_t*)(wsp + WS_RS); bf16_t* const ORET = (bf16_t*)(wsp + WS_ORET); \
    float* const MIX1 = (float*)(wsp + WS_MIX1); bf16_t* const MIXED = (bf16_t*)(wsp + WS_MIXED); int* const SC = (int*)(wsp + WS_SC); \
    (void)H; (void)H2; (void)Z; (void)X; (void)OG; (void)LSE; (void)AO; (void)RU; (void)RS; (void)ORET; (void)MIX1; (void)MIXED; (void)SC;
#define PH_W() const bf16_t* WtIn = (const bf16_t*)(wsp + WS_WTIN + l * SZ_WTIN); const bf16_t* WtOa = (const bf16_t*)(wsp + WS_WTOA + l * SZ_WTOA); const bf16_t* WtOr = (const bf16_t*)(wsp + WS_WTOR + l * SZ_WSQ); \
    const bf16_t* WtOut = (const bf16_t*)(wsp + WS_WTOUT + l * SZ_WSQ); const bf16_t* WtS = (const bf16_t*)(wsp + WS_WTS + l * SZ_WTS); (void)WtIn; (void)WtOa; (void)WtOr; (void)WtOut; (void)WtS;
    if (PHM(0) && IN(0)) for (int rep_ = 0; rep_ < (MK_REP == 0 ? 2 : 1); ++rep_) { PH_T(); p0_prologue(P, lds, t_, bid, G); }
    SEAM(0);
#pragma unroll
    for (int l = 0; l < NLAYER; ++l) {
        const int pb = 1 + 10 * l;
        if (PHM(1) && IN(pb + 0)) for (int rep_ = 0; rep_ < NREP(1); ++rep_) { PH_T(); PH_W(); pg8::Gemm g{H, WtIn, NP, INC, DM}; pg8::StaticOrder S; S.init(NP, INC, G, bid); const float* bg = P.in[9] + (size_t)l * 2048; EpiZ E{Z, bg};
            pg8::gemm_phase<EpiZ, pg8::StaticOrder, false>(lds, g, S, E, nullptr, t_);
            skinny<QZ>(H + (size_t)NP * DM, WtIn, INC, DM, QZ{Z, bg}, gwr_, nw, l_);
            if (bid >= G / 2) conv_tables(P, l, (bid - G / 2) * 8 + w_, (G - G / 2) * 8, l_); }
        SEAM(pb + 0);
#ifndef MK_REP3SUB
#define MK_REP3SUB 0
#endif
#define NREP3(s) ((((MK_REP3SUB >> (s)) & 1) && l == NLAYER - 1) ? 2 : 1)
        if (PHM(3) && IN(pb + 2)) { PH_T();
            if (P3M(1)) for (int rr = 0; rr < NREP3(1); ++rr) for (int u = bid; u < 512; u += G) ret1_unit(P, Z, RU, u, lds, t_);
            if (P3M(0)) for (int rr = 0; rr < NREP3(0); ++rr) attn_phase(P, l, Z, OG, LSE, lds, t_, bid, G);
        }
        SEAM(pb + 2);
        if (PHM(4) && IN(pb + 3)) for (int rep_ = 0; rep_ < NREP(4); ++rep_) { PH_T();
            for (int u = G - 1 - bid; u < 128; u += G) sret_unit(P, l, Z, ORET, u, lds, t_);
            for (int u = G - 1 - bid; u < 96; u += G) sattn_unit(P, l, Z, OG, LSE, u, lds, t_);
            p4_scan_combine(P, l, RU, RS, OG, LSE, AO, t_, bid, G); }
        SEAM(pb + 3);
        if (PHM(5) && IN(pb + 4)) for (int rep_ = 0; rep_ < NREP(5); ++rep_) { PH_T(); if (gw_ < NSMP) combine_row(OG, LSE, AO, NP + gw_, l_); for (int u = bid; u < 512; u += G) ret3_unit(P, Z, RS, ORET, u, lds, t_); }
        SEAM(pb + 4);
        if (PHM(6) && IN(pb + 5)) for (int rep_ = 0; rep_ < NREP(6); ++rep_) { PH_T(); PH_W();
            { pg8::Gemm g{AO, WtOa, NP, DM, 512}; pg8::StaticOrder S; S.init(NP, DM, G, bid); EpiQuadB<QGateA, 4> E{QGateA{Z, MIX1}};
              pg8::gemm_phase<EpiQuadB<QGateA, 4>, pg8::StaticOrder, false>(lds, g, S, E, nullptr, t_);
              skinny8<QGateA>(AO + (size_t)NP * 512, WtOa, DM, 512, QGateA{Z, MIX1}, G - 1 - bid, G, w_, l_, lds); }
            { pg8::Gemm g{ORET, WtOr, NP, DM, DM}; pg8::StaticOrder S; S.init(NP, DM, G, bid); EpiQuadB<QGateB, 4> E{QGateB{Z, MIX1, MIXED}};
              pg8::gemm_phase<EpiQuadB<QGateB, 4>, pg8::StaticOrder, false>(lds, g, S, E, nullptr, t_);
              skinny8<QGateB>(ORET + (size_t)NP * DM, WtOr, DM, DM, QGateB{Z, MIX1, MIXED}, G - 1 - bid, G, w_, l_, lds); } }
        SEAM(pb + 5);
        if (PHM(7) && IN(pb + 6)) for (int rep_ = 0; rep_ < NREP(7); ++rep_) { PH_T(); PH_W(); pg8::Gemm g{MIXED, WtOut, NP, DM, DM}; pg8::StaticOrder S; S.init(NP, DM, G, bid); const float* xp_ = l == 0 ? P.in[0] : X; const float* xs_ = l == 0 ? P.in[1] : X + (size_t)NP * DM; EpiQuadB<QRes, 4> E{QRes{xp_, xs_, X}};
            pg8::gemm_phase<EpiQuadB<QRes, 4>, pg8::StaticOrder, false>(lds, g, S, E, nullptr, t_);
            skinny8<QRes>(MIXED + (size_t)NP * DM, WtOut, DM, DM, QRes{xp_, xs_, X}, G - 1 - bid, G, w_, l_, lds); }
        SEAM(pb + 6);
        if (PHM(8) && IN(pb + 7)) for (int rep_ = 0; rep_ < NREP(8); ++rep_) { PH_T(); p8_rms(X, P.in[15] + (size_t)l * DM, H2, gw_, nw, l_); }
        SEAM(pb + 7);
        if (PHM(9) && IN(pb + 8)) for (int rep_ = 0; rep_ < NREP(9); ++rep_) { PH_T(); PH_W(); pg8::Gemm g{H2, WtS, NP, 2048, DM}; pg8::StaticOrder S; S.init(NP, 2048, G, bid); EpiQuad<QKey> E{QKey{SC}};
            pg8::gemm_phase<EpiQuad<QKey>, pg8::StaticOrder, false>(lds, g, S, E, nullptr, t_);
            skinny8<QKey>(H2 + (size_t)NP * DM, WtS, 2048, DM, QKey{SC}, G - 1 - bid, G, w_, l_, lds); }
        SEAM(pb + 8);
        if (PHM(10) && IN(pb + 9)) for (int rep_ = 0; rep_ < NREP(10); ++rep_) { PH_T(); p10_peer(P, l, SC, H2, X, H, lds, wave, bid, G); }
        SEAM(pb + 9);
    }
#undef IN
#undef SEAM
}
}

#ifndef MK_ONE_LAUNCH
#define MK_ONE_LAUNCH 1
#endif
static int t5_bucket(long dist) {
    const int max_exact = 16;
    if (dist < max_exact) return (int)dist;
    const double ratio = log((double)(dist < 1 ? 1 : dist) / max_exact) / log(2048.0 / max_exact);
    long large = max_exact + (long)(ratio * (32 - max_exact));
    return (int)(large < 31 ? large : 31);
}
extern "C" void kernel_launch(void* const* d_in, const int* in_sizes, int n_in, void* d_out, int out_size, void* d_ws, size_t ws_size, hipStream_t stream) {
    using namespace mk;
    static int grid = 0;
    if (grid == 0) {
        if (n_in != 20 || (size_t)out_size != O_END || ws_size < WS_END) { fprintf(stderr, "kernel_launch: unexpected shapes (n_in %d out %d ws %zu need %zu)\n", n_in, out_size, ws_size, (size_t)WS_END); grid = -1; return; }
        int dev = 0, cus = 0, per_cu = 0;
        if (hipGetDevice(&dev) != hipSuccess || hipDeviceGetAttribute(&cus, hipDeviceAttributeMultiprocessorCount, dev) != hipSuccess) { grid = -1; return; }
        if (hipFuncSetAttribute((const void*)mk_fwd, hipFuncAttributeMaxDynamicSharedMemorySize, LDS_BYTES) != hipSuccess) { fprintf(stderr, "kernel_launch: hipFuncSetAttribute failed\n"); grid = -1; return; }
        if (hipOccupancyMaxActiveBlocksPerMultiprocessor(&per_cu, (const void*)mk_fwd, 512, LDS_BYTES) != hipSuccess || per_cu < 1) { fprintf(stderr, "kernel_launch: occupancy query says %d\n", per_cu); (void)hipGetLastError(); }
        grid = cus;
    }
    if (grid < 0) return;
    Params p; memset(&p, 0, sizeof(p));
    for (int i = 0; i < 20; ++i) p.in[i] = (const float*)d_in[i];
    p.out = (float*)d_out; p.ws = (unsigned char*)d_ws; p.rsq128 = 0.08838834764831845f;
    for (int i = 0; i < 64; ++i) { const double lin = (i == 63) ? 1.0 : i * (1.0 / 63.0); p.ang[i] = (float)(1.0 / pow(10000.0, lin)); }
    for (int h = 0; h < 4; ++h) p.logg[h] = (float)log(1.0 - pow(2.0, -5.0 - h));
    for (int g = 0; g < 3; ++g) for (int m = 0; m <= 128; ++m) p.bucket[g][m] = (unsigned char)t5_bucket((long)m << (2 * g));
    (void)hipMemsetAsync(d_ws, 0, CTL_BYTES, stream);
#if MK_ONE_LAUNCH
    p.ph_lo = 0; p.ph_hi = NPH; p.use_bar = 1;
    hipLaunchKernelGGL(mk_fwd, dim3(grid), dim3(512), LDS_BYTES, stream, p);
#else
    for (int ph = 0; ph < NPH; ++ph) { p.ph_lo = ph; p.ph_hi = ph + 1; p.use_bar = 0; hipLaunchKernelGGL(mk_fwd, dim3(grid), dim3(512), LDS_BYTES, stream, p); }
#endif
}
```

```cpp
#include <hip/hip_runtime.h>
#include <math.h>
#include <stdio.h>
#include <string.h>
namespace pg8 {
#define PG8_LAS __attribute__((address_space(3)))
typedef unsigned short bf16_t;
typedef short bf16x8 __attribute__((ext_vector_type(8)));
typedef float f32x4 __attribute__((ext_vector_type(4)));
typedef unsigned u32x4 __attribute__((ext_vector_type(4)));
constexpr int BM = 256, BK = 64, HALF = 128, HTB = HALF * BK * 2  , STAGE_BYTES = 8 * HTB, NXCD = 8, WGM = 8;

__host__ __device__ __forceinline__ int lds_byte(int r, int c) { const int st = (r >> 4) * 2 + (c >> 5), rr = r & 15, cc = c & 31, ob = rr * 64 + cc * 2; return st * 1024 + (ob ^ (((ob >> 9) & 1) << 5)); }
__host__ __device__ __forceinline__ void stage_rc(int b, int& R, int& C) { const int st = b / 1024, sb = b % 1024, swz = sb ^ (((sb >> 9) & 1) << 5); R = (st >> 1) * 16 + swz / 64; C = (st & 1) * 32 + (swz % 64) / 2; }
__host__ __device__ __forceinline__ int perm32(int rho) { const int n = rho >> 4, i = rho & 15; return 8 * (i >> 2) + 4 * n + (i & 3); }

struct Unit { int pm, pn; };
struct Gemm { const bf16_t* A; const bf16_t* Bt; int M, N, K; };

struct StaticOrder {
    int nM, nN, nwg, G, c;
    __host__ __device__ void init(int M, int N, int G_, int c_) { nM = M / BM; nN = N / BM; nwg = nM * nN; G = G_; c = c_; }
    __host__ __device__ bool next(int i, Unit& u) const {
        const long L = (long)i * G + c; if (L >= nwg) return false;
        int wgid = (int)L; { const int q = nwg / NXCD, r = nwg % NXCD, xcd = wgid % NXCD, off = wgid / NXCD; wgid = (xcd < r ? xcd * (q + 1) : r * (q + 1) + (xcd - r) * q) + off; }
        const int nig = WGM * nN, gid = wgid / nig, fm = gid * WGM, gsz = (nM - fm) < WGM ? (nM - fm) : WGM;
        u.pm = fm + ((wgid % nig) % gsz); u.pn = (wgid % nig) / gsz; return true;
    }
    __device__ __forceinline__ void a_ready(const Unit&) const {}
    __device__ __forceinline__ void done(const Unit&) const {}
};
__device__ __forceinline__ unsigned cvt_pk_bf16(float lo, float hi) { unsigned r; asm volatile("v_cvt_pk_bf16_f32 %0, %1, %2" : "=v"(r) : "v"(lo), "v"(hi)); return r; }
template <class Epi, class Sched, bool STAMP = false>
__device__ __forceinline__ void gemm_phase(PG8_LAS unsigned char* lds, const Gemm g, const Sched& S, const Epi& E, unsigned long long* stamps, int tid_in) {
    int tid_ = tid_in; asm volatile("" : "+v"(tid_));
    const int tid = tid_, wid = __builtin_amdgcn_readfirstlane(tid >> 6), lane = tid & 63, wr = wid >> 2, wc = wid & 3, fr = lane & 15, fq = lane >> 4;
    const int K = g.K, nt = K / BK;
    int ts_lo = 0, ts_hi = 0, nts = 0; const unsigned long long rt_entry = STAMP ? (unsigned long long)wall_clock64() : 0ull;
#define PG8_STAMP() do { if (STAMP && wid == 0 && nts < 64) { const unsigned long long _c = (unsigned long long)clock64(); \
        ts_lo = (lane == nts) ? (int)(unsigned)_c : ts_lo; ts_hi = (lane == nts) ? (int)(unsigned)(_c >> 32) : ts_hi; ++nts; } } while (0)
    PG8_STAMP();
    unsigned voffA[2], voffB[2];
#pragma unroll
    for (int i = 0; i < 2; ++i) { int R, C; stage_rc(tid * 16 + i * 8192, R, C); const int Rb = Epi::PERM ? ((R & ~31) + perm32(R & 31)) : R;
        voffA[i] = (unsigned)(R * K + C) * 2u; voffB[i] = (unsigned)(Rb * K + C) * 2u; }
    const size_t kstep = (size_t)(BK * 2);
    const size_t hstep = (size_t)HALF * K * 2;
    const size_t tstep = 2 * hstep;
    const unsigned ldsw = (unsigned)wid * 1024u;
    const int aoff = lds_byte(wr * 64 + fr, fq * 8), boff = lds_byte(wc * 32 + fr, fq * 8);
#define PG8_SA(b, h) (((b) * 2 + (h)) * HTB)
#define PG8_SB(b, h) ((4 + (b) * 2 + (h)) * HTB)
#define PG8_STAGE(bufoff, gbase, voff) do { _Pragma("unroll") for (int _i = 0; _i < 2; ++_i) \
        __builtin_amdgcn_global_load_lds((const unsigned*)((const char*)(gbase) + (voff)[_i]), (PG8_LAS unsigned*)(lds + (bufoff) + ldsw + _i * 8192), 16, 0, 0); } while (0)
#define PG8_LDA(dst, b, h) do { _Pragma("unroll") for (int m = 0; m < 4; ++m) _Pragma("unroll") for (int k = 0; k < 2; ++k) dst[m][k] = *(const PG8_LAS bf16x8*)(lds + PG8_SA(b, h) + aoff + m * 2048 + k * 1024); } while (0)
#define PG8_LDB(dst, b, h) do { _Pragma("unroll") for (int n = 0; n < 2; ++n) _Pragma("unroll") for (int k = 0; k < 2; ++k) dst[n][k] = *(const PG8_LAS bf16x8*)(lds + PG8_SB(b, h) + boff + n * 2048 + k * 1024); } while (0)
#define PG8_MMA(ai, bj, At, Bt) do { __builtin_amdgcn_s_setprio(1); _Pragma("unroll") for (int m = 0; m < 4; ++m) _Pragma("unroll") for (int n = 0; n < 2; ++n) _Pragma("unroll") for (int k = 0; k < 2; ++k) \
        acc[ai][bj][m][n] = __builtin_amdgcn_mfma_f32_16x16x32_bf16(Bt[n][k], At[m][k], acc[ai][bj][m][n], 0, 0, 0); __builtin_amdgcn_s_setprio(0); } while (0)
#define PG8_WAIT_V(n) asm volatile("s_waitcnt vmcnt(" #n ")" ::: "memory")
#define PG8_WAIT_L(n) asm volatile("s_waitcnt lgkmcnt(" #n ")" ::: "memory")
#define PG8_BAR __builtin_amdgcn_s_barrier()
#define PG8_SCHED __builtin_amdgcn_sched_barrier(0)
    Unit cur, nxt; int ui = 0;
    if (!S.next(0, cur)) return;
    f32x4 acc[2][2][4][2];
#pragma unroll
    for (int a = 0; a < 2; ++a)
#pragma unroll
        for (int b = 0; b < 2; ++b)
#pragma unroll
            for (int m = 0; m < 4; ++m)
#pragma unroll
                for (int n = 0; n < 2; ++n) acc[a][b][m][n] = (f32x4){0.f, 0.f, 0.f, 0.f};
    bf16x8 At[4][2], B0[2][2], B1[2][2];
    const char* cA = (const char*)g.A + (size_t)cur.pm * tstep; const char* cB = (const char*)g.Bt + (size_t)cur.pn * tstep;
    S.a_ready(cur);
    PG8_STAGE(PG8_SB(0, 0), cB, voffB); PG8_STAGE(PG8_SA(0, 0), cA, voffA); PG8_STAGE(PG8_SB(0, 1), cB + hstep, voffB); PG8_STAGE(PG8_SA(0, 1), cA + hstep, voffA);
    if (wr == 1) PG8_BAR;
    PG8_WAIT_V(4); PG8_BAR;
    PG8_STAGE(PG8_SB(1, 0), cB + kstep, voffB); PG8_STAGE(PG8_SA(1, 0), cA + kstep, voffA); PG8_STAGE(PG8_SB(1, 1), cB + hstep + kstep, voffB);
    PG8_WAIT_V(6); PG8_BAR;
    PG8_STAMP();
    for (;;) {
        const bool has_next = S.next(ui + 1, nxt);
        const char* nA = has_next ? (const char*)g.A + (size_t)nxt.pm * tstep : cA; const char* nB = has_next ? (const char*)g.Bt + (size_t)nxt.pn * tstep : cB;
        for (int t = 0; t < nt; t += 2) {
            const bool last = (t == nt - 2);
            const char* a1 = cA + (size_t)(t + 1) * kstep;
            const char* a2 = last ? nA : cA + (size_t)(t + 2) * kstep; const char* b2 = last ? nB : cB + (size_t)(t + 2) * kstep;
            const char* a3 = a2 + kstep; const char* b3 = b2 + kstep;
            if (last && has_next) S.a_ready(nxt);
            PG8_LDB(B0, 0, 0); PG8_SCHED; PG8_LDA(At, 0, 0); PG8_STAGE(PG8_SA(1, 1), a1 + hstep, voffA);
            PG8_WAIT_L(8); PG8_BAR; PG8_WAIT_L(0); PG8_MMA(0, 0, At, B0); PG8_BAR; PG8_SCHED;
            PG8_LDB(B1, 0, 1); PG8_STAGE(PG8_SB(0, 0), b2, voffB);
            PG8_BAR; PG8_WAIT_L(0); PG8_MMA(0, 1, At, B1); PG8_BAR;
            PG8_LDA(At, 0, 1); PG8_STAGE(PG8_SA(0, 0), a2, voffA);
            PG8_BAR; PG8_WAIT_L(0); PG8_MMA(1, 0, At, B0); PG8_BAR; PG8_SCHED;
            PG8_STAGE(PG8_SB(0, 1), b2 + hstep, voffB);
            PG8_WAIT_V(6); PG8_BAR; PG8_MMA(1, 1, At, B1); PG8_BAR;
            PG8_LDB(B0, 1, 0); PG8_SCHED; PG8_LDA(At, 1, 0); PG8_STAGE(PG8_SA(0, 1), a2 + hstep, voffA);
            PG8_WAIT_L(8); PG8_BAR; PG8_WAIT_L(0); PG8_MMA(0, 0, At, B0); PG8_BAR; PG8_SCHED;
            PG8_LDB(B1, 1, 1); PG8_STAGE(PG8_SB(1, 0), b3, voffB);
            PG8_BAR; PG8_WAIT_L(0); PG8_MMA(0, 1, At, B1); PG8_BAR;
            PG8_LDA(At, 1, 1); PG8_STAGE(PG8_SA(1, 0), a3, voffA);
            PG8_BAR; PG8_WAIT_L(0); PG8_MMA(1, 0, At, B0); PG8_BAR; PG8_SCHED;
            PG8_STAGE(PG8_SB(1, 1), b3 + hstep, voffB);
            PG8_WAIT_V(6); PG8_BAR; PG8_MMA(1, 1, At, B1); PG8_BAR;
        }
        PG8_STAMP();
        if constexpr (!Epi::AFTER_DRAIN) { E(acc, cur, wr, wc, fr, fq); S.done(cur); }
        PG8_STAMP();
        if (!has_next) break;
#pragma unroll
        for (int a = 0; a < 2; ++a)
#pragma unroll
            for (int b = 0; b < 2; ++b)
#pragma unroll
                for (int m = 0; m < 4; ++m)
#pragma unroll
                    for (int n = 0; n < 2; ++n) acc[a][b][m][n] = (f32x4){0.f, 0.f, 0.f, 0.f};
        cur = nxt; cA = nA; cB = nB; ++ui;
    }
    PG8_WAIT_V(0);
    if (wr == 0) PG8_BAR;
    PG8_BAR;
    if constexpr (Epi::AFTER_DRAIN) { E.fused(acc, cur, wr, wc, fr, fq, lds, wid, lane); S.done(cur); }
    PG8_STAMP();
    if (STAMP && wid == 0) { stamps[lane] = lane < nts ? (((unsigned long long)(unsigned)ts_hi << 32) | (unsigned)ts_lo) : 0ull;
        if (lane == 62) stamps[62] = rt_entry; if (lane == 63) stamps[63] = (unsigned long long)wall_clock64(); }
#undef PG8_STAMP
#undef PG8_SA
#undef PG8_SB
#undef PG8_STAGE
#undef PG8_LDA
#undef PG8_LDB
#undef PG8_MMA
#undef PG8_WAIT_V
#undef PG8_WAIT_L
#undef PG8_BAR
#undef PG8_SCHED
}
}

#define XB_TMO      128
#define XB_XCNT(j)  (256  + 64 * (j))
#define XB_XSUB(j)  (1280 + 64 * (j))
#define XB_XGEN(j)  (2304 + 64 * (j))
#define XB_TOP      3328
#define XB_TOPGEN   3392
#define XCD_BAR_WORDS 3456
#define XB_SPIN_CAP (1u << 18)
#define LAS __attribute__((address_space(3)))

__device__ __forceinline__ unsigned xb_ld(unsigned* p)              { return __hip_atomic_load(p, __ATOMIC_RELAXED, __HIP_MEMORY_SCOPE_AGENT); }
__device__ __forceinline__ unsigned xb_add(unsigned* p, unsigned v) { return __hip_atomic_fetch_add(p, v, __ATOMIC_RELAXED, __HIP_MEMORY_SCOPE_AGENT); }
__device__ __forceinline__ unsigned xb_xcc_id() { return (unsigned)__builtin_amdgcn_s_getreg((3 << 11) | 20) & 0xFu; }
#define XB_SPIN(cond, bar) do { unsigned _sp = 0; while (cond) { __builtin_amdgcn_s_sleep(1); \
    if ((++_sp & 255u) == 0u) { if (xb_ld(&(bar)[XB_TMO])) break; if (_sp > XB_SPIN_CAP) { atomicAdd(&(bar)[XB_TMO], 1u); break; } } } } while (0)

struct XcdBarrier {
    int wv;
    unsigned* bar; unsigned x;
    volatile LAS unsigned* st;
};

__device__ __forceinline__ unsigned xb_lane() { unsigned l; asm volatile("v_mbcnt_lo_u32_b32 %0, -1, 0\n\tv_mbcnt_hi_u32_b32 %0, -1, %0" : "=v"(l)); return l; }
__device__ __forceinline__ XcdBarrier xcd_barrier_post(unsigned* bar, volatile LAS unsigned* st, int wv) {
    XcdBarrier b; b.wv = wv; b.bar = bar; b.x = xb_xcc_id(); b.st = st;
    if (wv == 0 && xb_lane() == 0u) (void)xb_add(&bar[XB_XCNT(b.x)], 1u);
    return b;
}
__device__ __forceinline__ void xcd_barrier_complete(unsigned* bar, unsigned x, unsigned& nloc, unsigned& nx) {
    const unsigned G = gridDim.x * gridDim.y * gridDim.z;
    unsigned sum, cnt, mine, sp = 0u;
    for (;;) {
        sum = 0u; cnt = 0u; mine = 0u;
#pragma unroll
        for (unsigned j = 0; j < 16; ++j) { const unsigned c = xb_ld(&bar[XB_XCNT(j)]); sum += c; cnt += (c > 0u) ? 1u : 0u; mine = (j == x) ? c : mine; }
        if (sum == G) break;
        __builtin_amdgcn_s_sleep(1);
        if ((++sp & 255u) == 0u) { if (xb_ld(&bar[XB_TMO])) break; if (sp > XB_SPIN_CAP) { atomicAdd(&bar[XB_TMO], 1u); break; } }
    }
    nloc = mine > 0u ? mine : 1u; nx = cnt > 0u ? cnt : 1u;
}

__device__ __forceinline__ void xcd_barrier(const XcdBarrier& b) {
    asm volatile("s_waitcnt vmcnt(0)" ::: "memory");
    __syncthreads();
    if (b.wv == 0 && xb_lane() == 0u) {
        unsigned* bar = b.bar;
        __builtin_amdgcn_s_waitcnt(0);
        unsigned nloc = b.st[0], nx = b.st[1];
        if (nloc == 0u) { xcd_barrier_complete(bar, b.x, nloc, nx); b.st[0] = nloc; b.st[1] = nx; }
        const unsigned old = xb_add(&bar[XB_XSUB(b.x)], 1u);
        const unsigned gen = old / nloc;
        if (old + 1u == (gen + 1u) * nloc) {
            __builtin_amdgcn_fence(__ATOMIC_RELEASE, "agent");
            asm volatile("s_waitcnt vmcnt(0)" ::: "memory");
            const unsigned og = xb_add(&bar[XB_TOP], 1u);
            const unsigned tg = og / nx;
            if (og + 1u == (tg + 1u) * nx) xb_add(&bar[XB_TOPGEN], 1u);
            else XB_SPIN(xb_ld(&bar[XB_TOPGEN]) == tg, bar);
            __builtin_amdgcn_fence(__ATOMIC_ACQUIRE, "agent");
            xb_add(&bar[XB_XGEN(b.x)], 1u);
            asm volatile("s_waitcnt vmcnt(0)" ::: "memory");
        } else {
            XB_SPIN(xb_ld(&bar[XB_XGEN(b.x)]) == gen, bar);
            __builtin_amdgcn_fence(__ATOMIC_ACQUIRE, "agent");
            asm volatile("s_waitcnt vmcnt(0)" ::: "memory");
        }
    }
    __syncthreads();
}


namespace mk {
using pg8::bf16_t; using pg8::bf16x8; using pg8::f32x4; using pg8::u32x4;
typedef unsigned u32x2 __attribute__((ext_vector_type(2)));
typedef short s16x4 __attribute__((ext_vector_type(4)));
typedef int i32x4 __attribute__((ext_vector_type(4)));
typedef __bf16 bf2_t __attribute__((ext_vector_type(2)));
typedef float f32x2 __attribute__((ext_vector_type(2)));
typedef float f32x16 __attribute__((ext_vector_type(16)));
typedef float f32x32 __attribute__((ext_vector_type(32)));
typedef unsigned u32x6 __attribute__((ext_vector_type(6)));

constexpr int DM = 1024, NP = 16384, NSMP = 32, NR = NP + NSMP, INC = 9728, NLAYER = 2;
constexpr int C_QA = 0, C_KA = 1536, C_VA = 3072, C_QR = 4608, C_KR = 5120, C_VR = 5632, C_GR = 6656, C_GA = 7680, C_GB = 8704;
constexpr float EPS = 1e-6f;
constexpr int LDS_BYTES = 162816, LDS_BAR = 162800;

constexpr size_t al256(size_t x) { return (x + 255) & ~(size_t)255; }
constexpr size_t WS_CTL = 0, CTL_BYTES = 65536;
constexpr size_t SZ_WTIN = (size_t)INC * DM * 2, SZ_WTOA = (size_t)DM * 512 * 2, SZ_WSQ = (size_t)DM * DM * 2, SZ_WTS = (size_t)2048 * DM * 2, SZ_TAB = (size_t)16384 * DM * 2;
constexpr size_t WS_WTIN = WS_CTL + CTL_BYTES;
constexpr size_t WS_WTOA = WS_WTIN + NLAYER * SZ_WTIN;
constexpr size_t WS_WTOR = WS_WTOA + NLAYER * SZ_WTOA;
constexpr size_t WS_WTOUT = WS_WTOR + NLAYER * SZ_WSQ;
constexpr size_t WS_WTS = WS_WTOUT + NLAYER * SZ_WSQ;
constexpr size_t WS_UBF = WS_WTS + NLAYER * SZ_WTS;
constexpr size_t WS_VBF = WS_UBF + NLAYER * SZ_TAB;
constexpr size_t WS_XRES = WS_VBF + NLAYER * SZ_TAB;
constexpr size_t WS_H = WS_XRES + al256((size_t)NR * DM * 4);
constexpr size_t WS_H2 = WS_H + al256((size_t)NR * DM * 2);
constexpr size_t WS_Z = WS_H2 + al256((size_t)NR * DM * 2);
constexpr size_t ZO_A = 0;
constexpr size_t ZO_RQ = ZO_A + (size_t)NP * 4608;
constexpr size_t ZO_RK = ZO_RQ + (size_t)NP * 512;
constexpr size_t ZO_RV = ZO_RK + (size_t)NP * 512;
constexpr size_t ZO_GR = ZO_RV + (size_t)NP * 1024;
constexpr size_t ZO_GA = ZO_GR + (size_t)NP * 1024;
constexpr size_t ZO_GB = ZO_GA + (size_t)NP * 1024;
static_assert(ZO_GB + (size_t)NP * 1024 == (size_t)NP * INC, "compact layouts fill the prompt part of Z exactly");
constexpr size_t WS_OG = WS_Z + al256((size_t)NR * INC * 2);
constexpr size_t WS_LSE = WS_OG + al256((size_t)3 * NR * 512 * 2);
constexpr size_t WS_AO = WS_LSE + al256((size_t)3 * NR * 4 * 4);
constexpr size_t WS_RU = WS_AO + al256((size_t)NR * 512 * 2);
constexpr size_t WS_RS = WS_RU + (size_t)2 * 64 * 4 * 32768 * 4;
constexpr size_t WS_ORET = WS_RS + (size_t)2 * 64 * 4 * 32768 * 2;
constexpr size_t WS_MIX1 = WS_ORET + al256((size_t)NR * DM * 2);
constexpr size_t WS_MIXED = WS_MIX1 + al256((size_t)NR * DM * 4);
constexpr size_t WS_SC = WS_MIXED + al256((size_t)NR * DM * 2);
constexpr size_t WS_TSC = WS_SC + al256((size_t)NR * 2048 * 4);
constexpr size_t WS_CS = WS_TSC + (size_t)4 * 16384 * 4;
constexpr size_t WS_BT = WS_CS + al256((size_t)8193 * 64 * 8);
constexpr size_t WS_END = WS_BT + al256((size_t)12 * 132 * 4);
constexpr size_t SZ_TAB8 = (size_t)16384 * DM;
constexpr size_t SZ_TAB6 = (size_t)16384 * 768;

constexpr size_t O_YP = 0, O_YS = O_YP + (size_t)NP * DM, O_KV1P = O_YS + (size_t)NSMP * DM;
constexpr size_t O_KV4P = O_KV1P + (size_t)2 * 2 * 128 * 1024, O_KV16P = O_KV4P + (size_t)2 * 2 * 512 * 1024, O_RETP = O_KV16P + (size_t)2 * 2 * 2048 * 1024;
constexpr size_t O_KV1S = O_RETP + (size_t)2 * 2 * 4 * 32768, O_KV4S = O_KV1S + 65536, O_KV16S = O_KV4S + 65536, O_RETS = O_KV16S + 65536;
constexpr size_t O_END = O_RETS + (size_t)2 * 32 * 4 * 32768;

struct Params {
    const float* in[20]; float* out; unsigned char* ws;
    float ang[64]; float logg[4];
    unsigned char bucket[3][132]; unsigned char padb[4];
    int ph_lo, ph_hi, use_bar; float rsq128;
};
static_assert(sizeof(Params) == 20 * 8 + 16 + 256 + 16 + 400 + 16, "Params has holes");

__device__ __forceinline__ unsigned pkbf(float lo, float hi) { unsigned r; asm("v_cvt_pk_bf16_f32 %0, %1, %2" : "=v"(r) : "v"(lo), "v"(hi)); return r; }
__device__ __forceinline__ float bflo(unsigned u) { return __uint_as_float(u << 16); }
__device__ __forceinline__ float bfhi(unsigned u) { return __uint_as_float(u & 0xffff0000u); }
__device__ __forceinline__ float bf1(bf16_t u) { return __uint_as_float(((unsigned)u) << 16); }
__device__ __forceinline__ bf16_t tobf1(float f) { return (bf16_t)(pkbf(f, 0.f) & 0xffffu); }
__device__ __forceinline__ float tobf1f(float f) { return __uint_as_float(pkbf(f, 0.f) << 16); }
__device__ __forceinline__ unsigned offb(unsigned row, unsigned ch) { return 256u * row + 16u * (ch ^ (((row & 3u) << 2) | ((row >> 2) & 3u))); }
__device__ __forceinline__ s16x4 trr(LAS unsigned char* p) { return __builtin_amdgcn_ds_read_tr16_b64_v4i16((LAS s16x4*)p); }
__device__ __forceinline__ bf16x8 cat4(s16x4 a, s16x4 b) { bf16x8 r; r[0] = a[0]; r[1] = a[1]; r[2] = a[2]; r[3] = a[3]; r[4] = b[0]; r[5] = b[1]; r[6] = b[2]; r[7] = b[3]; return r; }
__device__ __forceinline__ bf16x8 pack8(f32x4 a, f32x4 b) { u32x4 w; w.x = pkbf(a[0], a[1]); w.y = pkbf(a[2], a[3]); w.z = pkbf(b[0], b[1]); w.w = pkbf(b[2], b[3]); return __builtin_bit_cast(bf16x8, w); }
__device__ __forceinline__ f32x4 mfma16(bf16x8 a, bf16x8 b, f32x4 c) { return __builtin_amdgcn_mfma_f32_16x16x32_bf16(a, b, c, 0, 0, 0); }
__device__ __forceinline__ float shx(float v, int m) {
    const int x = __float_as_int(v); int r;
    switch (m) {
        case 1: r = __builtin_amdgcn_ds_swizzle(x, (1 << 10) | 0x1f); break;
        case 2: r = __builtin_amdgcn_ds_swizzle(x, (2 << 10) | 0x1f); break;
        case 4: r = __builtin_amdgcn_ds_swizzle(x, (4 << 10) | 0x1f); break;
        case 8: r = __builtin_amdgcn_ds_swizzle(x, (8 << 10) | 0x1f); break;
        case 16: r = __builtin_amdgcn_ds_swizzle(x, (16 << 10) | 0x1f); break;
        default: { const u32x2 p = __builtin_amdgcn_permlane32_swap((unsigned)x, (unsigned)x, false, false); r = (int)(xb_lane() < 32u ? p.y : p.x); } break;
    }
    return __int_as_float(r);
}
__device__ __forceinline__ float wsum64(float v) { v += shx(v, 32); v += shx(v, 16); v += shx(v, 8); v += shx(v, 4); v += shx(v, 2); v += shx(v, 1); return v; }
__device__ __forceinline__ float sigmoidf_(float x) { return 1.f / (1.f + __expf(-x)); }
__device__ __forceinline__ int med3i(int a, int b, int c) { int r; asm("v_med3_i32 %0, %1, %2, %3" : "=v"(r) : "v"(a), "v"(b), "v"(c)); return r; }
__device__ __forceinline__ int sortable(float x) { const int b = __float_as_int(x); return b ^ ((b >> 31) & 0x7fffffff); }
__device__ __forceinline__ float unsortable(int s) { return __int_as_float(s ^ ((s >> 31) & 0x7fffffff)); }
__device__ __forceinline__ void ins16(int (&sv)[16], int x) {
#pragma unroll
    for (int i = 15; i >= 1; --i) sv[i] = med3i(sv[i - 1], sv[i], x);
    sv[0] = sv[0] > x ? sv[0] : x;
}
__device__ __forceinline__ float dot2bf(unsigned a, unsigned b, float c) { return __builtin_amdgcn_fdot2_f32_bf16(__builtin_bit_cast(bf2_t, a), __builtin_bit_cast(bf2_t, b), c, false); }

template <class Q> struct EpiQuad {
    static constexpr bool PERM = false, AFTER_DRAIN = false;
    Q q;
    __device__ __forceinline__ void operator()(const f32x4 (&acc)[2][2][4][2], const pg8::Unit& u, int wr, int wc, int fr, int fq) const {
        const int row0 = u.pm * 256 + wr * 64 + fr, col0 = u.pn * 256 + wc * 32 + 4 * fq;
#pragma unroll
        for (int ai = 0; ai < 2; ++ai)
#pragma unroll
            for (int m = 0; m < 4; ++m)
#pragma unroll
                for (int bj = 0; bj < 2; ++bj)
#pragma unroll
                    for (int n = 0; n < 2; ++n) { q.quad(row0 + ai * 128 + m * 16, col0 + bj * 128 + n * 16, acc[ai][bj][m][n]); if (Q::FENCE) asm volatile("" ::: "memory"); }
    }
};
template <class Q, int MB  > struct EpiQuadB {
    static constexpr bool PERM = false, AFTER_DRAIN = false;
    Q q;
    __device__ __forceinline__ void operator()(const f32x4 (&acc)[2][2][4][2], const pg8::Unit& u, int wr, int wc, int fr, int fq) const {
        const int row0 = u.pm * 256 + wr * 64 + fr, col0 = u.pn * 256 + wc * 32 + 4 * fq;
#pragma unroll
        for (int ai = 0; ai < 2; ++ai)
#pragma unroll
            for (int mp = 0; mp < 4 / MB; ++mp) { typename Q::L ld[MB][2][2];
#pragma unroll
                for (int mm = 0; mm < MB; ++mm)
#pragma unroll
                    for (int bj = 0; bj < 2; ++bj)
#pragma unroll
                        for (int n = 0; n < 2; ++n) ld[mm][bj][n] = q.load(row0 + ai * 128 + (MB * mp + mm) * 16, col0 + bj * 128 + n * 16);
                __builtin_amdgcn_sched_barrier(0);
#pragma unroll
                for (int mm = 0; mm < MB; ++mm)
#pragma unroll
                    for (int bj = 0; bj < 2; ++bj)
#pragma unroll
                        for (int n = 0; n < 2; ++n) q.fin(row0 + ai * 128 + (MB * mp + mm) * 16, col0 + bj * 128 + n * 16, acc[ai][bj][MB * mp + mm][n], ld[mm][bj][n]);
                asm volatile("" ::: "memory"); }
    }
};
struct QZ { static constexpr bool FENCE = false; bf16_t* Z; const float* bg;
    __device__ __forceinline__ void quad(int row, int col, f32x4 v) const {
        if (col >= C_GA) { const f32x4 b = *(const f32x4*)(bg + (col - C_GA)); v[0] = sigmoidf_(v[0] + b[0]); v[1] = sigmoidf_(v[1] + b[1]); v[2] = sigmoidf_(v[2] + b[2]); v[3] = sigmoidf_(v[3] + b[3]); }
        u32x2 w; w.x = pkbf(v[0], v[1]); w.y = pkbf(v[2], v[3]); *(u32x2*)(Z + (size_t)row * INC + col) = w; } };
struct EpiZ {
    static constexpr bool PERM = true, AFTER_DRAIN = false;
    bf16_t* Z; const float* bg;
    __device__ __forceinline__ void operator()(const f32x4 (&acc)[2][2][4][2], const pg8::Unit& u, int wr, int wc, int fr, int fq) const {
        const int pn = u.pn; const bool gate = pn >= 30;
        size_t base; int rs, bjs, dsh = 0;
        if (pn < 18) { const int which = pn / 6, g = (pn % 6) >> 1; dsh = 2 * g; base = ZO_A + (size_t)(((which * 3 + g) * 4 + 2 * (pn & 1)) * 2) * 8192 * 128; rs = 128; bjs = 2 * 8192 * 128; }
        else if (pn < 22) { base = (pn < 20 ? ZO_RQ : ZO_RK) + (size_t)(2 * (pn & 1)) * NP * 128; rs = 128; bjs = NP * 128; }
        else if (pn < 30) { base = (pn < 26 ? ZO_RV + (size_t)(pn - 22) * NP * 256 : ZO_GR + (size_t)(pn - 26) * NP * 256); rs = 256; bjs = 128; }
        else { base = (pn < 34 ? ZO_GA + (size_t)(pn - 30) * 256 : ZO_GB + (size_t)(pn - 34) * 256); rs = 1024; bjs = 128; }
        const int row0 = u.pm * 256 + wr * 64 + fr, dim = wc * 32 + 8 * fq, col0 = pn * 256 + dim;
#pragma unroll
        for (int bj = 0; bj < 2; ++bj) {
            f32x4 b0 = {0.f, 0.f, 0.f, 0.f}, b1 = {0.f, 0.f, 0.f, 0.f};
            if (gate) { b0 = *(const f32x4*)(bg + (col0 + bj * 128 - C_GA)); b1 = *(const f32x4*)(bg + (col0 + bj * 128 - C_GA) + 4); }
#pragma unroll
            for (int ai = 0; ai < 2; ++ai)
#pragma unroll
                for (int m = 0; m < 4; ++m) { f32x4 v0 = acc[ai][bj][m][0], v1 = acc[ai][bj][m][1];
                    if (gate) { v0[0] = sigmoidf_(v0[0] + b0[0]); v0[1] = sigmoidf_(v0[1] + b0[1]); v0[2] = sigmoidf_(v0[2] + b0[2]); v0[3] = sigmoidf_(v0[3] + b0[3]);
                                v1[0] = sigmoidf_(v1[0] + b1[0]); v1[1] = sigmoidf_(v1[1] + b1[1]); v1[2] = sigmoidf_(v1[2] + b1[2]); v1[3] = sigmoidf_(v1[3] + b1[3]); }
                    u32x4 w; w.x = pkbf(v0[0], v0[1]); w.y = pkbf(v0[2], v0[3]); w.z = pkbf(v1[0], v1[1]); w.w = pkbf(v1[2], v1[3]);
                    const int row = row0 + ai * 128 + m * 16, t = row & 8191, rt = (row & ~8191) + ((t & ((1 << dsh) - 1)) << (13 - dsh)) + (t >> dsh);
                    *(u32x4*)(Z + base + (size_t)rt * rs + bj * bjs + dim) = w; } }
    }
};
struct QGateA { static constexpr bool FENCE = true; const bf16_t* Z; float* M1;
    typedef u32x2 L;
    __device__ __forceinline__ L load(int row, int col) const { return *(const u32x2*)(row < NP ? Z + ZO_GA + (size_t)row * 1024 + col : Z + (size_t)row * INC + C_GA + col); }
    __device__ __forceinline__ void fin(int row, int col, f32x4 v, L g) const { u32x2 o; o.x = pkbf(bflo(g.x) * v[0], bfhi(g.x) * v[1]); o.y = pkbf(bflo(g.y) * v[2], bfhi(g.y) * v[3]); *(u32x2*)((bf16_t*)M1 + (size_t)row * DM + col) = o; }
    __device__ __forceinline__ void quad(int row, int col, f32x4 v) const { fin(row, col, v, load(row, col)); } };
struct QGateB { static constexpr bool FENCE = true; const bf16_t* Z; const float* M1; bf16_t* MX;
    struct L { u32x2 g; u32x2 m; };
    __device__ __forceinline__ L load(int row, int col) const { L l; l.g = *(const u32x2*)(row < NP ? Z + ZO_GB + (size_t)row * 1024 + col : Z + (size_t)row * INC + C_GB + col); l.m = *(const u32x2*)((const bf16_t*)M1 + (size_t)row * DM + col); return l; }
    __device__ __forceinline__ void fin(int row, int col, f32x4 v, L l) const { u32x2 w; w.x = pkbf(bflo(l.m.x) + bflo(l.g.x) * v[0], bfhi(l.m.x) + bfhi(l.g.x) * v[1]); w.y = pkbf(bflo(l.m.y) + bflo(l.g.y) * v[2], bfhi(l.m.y) + bfhi(l.g.y) * v[3]); *(u32x2*)(MX + (size_t)row * DM + col) = w; }
    __device__ __forceinline__ void quad(int row, int col, f32x4 v) const { fin(row, col, v, load(row, col)); } };
struct QRes { static constexpr bool FENCE = true; const float* Xp; const float* Xs; float* X;
    typedef f32x4 L;
    __device__ __forceinline__ L load(int row, int col) const { return *(const f32x4*)(row < NP ? Xp + (size_t)row * DM + col : Xs + (size_t)(row - NP) * DM + col); }
    __device__ __forceinline__ void fin(int row, int col, f32x4 v, L x) const { *(f32x4*)(X + (size_t)row * DM + col) = x + v; }
    __device__ __forceinline__ void quad(int row, int col, f32x4 v) const { fin(row, col, v, load(row, col)); } };
struct QKey { static constexpr bool FENCE = false; int* SC;
    __device__ __forceinline__ void quad(int row, int col, f32x4 v) const {
        i32x4 k; const int kb = 127 - (col & 127);
        k[0] = (sortable(v[0]) & ~127) | kb; k[1] = (sortable(v[1]) & ~127) | (kb - 1); k[2] = (sortable(v[2]) & ~127) | (kb - 2); k[3] = (sortable(v[3]) & ~127) | (kb - 3);
        *(i32x4*)(SC + ((size_t)(row >> 4) * 512 + (col >> 2)) * 64 + (row & 15) * 4) = k; } };

template <class Q> __device__ __forceinline__ void skinny(const bf16_t* Hs, const bf16_t* Bt, int N, int K, const Q& q, int gw, int nw, int lane_) {
    int lane = lane_; asm volatile("" : "+v"(lane));
    const int fr = lane & 15, fq = lane >> 4;
    for (int t = gw; t < (N >> 3); t += nw) { const int ct = t >> 1, rh = t & 1;
        f32x4 a0 = {0.f, 0.f, 0.f, 0.f};
        const bf16_t* bp = Bt + (size_t)(ct * 16 + fr) * K + fq * 8; const bf16_t* h0 = Hs + (size_t)(rh * 16 + fr) * K + fq * 8;
        bf16x8 wa[8], xa[8], wb[8], xb[8];
#pragma unroll
        for (int j = 0; j < 8; ++j) { wa[j] = *(const bf16x8*)(bp + 32 * j); xa[j] = *(const bf16x8*)(h0 + 32 * j); }
#pragma unroll
        for (int c = 0; c < K / 256; ++c) {
            if (c + 1 < K / 256) {
#pragma unroll
                for (int j = 0; j < 8; ++j) { const bf16x8 tw = *(const bf16x8*)(bp + 256 * (c + 1) + 32 * j), tx = *(const bf16x8*)(h0 + 256 * (c + 1) + 32 * j); if (c & 1) { wa[j] = tw; xa[j] = tx; } else { wb[j] = tw; xb[j] = tx; } } }
            __builtin_amdgcn_sched_barrier(0);
#pragma unroll
            for (int j = 0; j < 8; ++j) a0 = (c & 1) ? mfma16(wb[j], xb[j], a0) : mfma16(wa[j], xa[j], a0);
            __builtin_amdgcn_sched_barrier(0);
        }
        q.quad(NP + rh * 16 + fr, ct * 16 + 4 * fq, a0);
    }
}
template <class Q> __device__ __forceinline__ void skinny8(const bf16_t* Hs, const bf16_t* Bt, int N, int K, const Q& q, int ublk, int nblk, int w, int lane_, LAS unsigned char* lds) {
    int lane = lane_; asm volatile("" : "+v"(lane));
    const int fr = lane & 15, fq = lane >> 4; LAS f32x4* part = (LAS f32x4*)lds;
    for (int t = ublk; t < (N >> 3); t += nblk) { const int ct = t >> 1, rh = t & 1, ks = K >> 3;
        const bf16_t* bp = Bt + (size_t)(ct * 16 + fr) * K + w * ks + fq * 8; const bf16_t* h0 = Hs + (size_t)(rh * 16 + fr) * K + w * ks + fq * 8;
        bf16x8 wv[4], xv[4];
#pragma unroll
        for (int j = 0; j < 4; ++j) if (j < K / 256) { wv[j] = *(const bf16x8*)(bp + 32 * j); xv[j] = *(const bf16x8*)(h0 + 32 * j); }
        __builtin_amdgcn_sched_barrier(0);
        f32x4 a0 = {0.f, 0.f, 0.f, 0.f};
#pragma unroll
        for (int j = 0; j < 4; ++j) if (j < K / 256) a0 = mfma16(wv[j], xv[j], a0);
        __syncthreads();
        part[w * 64 + lane] = a0;
        __syncthreads();
        if (w == 0) { f32x4 a = part[lane];
#pragma unroll
            for (int ww = 1; ww < 8; ++ww) a += part[ww * 64 + lane];
            q.quad(NP + rh * 16 + fr, ct * 16 + 4 * fq, a); }
        __syncthreads();
    }
}

__device__ __forceinline__ void tconv_tile(const float* src, int K, int N, bf16_t* dst, int tile, LAS float* T, int tid) {
    const int ntn = N >> 6, tk = tile / ntn, tn = tile - tk * ntn, k0 = tk * 64, n0 = tn * 64;
#pragma unroll
    for (int i = 0; i < 2; ++i) { const int idx = tid + 512 * i, kr = idx >> 4, c4 = idx & 15; const float4 v = *(const float4*)(src + (size_t)(k0 + kr) * N + n0 + c4 * 4);
        LAS float* t = T + kr * 65 + c4 * 4; t[0] = v.x; t[1] = v.y; t[2] = v.z; t[3] = v.w; }
    __syncthreads();
    { const int n = tid >> 3, kq = tid & 7; float f[8];
#pragma unroll
      for (int i = 0; i < 8; ++i) f[i] = T[(kq * 8 + i) * 65 + n];
      u32x4 w; w.x = pkbf(f[0], f[1]); w.y = pkbf(f[2], f[3]); w.z = pkbf(f[4], f[5]); w.w = pkbf(f[6], f[7]);
      *(u32x4*)(dst + (size_t)(n0 + n) * K + k0 + kq * 8) = w; }
    __syncthreads();
}
__device__ __forceinline__ void wts_unit(const float* pwq, const float* sk, bf16_t* WtS, int hp, int dt, LAS float* skc, LAS float* pwc, int tid) {
    const int p = hp & 1, d0 = dt * 64;
#pragma unroll
    for (int i = 0; i < 8; ++i) { const int idx = tid + 512 * i, k = idx >> 5, c4 = idx & 31; const float4 v = *(const float4*)(sk + (size_t)(p * 128 + k) * 128 + c4 * 4);
        skc[(c4 * 4 + 0) * 132 + k] = v.x; skc[(c4 * 4 + 1) * 132 + k] = v.y; skc[(c4 * 4 + 2) * 132 + k] = v.z; skc[(c4 * 4 + 3) * 132 + k] = v.w; }
#pragma unroll
    for (int i = 0; i < 4; ++i) { const int idx = tid + 512 * i, d = idx >> 5, c4 = idx & 31; const float4 v = *(const float4*)(pwq + (size_t)(d0 + d) * 2048 + hp * 128 + c4 * 4);
        pwc[(c4 * 4 + 0) * 68 + d] = v.x; pwc[(c4 * 4 + 1) * 68 + d] = v.y; pwc[(c4 * 4 + 2) * 68 + d] = v.z; pwc[(c4 * 4 + 3) * 68 + d] = v.w; }
    __syncthreads();
    const int tk = tid & 31, td = tid >> 5;
    float acc[4][4];
#pragma unroll
    for (int i = 0; i < 4; ++i)
#pragma unroll
        for (int j = 0; j < 4; ++j) acc[i][j] = 0.f;
#pragma unroll 4
    for (int c = 0; c < 128; ++c) { const f32x4 a = *(const LAS f32x4*)(skc + c * 132 + tk * 4); const f32x4 b = *(const LAS f32x4*)(pwc + c * 68 + td * 4);
#pragma unroll
        for (int i = 0; i < 4; ++i)
#pragma unroll
            for (int j = 0; j < 4; ++j) acc[i][j] += a[i] * b[j]; }
#pragma unroll
    for (int i = 0; i < 4; ++i) { u32x2 w; w.x = pkbf(acc[i][0], acc[i][1]); w.y = pkbf(acc[i][2], acc[i][3]); *(u32x2*)(WtS + (size_t)(hp * 128 + tk * 4 + i) * DM + d0 + td * 4) = w; }
    __syncthreads();
}
#ifndef MK_FP6_IL
#define MK_FP6_IL 1
#endif
__device__ __forceinline__ void conv_tables(const Params& P, int layer, int gw, int nw, int lane) {
    unsigned char* ws = P.ws; const int hl = lane & 31, up = lane >> 5; float* tsc = (float*)(ws + WS_TSC);
    for (int r0 = gw * 4; r0 < 2 * 16384; r0 += nw * 4) {
        float4 v[2][8];
#pragma unroll
        for (int k = 0; k < 2; ++k) { const int q = r0 + 2 * k + up, tb = q >> 14, rr = layer * 16384 + (q & 16383); const float* src = P.in[18 + tb] + (size_t)rr * DM + hl * 32;
#pragma unroll
            for (int j = 0; j < 8; ++j) v[k][j] = *(const float4*)(src + 4 * j); }
#pragma unroll
        for (int k = 0; k < 2; ++k) { const int q = r0 + 2 * k + up, tb = q >> 14, rr = layer * 16384 + (q & 16383), r = tb * 32768 + rr; float m = 0.f;
#pragma unroll
            for (int j = 0; j < 8; ++j) m = fmaxf(m, fmaxf(fmaxf(fabsf(v[k][j].x), fabsf(v[k][j].y)), fmaxf(fabsf(v[k][j].z), fabsf(v[k][j].w))));
#pragma unroll
            for (int o = 1; o < 32; o <<= 1) m = fmaxf(m, shx(m, o));
            float s = 1.f; if (m > 1e-30f) s = __uint_as_float(__float_as_uint(7.5f / m) & 0x7f800000u);
            float e[32];
#pragma unroll
            for (int j = 0; j < 8; ++j) { e[4 * j] = v[k][j].x * s; e[4 * j + 1] = v[k][j].y * s; e[4 * j + 2] = v[k][j].z * s; e[4 * j + 3] = v[k][j].w * s; }
            f32x16 xa, xb;
#pragma unroll
            for (int i = 0; i < 16; ++i) { xa[i] = MK_FP6_IL ? e[2 * i] : e[i]; xb[i] = MK_FP6_IL ? e[2 * i + 1] : e[16 + i]; }
            u32x6 p = __builtin_amdgcn_cvt_scalef32_2xpk16_fp6_f32(xa, xb, 1.0f);
            unsigned char* dst = ws + (tb ? WS_VBF : WS_UBF) + (size_t)rr * 768;
            *(u32x4*)(dst + hl * 16) = (u32x4){p[0], p[1], p[2], p[3]}; *(u32x2*)(dst + 512 + hl * 8) = (u32x2){p[4], p[5]};
            if (hl == 0) tsc[r] = 1.f / s; } }
}
__device__ __forceinline__ void p0_prologue(const Params& P, LAS unsigned char* lds, int tid, int bid, int G) {
    unsigned char* ws = P.ws;
    for (int u = bid; u < NLAYER * 3072; u += G) {
        const int l = u / 3072, t = u - l * 3072;
        if (t < 2432) tconv_tile(P.in[8] + (size_t)l * DM * INC, DM, INC, (bf16_t*)(ws + WS_WTIN + l * SZ_WTIN), t, (LAS float*)lds, tid);
        else if (t < 2560) tconv_tile(P.in[12] + (size_t)l * 512 * DM, 512, DM, (bf16_t*)(ws + WS_WTOA + l * SZ_WTOA), t - 2432, (LAS float*)lds, tid);
        else if (t < 2816) tconv_tile(P.in[13] + (size_t)l * DM * DM, DM, DM, (bf16_t*)(ws + WS_WTOR + l * SZ_WSQ), t - 2560, (LAS float*)lds, tid);
        else tconv_tile(P.in[14] + (size_t)l * DM * DM, DM, DM, (bf16_t*)(ws + WS_WTOUT + l * SZ_WSQ), t - 2816, (LAS float*)lds, tid);
    }
    for (int u = bid; u < NLAYER * 256; u += G) {
        const int l = u >> 8, r = u & 255, hp = r >> 4, dt = r & 15;
        wts_unit(P.in[16] + (size_t)l * DM * 2048, P.in[17] + (size_t)l * 2 * 128 * 128, (bf16_t*)(ws + WS_WTS + l * SZ_WTS), hp, dt, (LAS float*)lds, (LAS float*)(lds + 128 * 132 * 4), tid);
    }
    if (bid == 0) { float* bt = (float*)(ws + WS_BT); for (int idx = tid; idx < 12 * 132; idx += 512) { const int gj = idx / 132, m = idx - gj * 132, g = gj >> 2, j = gj & 3;
        bt[idx] = m <= 128 ? P.in[6][(int)P.bucket[g][m] * 12 + g * 4 + j] : 0.f; } }
    { float2* cs = (float2*)(ws + WS_CS);
      for (int idx = bid * 512 + tid; idx < 8193 * 64; idx += G * 512) { const int pi = idx >> 6, i = idx & 63; const float pos = pi == 8192 ? 16384.f : (float)pi;
        const float th = pos * P.ang[i]; const double td = (double)th; const double kq = rint(td * 0.15915494309189535); const float rf = (float)(td - kq * 6.283185307179586);
        cs[idx] = make_float2(cosf(rf), sinf(rf)); } }
    { const int lane = tid & 63, gw = bid * 8 + (tid >> 6), nw = G * 8; bf16_t* H = (bf16_t*)(ws + WS_H); const float* nw1 = P.in[7];
      float4 wv[4];
#pragma unroll
      for (int j = 0; j < 4; ++j) wv[j] = *(const float4*)(nw1 + j * 256 + lane * 4);
      for (int row0 = gw * 2; row0 < NR; row0 += nw * 2) {
        float4 v[2][4];
#pragma unroll
        for (int k = 0; k < 2; ++k) { const int row = row0 + k; const float* x = row < NP ? P.in[0] + (size_t)row * DM : P.in[1] + (size_t)(row - NP) * DM;
#pragma unroll
            for (int j = 0; j < 4; ++j) v[k][j] = *(const float4*)(x + j * 256 + lane * 4); }
        __builtin_amdgcn_sched_barrier(0);
#pragma unroll
        for (int k = 0; k < 2; ++k) { const int row = row0 + k; float ss = 0.f;
#pragma unroll
            for (int j = 0; j < 4; ++j) ss += v[k][j].x * v[k][j].x + v[k][j].y * v[k][j].y + v[k][j].z * v[k][j].z + v[k][j].w * v[k][j].w;
            const float rstd = rsqrtf(wsum64(ss) * (1.f / 1024.f) + EPS);
#pragma unroll
            for (int j = 0; j < 4; ++j) { const float4 w = wv[j];
                u32x2 o; o.x = pkbf(v[k][j].x * rstd * w.x, v[k][j].y * rstd * w.y); o.y = pkbf(v[k][j].z * rstd * w.z, v[k][j].w * rstd * w.w); *(u32x2*)(H + (size_t)row * DM + j * 256 + lane * 4) = o; } } } }
}

struct AttnRaw { u32x4 kr[8], vr[8]; bf16x8 q[4]; float4 kw0, kw1; float bias, qw; };
struct AttnIdx { int g, j, b, d, r, blk, i0; size_t rowbase; };
__device__ __forceinline__ AttnIdx attn_decode(int u) { AttnIdx a; a.g = u >> 9; const int rem = u & 511; a.j = rem & 3; const int sb = rem >> 2; a.b = sb >> 6; const int x = sb & 63, dsh = 2 * a.g;
    a.d = 1 << dsh; a.r = x >> (6 - dsh); a.blk = x & ((64 >> dsh) - 1); a.rowbase = (size_t)a.b * 8192 + a.r; a.i0 = a.blk * 128; return a; }
__device__ __forceinline__ void attn_load(const __amdgpu_buffer_rsrc_t Zr, const float* qn, const float* kn, const float* BT, const AttnIdx& a, AttnRaw& R, int tid, int w, int fr, int fq) {
    const int dsh = 2 * a.g, sub0 = (a.r << (13 - dsh)) + a.i0;
    const int hk = ((((1 * 3 + a.g) * 4 + a.j) * 2 + a.b) * 8192) * 128, hv = ((((2 * 3 + a.g) * 4 + a.j) * 2 + a.b) * 8192) * 128, hq = ((((0 * 3 + a.g) * 4 + a.j) * 2 + a.b) * 8192) * 128;
#pragma unroll
    for (int c = 0; c < 8; ++c) { const int id = tid + 512 * c, kk = id >> 4, ch = id & 15; int i = a.i0 - 128 + kk; i = i < 0 ? 0 : i;
        const int ro = (((a.r << (13 - dsh)) + i) * 128 + ch * 8); R.kr[c] = __builtin_amdgcn_raw_buffer_load_b128(Zr, (hk + ro) * 2, 0, 0); R.vr[c] = __builtin_amdgcn_raw_buffer_load_b128(Zr, (hv + ro) * 2, 0, 0); }
    { const float* kwp = kn + a.g * 128 + (tid & 15) * 8; R.kw0 = *(const float4*)kwp; R.kw1 = *(const float4*)(kwp + 4); R.bias = BT[(a.g * 4 + a.j) * 132 + (tid < 132 ? tid : 0)]; R.qw = qn[a.g * 128 + (tid & 127)]; }
    const int qoff = (hq + (sub0 + 16 * w + fr) * 128 + fq * 8) * 2;
#pragma unroll
    for (int s = 0; s < 4; ++s) R.q[s] = __builtin_bit_cast(bf16x8, __builtin_amdgcn_raw_buffer_load_b128(Zr, qoff + 64 * s, 0, 0));
}
__device__ __forceinline__ void attn_phase(const Params& P, int l, const bf16_t* Z, bf16_t* OG, float* LSE, LAS unsigned char* lds, int tid_in, int bid, int G) {
    const int w = __builtin_amdgcn_readfirstlane(tid_in >> 6);
    LAS unsigned char* Ks = lds; LAS unsigned char* Vs = lds + 65536; LAS float* biasv = (LAS float*)(lds + 131072);
    const __amdgpu_buffer_rsrc_t Zr = __builtin_amdgcn_make_buffer_rsrc((void*)Z, 0, (int)((size_t)NR * INC * 2), 0x00020000);
    AttnRaw R; int u = bid;
    const float* qn = P.in[10] + l * 384; const float* kn = P.in[11] + l * 384; const float* BT = (const float*)(P.ws + WS_BT); LAS float* qwl = (LAS float*)(lds + 131072 + 1024);
    if (u < 1536) { const int l0 = tid_in & 63; attn_load(Zr, qn, kn, BT, attn_decode(u), R, tid_in, w, l0 & 15, l0 >> 4); }
    for (; u < 1536; u += G) {
        int lane; asm volatile("v_mbcnt_lo_u32_b32 %0, -1, 0\n\tv_mbcnt_hi_u32_b32 %0, -1, %0" : "=v"(lane));
        const int tid = w * 64 + lane, fr = lane & 15, fq = lane >> 4, q4 = fr >> 2, p4 = fr & 3;
        const AttnIdx a = attn_decode(u); const int g = a.g, j = a.j, blk = a.blk;
        { const int ch = tid & 15; const float4 kw0 = R.kw0, kw1 = R.kw1;
          const int keep = 128 << (2 * g); float* kvb = P.out + (g == 0 ? O_KV1P : (g == 1 ? O_KV4P : O_KV16P)) + (size_t)(l * 2 + a.b) * keep * 1024 + j * 128 + ch * 8;
#pragma unroll
          for (int c = 0; c < 8; ++c) { const int id = tid + 512 * c, kk = id >> 4; const u32x4 raw = R.kr[c];
            float f[8] = {bflo(raw.x), bfhi(raw.x), bflo(raw.y), bfhi(raw.y), bflo(raw.z), bfhi(raw.z), bflo(raw.w), bfhi(raw.w)};
            float ss = 0.f;
#pragma unroll
            for (int i = 0; i < 8; ++i) ss += f[i] * f[i];
            ss += shx(ss, 1); ss += shx(ss, 2); ss += shx(ss, 4); ss += shx(ss, 8);
            const float rstd = rsqrtf(ss * (1.f / 128.f) + EPS);
            f[0] *= rstd * kw0.x; f[1] *= rstd * kw0.y; f[2] *= rstd * kw0.z; f[3] *= rstd * kw0.w; f[4] *= rstd * kw1.x; f[5] *= rstd * kw1.y; f[6] *= rstd * kw1.z; f[7] *= rstd * kw1.w;
            u32x4 o; o.x = pkbf(f[0], f[1]); o.y = pkbf(f[2], f[3]); o.z = pkbf(f[4], f[5]); o.w = pkbf(f[6], f[7]);
            *(LAS u32x4*)(Ks + offb(kk, ch)) = o; *(LAS u32x4*)(Vs + offb(kk, ch)) = R.vr[c];
            if (c >= 4) { const int tt = a.r + a.d * (a.i0 - 128 + kk) - (8192 - keep);
                if (tt >= 0) { float* d = kvb + (size_t)tt * 1024; const u32x4 vr = R.vr[c];
                    *(float4*)d = make_float4(f[0], f[1], f[2], f[3]); *(float4*)(d + 4) = make_float4(f[4], f[5], f[6], f[7]);
                    *(float4*)(d + 512) = make_float4(bflo(vr.x), bfhi(vr.x), bflo(vr.y), bfhi(vr.y)); *(float4*)(d + 516) = make_float4(bflo(vr.z), bfhi(vr.z), bflo(vr.w), bfhi(vr.w)); } }
            __builtin_amdgcn_sched_barrier(0); } }
        if (tid < 132) biasv[tid] = R.bias;
        if (tid < 128) qwl[tid] = R.qw;
        const size_t qrow = a.rowbase + (size_t)a.d * (a.i0 + 16 * w + fr);
        __syncthreads();
        bf16x8 Qf[4];
        { float ss = 0.f; float qf[4][8];
#pragma unroll
          for (int s = 0; s < 4; ++s) { const u32x4 r4 = __builtin_bit_cast(u32x4, R.q[s]); qf[s][0] = bflo(r4.x); qf[s][1] = bfhi(r4.x); qf[s][2] = bflo(r4.y); qf[s][3] = bfhi(r4.y); qf[s][4] = bflo(r4.z); qf[s][5] = bfhi(r4.z); qf[s][6] = bflo(r4.w); qf[s][7] = bfhi(r4.w);
#pragma unroll
              for (int i = 0; i < 8; ++i) ss += qf[s][i] * qf[s][i]; }
          ss += shx(ss, 16); ss += shx(ss, 32);
          const float rstd = rsqrtf(ss * (1.f / 128.f) + EPS) * P.rsq128; const LAS float* qwp = qwl + fq * 8;
#pragma unroll
          for (int s = 0; s < 4; ++s) { const f32x4 w0 = *(const LAS f32x4*)(qwp + 32 * s), w1 = *(const LAS f32x4*)(qwp + 32 * s + 4); u32x4 o;
              o.x = pkbf(qf[s][0] * rstd * w0[0], qf[s][1] * rstd * w0[1]); o.y = pkbf(qf[s][2] * rstd * w0[2], qf[s][3] * rstd * w0[3]); o.z = pkbf(qf[s][4] * rstd * w1[0], qf[s][5] * rstd * w1[1]); o.w = pkbf(qf[s][6] * rstd * w1[2], qf[s][7] * rstd * w1[3]);
              Qf[s] = __builtin_bit_cast(bf16x8, o); } }
        { int un = u + G; asm volatile("" : "+s"(un));
          if (un < 1536) attn_load(Zr, qn, kn, BT, attn_decode(un), R, tid, w, fr, fq); }
        f32x4 sa[9];
#pragma unroll
        for (int ti = 0; ti < 9; ++ti) { sa[ti] = (f32x4){0.f, 0.f, 0.f, 0.f}; const int kt = w + ti;
#pragma unroll
            for (int s = 0; s < 4; ++s) { const bf16x8 kf = *(const LAS bf16x8*)(Ks + offb(16 * kt + fr, 4 * s + fq)); sa[ti] = mfma16(kf, Qf[s], sa[ti]); }
            if (ti & 1) __builtin_amdgcn_sched_barrier(0); }
        float mx = -3.0e38f;
#pragma unroll
        for (int ti = 0; ti < 9; ++ti)
#pragma unroll
            for (int e = 0; e < 4; ++e) { const int kk = 16 * (w + ti) + 4 * fq + e, m = 128 + fr - 16 * ti - 4 * fq - e; const bool ok = (m >= 0) && (m <= 128) && (blk > 0 || kk >= 128);
                const int mc = m < 0 ? 0 : (m > 128 ? 128 : m); const float bv = biasv[mc]; float sv = sa[ti][e] + bv; sv = ok ? sv : -1.0e30f; sa[ti][e] = sv; mx = fmaxf(mx, sv); }
        mx = fmaxf(mx, shx(mx, 16)); mx = fmaxf(mx, shx(mx, 32));
        float sum = 0.f;
#pragma unroll
        for (int ti = 0; ti < 9; ++ti)
#pragma unroll
            for (int e = 0; e < 4; ++e) { const float pe = __expf(sa[ti][e] - mx); sa[ti][e] = pe; sum += pe; }
        sum += shx(sum, 16); sum += shx(sum, 32);
        f32x4 oa[8];
#pragma unroll
        for (int c = 0; c < 8; ++c) oa[c] = (f32x4){0.f, 0.f, 0.f, 0.f};
#pragma unroll
        for (int ks = 0; ks < 5; ++ks) { const int T0 = 2 * ks, T1 = 2 * ks + 1;
            const f32x4 z4 = {0.f, 0.f, 0.f, 0.f}; const bf16x8 Pb = pack8(sa[T0], T1 < 9 ? sa[T1] : z4);
            const int rb0 = 16 * (w + T0) + 4 * fq; int rb1 = 16 * (w + T1) + 4 * fq; rb1 = rb1 > 252 ? 252 : rb1;
#pragma unroll
            for (int c = 0; c < 8; ++c) { const s16x4 a0 = trr(Vs + offb(rb0 + q4, 2 * c + (p4 >> 1)) + 8 * (p4 & 1)); const s16x4 a1 = trr(Vs + offb(rb1 + q4, 2 * c + (p4 >> 1)) + 8 * (p4 & 1));
                oa[c] = mfma16(cat4(a0, a1), Pb, oa[c]); }
            __builtin_amdgcn_sched_barrier(0); }
        const float inv = 1.f / sum; bf16_t* orow = OG + ((size_t)g * NR + qrow) * 512 + j * 128;
#pragma unroll
        for (int c = 0; c < 8; ++c) { u32x2 o; o.x = pkbf(oa[c][0] * inv, oa[c][1] * inv); o.y = pkbf(oa[c][2] * inv, oa[c][3] * inv); *(u32x2*)(orow + 16 * c + 4 * fq) = o; }
        if (fq == 0) LSE[((size_t)g * NR + qrow) * 4 + j] = mx + __logf(sum);
        __syncthreads();
    }
}

__device__ __forceinline__ void sattn_unit(const Params& P, int l, const bf16_t* Z, bf16_t* OG, float* LSE, int u, LAS unsigned char* lds, int tid) {
    const int lane = tid & 63, w = __builtin_amdgcn_readfirstlane(tid >> 6);
    const int b = u / 3, g = u - b * 3, d = 1 << (2 * g), lg = 128 * d;
    const float* cache = P.in[2 + g] + ((size_t)(l * 32 + b) * lg) * 1024;
    const bf16_t* zr = Z + (size_t)(NP + b) * INC;
    LAS float* sc = (LAS float*)lds;
    LAS float* st = (LAS float*)(lds + 2112);
    LAS float* part = (LAS float*)(lds + 4096);
    float q[8];
    { const u32x2 a = *(const u32x2*)(zr + C_QA + g * 512 + lane * 4), c = *(const u32x2*)(zr + C_QA + g * 512 + 256 + lane * 4);
      q[0] = bflo(a.x); q[1] = bfhi(a.x); q[2] = bflo(a.y); q[3] = bfhi(a.y); q[4] = bflo(c.x); q[5] = bfhi(c.x); q[6] = bflo(c.y); q[7] = bfhi(c.y);
      float s1 = q[0] * q[0] + q[1] * q[1] + q[2] * q[2] + q[3] * q[3], s2 = q[4] * q[4] + q[5] * q[5] + q[6] * q[6] + q[7] * q[7];
#pragma unroll
      for (int o = 1; o < 32; o <<= 1) { s1 += shx(s1, o); s2 += shx(s2, o); }
      const float r1 = rsqrtf(s1 * (1.f / 128.f) + EPS) * P.rsq128, r2 = rsqrtf(s2 * (1.f / 128.f) + EPS) * P.rsq128;
      const float4 wq = *(const float4*)(P.in[10] + (l * 3 + g) * 128 + (lane & 31) * 4);
      q[0] = tobf1f(q[0] * r1 * wq.x); q[1] = tobf1f(q[1] * r1 * wq.y); q[2] = tobf1f(q[2] * r1 * wq.z); q[3] = tobf1f(q[3] * r1 * wq.w);
      q[4] = tobf1f(q[4] * r2 * wq.x); q[5] = tobf1f(q[5] * r2 * wq.y); q[6] = tobf1f(q[6] * r2 * wq.z); q[7] = tobf1f(q[7] * r2 * wq.w); }
    if (w == 0) {
        float k[8];
        { const u32x2 a = *(const u32x2*)(zr + C_KA + g * 512 + lane * 4), c = *(const u32x2*)(zr + C_KA + g * 512 + 256 + lane * 4);
            k[0] = bflo(a.x); k[1] = bfhi(a.x); k[2] = bflo(a.y); k[3] = bfhi(a.y); k[4] = bflo(c.x); k[5] = bfhi(c.x); k[6] = bflo(c.y); k[7] = bfhi(c.y);
            float t1 = k[0] * k[0] + k[1] * k[1] + k[2] * k[2] + k[3] * k[3], t2 = k[4] * k[4] + k[5] * k[5] + k[6] * k[6] + k[7] * k[7];
#pragma unroll
            for (int o = 1; o < 32; o <<= 1) { t1 += shx(t1, o); t2 += shx(t2, o); }
            const float r1 = rsqrtf(t1 * (1.f / 128.f) + EPS), r2 = rsqrtf(t2 * (1.f / 128.f) + EPS); const float4 wk = *(const float4*)(P.in[11] + (l * 3 + g) * 128 + (lane & 31) * 4);
            k[0] *= r1 * wk.x; k[1] *= r1 * wk.y; k[2] *= r1 * wk.z; k[3] *= r1 * wk.w; k[4] *= r2 * wk.x; k[5] *= r2 * wk.y; k[6] *= r2 * wk.z; k[7] *= r2 * wk.w;
            float* kvd = P.out + (g == 0 ? O_KV1S : (g == 1 ? O_KV4S : O_KV16S)) + (size_t)(l * 32 + b) * 1024;
            *(float4*)(kvd + lane * 4) = make_float4(k[0], k[1], k[2], k[3]); *(float4*)(kvd + 256 + lane * 4) = make_float4(k[4], k[5], k[6], k[7]);
            const u32x2 va = *(const u32x2*)(zr + C_VA + g * 512 + lane * 4), vc = *(const u32x2*)(zr + C_VA + g * 512 + 256 + lane * 4);
            *(float4*)(kvd + 512 + lane * 4) = make_float4(bflo(va.x), bfhi(va.x), bflo(va.y), bfhi(va.y)); *(float4*)(kvd + 768 + lane * 4) = make_float4(bflo(vc.x), bfhi(vc.x), bflo(vc.y), bfhi(vc.y));
#pragma unroll
            for (int i = 0; i < 8; ++i) k[i] = tobf1f(k[i]); }
        float s1 = q[0] * k[0] + q[1] * k[1] + q[2] * k[2] + q[3] * k[3], s2 = q[4] * k[4] + q[5] * k[5] + q[6] * k[6] + q[7] * k[7];
#pragma unroll
        for (int o = 1; o < 32; o <<= 1) { s1 += shx(s1, o); s2 += shx(s2, o); }
        if ((lane & 31) == 0) { const int h0 = lane >> 5; sc[h0 * 132] = s1; sc[(2 + h0) * 132] = s2; }
    }
#pragma unroll 1
    for (int half = 0; half < 2; ++half) {
        float4 ka[8], kb[8];
#pragma unroll
        for (int i = 0; i < 8; ++i) { const int jj = 1 + w + 8 * (half * 8 + i); const float* kp = cache + (size_t)(lg - jj * d) * 1024; ka[i] = *(const float4*)(kp + lane * 4); kb[i] = *(const float4*)(kp + 256 + lane * 4); }
#pragma unroll
        for (int i = 0; i < 8; ++i) { const int jj = 1 + w + 8 * (half * 8 + i);
            float s1 = q[0] * ka[i].x + q[1] * ka[i].y + q[2] * ka[i].z + q[3] * ka[i].w, s2 = q[4] * kb[i].x + q[5] * kb[i].y + q[6] * kb[i].z + q[7] * kb[i].w;
#pragma unroll
            for (int o = 1; o < 32; o <<= 1) { s1 += shx(s1, o); s2 += shx(s2, o); }
            if ((lane & 31) == 0) { const int h0 = lane >> 5; sc[h0 * 132 + jj] = s1; sc[(2 + h0) * 132 + jj] = s2; } }
    }
    __syncthreads();
    if (w < 4) { const float* btg = (const float*)(P.ws + WS_BT) + (g * 4 + w) * 132;
        const float v0 = sc[w * 132 + lane] + btg[lane], v1 = sc[w * 132 + 64 + lane] + btg[64 + lane], v2 = lane == 0 ? sc[w * 132 + 128] + btg[128] : -3.0e38f;
        float mx = fmaxf(fmaxf(v0, v1), v2);
#pragma unroll
        for (int o = 1; o < 64; o <<= 1) mx = fmaxf(mx, shx(mx, o));
        const float e0 = __expf(v0 - mx), e1 = __expf(v1 - mx), e2 = lane == 0 ? __expf(v2 - mx) : 0.f;
        sc[w * 132 + lane] = e0; sc[w * 132 + 64 + lane] = e1; if (lane == 0) sc[w * 132 + 128] = e2;
        const float sm = wsum64(e0 + e1 + e2);
        if (lane == 0) { st[w] = mx; st[4 + w] = sm; } }
    __syncthreads();
    float acc[8];
#pragma unroll
    for (int i = 0; i < 8; ++i) acc[i] = 0.f;
    if (w == 0) { const u32x2 a = *(const u32x2*)(zr + C_VA + g * 512 + lane * 4), c = *(const u32x2*)(zr + C_VA + g * 512 + 256 + lane * 4);
        const float p1 = sc[(lane >> 5) * 132], p2 = sc[(2 + (lane >> 5)) * 132];
        acc[0] += p1 * bflo(a.x); acc[1] += p1 * bfhi(a.x); acc[2] += p1 * bflo(a.y); acc[3] += p1 * bfhi(a.y); acc[4] += p2 * bflo(c.x); acc[5] += p2 * bfhi(c.x); acc[6] += p2 * bflo(c.y); acc[7] += p2 * bfhi(c.y); }
#pragma unroll 1
    for (int half = 0; half < 2; ++half) {
        float4 va[8], vb[8];
#pragma unroll
        for (int i = 0; i < 8; ++i) { const int jj = 1 + w + 8 * (half * 8 + i); const float* vp = cache + (size_t)(lg - jj * d) * 1024 + 512; va[i] = *(const float4*)(vp + lane * 4); vb[i] = *(const float4*)(vp + 256 + lane * 4); }
#pragma unroll
        for (int i = 0; i < 8; ++i) { const int jj = 1 + w + 8 * (half * 8 + i); const float p1 = sc[(lane >> 5) * 132 + jj], p2 = sc[(2 + (lane >> 5)) * 132 + jj];
            acc[0] += p1 * va[i].x; acc[1] += p1 * va[i].y; acc[2] += p1 * va[i].z; acc[3] += p1 * va[i].w; acc[4] += p2 * vb[i].x; acc[5] += p2 * vb[i].y; acc[6] += p2 * vb[i].z; acc[7] += p2 * vb[i].w; }
    }
    *(LAS f32x4*)(part + w * 512 + lane * 4) = (f32x4){acc[0], acc[1], acc[2], acc[3]};
    *(LAS f32x4*)(part + w * 512 + 256 + lane * 4) = (f32x4){acc[4], acc[5], acc[6], acc[7]};
    __syncthreads();
    { float s = 0.f;
#pragma unroll
      for (int ww = 0; ww < 8; ++ww) s += part[ww * 512 + tid];
      const int j = tid >> 7; OG[((size_t)g * NR + NP + b) * 512 + tid] = tobf1(s / st[4 + j]);
      if (tid < 4) LSE[((size_t)g * NR + NP + b) * 4 + tid] = st[tid] + __logf(st[4 + tid]); }
    __syncthreads();
}

template <bool ZETA> __device__ __forceinline__ void ret_stage(const bf16_t* Z, const float2* CS, size_t row0, int pos0, int h, float lgh, float rsq128, LAS unsigned char* lds, int tid) {
    u32x4 vraw[8];
#pragma unroll
    for (int c = 0; c < 8; ++c) { const int id = tid + 512 * c, tok = id >> 5, c32 = id & 31; vraw[c] = *(const u32x4*)(Z + ZO_RV + ((size_t)h * NP + row0 + tok) * 256 + c32 * 8); }
    __builtin_amdgcn_sched_barrier(0);
#pragma unroll
    for (int c = 0; c < 2; ++c) { const int id = tid + 512 * c, tok = id >> 3, c8 = id & 7; const bf16_t* kp = Z + ZO_RK + ((size_t)h * NP + row0 + tok) * 128 + c8 * 8;
        const u32x4 a = *(const u32x4*)kp, bq = *(const u32x4*)(kp + 64); const float4* cp = (const float4*)(CS + (size_t)(pos0 + tok) * 64 + c8 * 8);
        const float4 c0 = cp[0], c1 = cp[1], c2 = cp[2], c3 = cp[3];
        float sc = rsq128; if (ZETA) sc *= __expf((float)(127 - tok) * lgh);
        const float x1[8] = {bflo(a.x), bfhi(a.x), bflo(a.y), bfhi(a.y), bflo(a.z), bfhi(a.z), bflo(a.w), bfhi(a.w)}, x2[8] = {bflo(bq.x), bfhi(bq.x), bflo(bq.y), bfhi(bq.y), bflo(bq.z), bfhi(bq.z), bflo(bq.w), bfhi(bq.w)};
        const float cs[8] = {c0.x, c0.z, c1.x, c1.z, c2.x, c2.z, c3.x, c3.z}, sn[8] = {c0.y, c0.w, c1.y, c1.w, c2.y, c2.w, c3.y, c3.w};
        float o1[8], o2[8];
#pragma unroll
        for (int i = 0; i < 8; ++i) { o1[i] = (x1[i] * cs[i] - x2[i] * sn[i]) * sc; o2[i] = (x1[i] * sn[i] + x2[i] * cs[i]) * sc; }
        u32x4 w1, w2; w1.x = pkbf(o1[0], o1[1]); w1.y = pkbf(o1[2], o1[3]); w1.z = pkbf(o1[4], o1[5]); w1.w = pkbf(o1[6], o1[7]); w2.x = pkbf(o2[0], o2[1]); w2.y = pkbf(o2[2], o2[3]); w2.z = pkbf(o2[4], o2[5]); w2.w = pkbf(o2[6], o2[7]);
        *(LAS u32x4*)(lds + offb(tok, c8)) = w1; *(LAS u32x4*)(lds + offb(tok, c8 + 8)) = w2; }
#pragma unroll
    for (int c = 0; c < 8; ++c) { const int id = tid + 512 * c, tok = id >> 5, c32 = id & 31; *(LAS u32x4*)(lds + 32768 + (c32 >> 4) * 32768 + offb(tok, c32 & 15)) = vraw[c]; }
}
__device__ __forceinline__ void ret1_unit(const Params& P, const bf16_t* Z, float* RU, int u, LAS unsigned char* lds, int tid) {
    const int lane = tid & 63, w = __builtin_amdgcn_readfirstlane(tid >> 6), fr = lane & 15, fq = lane >> 4, q4 = fr >> 2, p4 = fr & 3;
    const int h = u & 3, bc = u >> 2;
    ret_stage<true>(Z, (const float2*)(P.ws + WS_CS), (size_t)bc * 128, (bc & 63) * 128, h, P.logg[h], P.rsq128, lds, tid);
    __syncthreads();
    f32x4 acc[8][2];
#pragma unroll
    for (int mt = 0; mt < 8; ++mt) { acc[mt][0] = (f32x4){0.f, 0.f, 0.f, 0.f}; acc[mt][1] = (f32x4){0.f, 0.f, 0.f, 0.f}; }
#pragma unroll
    for (int ks = 0; ks < 4; ++ks) {
        const int r0 = 32 * ks + 8 * fq + q4;
        bf16x8 Bf[2];
#pragma unroll
        for (int nt = 0; nt < 2; ++nt) { const int dvt = 2 * w + nt; LAS unsigned char* vb = lds + 32768 + (dvt >> 3) * 32768; const int c = dvt & 7;
            Bf[nt] = cat4(trr(vb + offb(r0, 2 * c + (p4 >> 1)) + 8 * (p4 & 1)), trr(vb + offb(r0 + 4, 2 * c + (p4 >> 1)) + 8 * (p4 & 1))); }
#pragma unroll
        for (int mt = 0; mt < 8; ++mt) { const bf16x8 Af = cat4(trr(lds + offb(r0, 2 * mt + (p4 >> 1)) + 8 * (p4 & 1)), trr(lds + offb(r0 + 4, 2 * mt + (p4 >> 1)) + 8 * (p4 & 1)));
            acc[mt][0] = mfma16(Af, Bf[0], acc[mt][0]); acc[mt][1] = mfma16(Af, Bf[1], acc[mt][1]); }
    }
    bf16_t* Up = (bf16_t*)RU + ((size_t)bc * 4 + h) * 32768;
#pragma unroll
    for (int mt = 0; mt < 8; ++mt)
#pragma unroll
        for (int nt = 0; nt < 2; ++nt) { u32x2 o; o.x = pkbf(acc[mt][nt][0], acc[mt][nt][1]); o.y = pkbf(acc[mt][nt][2], acc[mt][nt][3]); *(u32x2*)(Up + (size_t)(32 * w + 16 * nt + fr) * 128 + 16 * mt + 4 * fq) = o; }
    __syncthreads();
}
__device__ __forceinline__ void sret_unit(const Params& P, int l, const bf16_t* Z, bf16_t* ORET, int u, LAS unsigned char* lds, int tid) {
    const int b = u >> 2, h = u & 3; const bf16_t* zr = Z + (size_t)(NP + b) * INC;
    LAS float* qf = (LAS float*)lds; LAS float* kf = qf + 128; LAS float* part = kf + 128; LAS float* red = part + 512;
    if (tid < 64) { const float2 cs = ((const float2*)(P.ws + WS_CS))[(size_t)8192 * 64 + tid];
        const float q1 = bf1(zr[C_QR + h * 128 + tid]), q2 = bf1(zr[C_QR + h * 128 + 64 + tid]), k1 = bf1(zr[C_KR + h * 128 + tid]), k2 = bf1(zr[C_KR + h * 128 + 64 + tid]);
        qf[tid] = tobf1f(q1 * cs.x - q2 * cs.y); qf[64 + tid] = tobf1f(q1 * cs.y + q2 * cs.x);
        kf[tid] = tobf1f((k1 * cs.x - k2 * cs.y) * P.rsq128); kf[64 + tid] = tobf1f((k1 * cs.y + k2 * cs.x) * P.rsq128); }
    __syncthreads();
    const int e = tid & 255, half = tid >> 8; const float ve = bf1(zr[C_VR + h * 256 + e]); const float gamma = __expf(P.logg[h]);
    float qk = 0.f;
#pragma unroll 4
    for (int dk = 0; dk < 128; ++dk) qk += qf[dk] * kf[dk];
    const float* r0 = P.in[5] + ((size_t)(l * 32 + b) * 4 + h) * 32768; float* rn = P.out + O_RETS + ((size_t)(l * 32 + b) * 4 + h) * 32768;
    float acc = 0.f;
#pragma unroll
    for (int q = 0; q < 2; ++q) { float rv[32];
#pragma unroll
        for (int i = 0; i < 32; ++i) rv[i] = r0[(half * 64 + q * 32 + i) * 256 + e];
        __builtin_amdgcn_sched_barrier(0);
#pragma unroll
        for (int i = 0; i < 32; ++i) { const int dk = half * 64 + q * 32 + i; const float r = rv[i]; rn[dk * 256 + e] = gamma * r + kf[dk] * ve; acc += qf[dk] * r; }
        __builtin_amdgcn_sched_barrier(0); }
    part[half * 256 + e] = acc;
    __syncthreads();
    float o = 0.f;
    if (tid < 256) { o = qk * ve + gamma * (part[e] + part[256 + e]); const float s = wsum64(o * o); if ((tid & 63) == 0) red[tid >> 6] = s; }
    __syncthreads();
    if (tid < 256) { const float ss = red[0] + red[1] + red[2] + red[3]; const float rstd = rsqrtf(ss * (1.f / 256.f) + EPS); const float gr = bf1(zr[C_GR + h * 256 + e]);
        ORET[(size_t)(NP + b) * DM + h * 256 + e] = tobf1(o * rstd * gr * sigmoidf_(gr)); }
    __syncthreads();
}

struct CombIn { float l0, l1, l2; u32x4 a, bq, c; };
__device__ __forceinline__ void comb_load(const bf16_t* OG, const float* LSE, int row, int lane, CombIn& I) {
    const int j = lane >> 4;
    I.l0 = LSE[((size_t)0 * NR + row) * 4 + j]; I.l1 = LSE[((size_t)1 * NR + row) * 4 + j]; I.l2 = LSE[((size_t)2 * NR + row) * 4 + j];
    I.a = *(const u32x4*)(OG + ((size_t)0 * NR + row) * 512 + lane * 8); I.bq = *(const u32x4*)(OG + ((size_t)1 * NR + row) * 512 + lane * 8); I.c = *(const u32x4*)(OG + ((size_t)2 * NR + row) * 512 + lane * 8);
}
__device__ __forceinline__ void comb_fin(const CombIn& I, bf16_t* AO, int row, int lane) {
        const float l0 = I.l0, l1 = I.l1, l2 = I.l2; const u32x4 a = I.a, bq = I.bq, c = I.c;
        const float m = fmaxf(l0, fmaxf(l1, l2)); float w0 = __expf(l0 - m), w1 = __expf(l1 - m), w2 = __expf(l2 - m); const float inv = 1.f / (w0 + w1 + w2); w0 *= inv; w1 *= inv; w2 *= inv;
        u32x4 o;
        o.x = pkbf(w0 * bflo(a.x) + w1 * bflo(bq.x) + w2 * bflo(c.x), w0 * bfhi(a.x) + w1 * bfhi(bq.x) + w2 * bfhi(c.x));
        o.y = pkbf(w0 * bflo(a.y) + w1 * bflo(bq.y) + w2 * bflo(c.y), w0 * bfhi(a.y) + w1 * bfhi(bq.y) + w2 * bfhi(c.y));
        o.z = pkbf(w0 * bflo(a.z) + w1 * bflo(bq.z) + w2 * bflo(c.z), w0 * bfhi(a.z) + w1 * bfhi(bq.z) + w2 * bfhi(c.z));
        o.w = pkbf(w0 * bflo(a.w) + w1 * bflo(bq.w) + w2 * bflo(c.w), w0 * bfhi(a.w) + w1 * bfhi(bq.w) + w2 * bfhi(c.w));
        *(u32x4*)(AO + (size_t)row * 512 + lane * 8) = o;
}
__device__ __forceinline__ void combine_row(const bf16_t* OG, const float* LSE, bf16_t* AO, int row, int lane) { CombIn I; comb_load(OG, LSE, row, lane, I); comb_fin(I, AO, row, lane); }
__device__ __forceinline__ void p4_scan_combine(const Params& P, int l, const float* RU, bf16_t* RS, const bf16_t* OG, const float* LSE, bf16_t* AO, int tid, int bid, int G) {
    const int gt = bid * 512 + tid;
    if (gt < 65536) { const int bh = gt >> 13, b = bh >> 2, h = bh & 3, e4 = gt & 8191; const float g128 = __expf(128.f * P.logg[h]);
        f32x4 S = {0.f, 0.f, 0.f, 0.f};
        f32x4 ua[8], ub[8];
#pragma unroll
        for (int j = 0; j < 8; ++j) { const u32x2 t = *(const u32x2*)((const bf16_t*)RU + ((size_t)(b * 64 + j) * 4 + h) * 32768 + (size_t)e4 * 4); ua[j] = (f32x4){bflo(t.x), bfhi(t.x), bflo(t.y), bfhi(t.y)}; }
#pragma unroll
        for (int cb = 0; cb < 8; ++cb) {
            if (cb < 7) {
#pragma unroll
                for (int j = 0; j < 8; ++j) { const u32x2 q = *(const u32x2*)((const bf16_t*)RU + ((size_t)(b * 64 + (cb + 1) * 8 + j) * 4 + h) * 32768 + (size_t)e4 * 4); const f32x4 t = {bflo(q.x), bfhi(q.x), bflo(q.y), bfhi(q.y)}; if (cb & 1) ua[j] = t; else ub[j] = t; } }
            __builtin_amdgcn_sched_barrier(0);
#pragma unroll
            for (int j = 0; j < 8; ++j) { const size_t idx = ((size_t)(b * 64 + cb * 8 + j) * 4 + h) * 32768 + (size_t)e4 * 4;
                u32x2 o; o.x = pkbf(S[0], S[1]); o.y = pkbf(S[2], S[3]); *(u32x2*)(RS + idx) = o;
                const f32x4 uv = (cb & 1) ? ub[j] : ua[j]; S = S * g128 + uv; }
            __builtin_amdgcn_sched_barrier(0);
        }
        const int dv = (e4 * 4) >> 7, dk = (e4 * 4) & 127; float* o = P.out + O_RETP + ((size_t)(l * 2 + b) * 4 + h) * 32768;
#pragma unroll
        for (int i = 0; i < 4; ++i) o[(size_t)(dk + i) * 256 + dv] = S[i]; }
    const int lane = tid & 63, gw = bid * 8 + (tid >> 6), nw = G * 8;
    for (int row = gw; row < NP; row += 4 * nw) {
        if (row + 3 * nw < NP) { CombIn I[4];
#pragma unroll
            for (int k = 0; k < 4; ++k) comb_load(OG, LSE, row + k * nw, lane, I[k]);
            __builtin_amdgcn_sched_barrier(0);
#pragma unroll
            for (int k = 0; k < 4; ++k) comb_fin(I[k], AO, row + k * nw, lane); }
        else for (int r2 = row; r2 < NP; r2 += nw) combine_row(OG, LSE, AO, r2, lane); }
}

__device__ __forceinline__ void ret3_unit(const Params& P, const bf16_t* Z, const bf16_t* RS, bf16_t* ORET, int u, LAS unsigned char* lds, int tid) {
    const int lane = tid & 63, w = __builtin_amdgcn_readfirstlane(tid >> 6), fr = lane & 15, fq = lane >> 4, q4 = fr >> 2, p4 = fr & 3;
    const int h = u & 3, bc = u >> 2; const float lgh = P.logg[h];
    ret_stage<false>(Z, (const float2*)(P.ws + WS_CS), (size_t)bc * 128, (bc & 63) * 128, h, lgh, P.rsq128, lds, tid);
    const size_t row = (size_t)bc * 128 + 16 * w + fr;
    bf16x8 Qf[4];
    { const bf16_t* qp = Z + ZO_RQ + ((size_t)h * NP + row) * 128 + fq * 8;
#pragma unroll
      for (int s = 0; s < 4; ++s) Qf[s] = *(const bf16x8*)(qp + 32 * s);
      const float2* cp = (const float2*)(P.ws + WS_CS) + (size_t)((bc & 63) * 128 + 16 * w + fr) * 64 + fq * 8;
#pragma unroll
      for (int s = 0; s < 2; ++s) { const u32x4 a = __builtin_bit_cast(u32x4, Qf[s]), bq = __builtin_bit_cast(u32x4, Qf[s + 2]); const float4* c4 = (const float4*)(cp + 32 * s); const float4 c0 = c4[0], c1 = c4[1], c2 = c4[2], c3 = c4[3];
          const float x1[8] = {bflo(a.x), bfhi(a.x), bflo(a.y), bfhi(a.y), bflo(a.z), bfhi(a.z), bflo(a.w), bfhi(a.w)}, x2[8] = {bflo(bq.x), bfhi(bq.x), bflo(bq.y), bfhi(bq.y), bflo(bq.z), bfhi(bq.z), bflo(bq.w), bfhi(bq.w)};
          const float cs[8] = {c0.x, c0.z, c1.x, c1.z, c2.x, c2.z, c3.x, c3.z}, sn[8] = {c0.y, c0.w, c1.y, c1.w, c2.y, c2.w, c3.y, c3.w};
          float o1[8], o2[8];
#pragma unroll
          for (int i = 0; i < 8; ++i) { o1[i] = x1[i] * cs[i] - x2[i] * sn[i]; o2[i] = x1[i] * sn[i] + x2[i] * cs[i]; }
          u32x4 w1, w2; w1.x = pkbf(o1[0], o1[1]); w1.y = pkbf(o1[2], o1[3]); w1.z = pkbf(o1[4], o1[5]); w1.w = pkbf(o1[6], o1[7]); w2.x = pkbf(o2[0], o2[1]); w2.y = pkbf(o2[2], o2[3]); w2.z = pkbf(o2[4], o2[5]); w2.w = pkbf(o2[6], o2[7]);
          Qf[s] = __builtin_bit_cast(bf16x8, w1); Qf[s + 2] = __builtin_bit_cast(bf16x8, w2); } }
    u32x4 rr[8];
    { const bf16_t* Rp = RS + ((size_t)bc * 4 + h) * 32768;
#pragma unroll
      for (int c = 0; c < 8; ++c) rr[c] = *(const u32x4*)(Rp + (size_t)(tid + 512 * c) * 8); }
    __syncthreads();
    f32x4 Pm[8];
#pragma unroll
    for (int mt = 0; mt < 8; ++mt) { Pm[mt] = (f32x4){0.f, 0.f, 0.f, 0.f};
        if (mt <= w) {
#pragma unroll
            for (int s = 0; s < 4; ++s) { const bf16x8 kf = *(const LAS bf16x8*)(lds + offb(16 * mt + fr, 4 * s + fq)); Pm[mt] = mfma16(kf, Qf[s], Pm[mt]); }
#pragma unroll
            for (int e = 0; e < 4; ++e) { const int diff = 16 * w + fr - (16 * mt + 4 * fq + e); Pm[mt][e] = diff >= 0 ? Pm[mt][e] * __expf((float)diff * lgh) : 0.f; } } }
    __syncthreads();
#pragma unroll
    for (int c = 0; c < 8; ++c) { const int id = tid + 512 * c, dv = id >> 4, ch = id & 15;
        *(LAS u32x4*)(lds + (dv < 128 ? 98304 : 0) + offb(dv & 127, ch)) = rr[c]; }
    f32x4 acc[16];
#pragma unroll
    for (int dt = 0; dt < 16; ++dt) acc[dt] = (f32x4){0.f, 0.f, 0.f, 0.f};
#pragma unroll
    for (int ks = 0; ks < 4; ++ks) if (2 * ks <= w) { const bf16x8 Pb = pack8(Pm[2 * ks], Pm[2 * ks + 1]); const int r0 = 32 * ks + 4 * fq + q4;
#pragma unroll
        for (int dt = 0; dt < 16; ++dt) { LAS unsigned char* vb = lds + 32768 + (dt >> 3) * 32768; const int c = dt & 7;
            acc[dt] = mfma16(cat4(trr(vb + offb(r0, 2 * c + (p4 >> 1)) + 8 * (p4 & 1)), trr(vb + offb(r0 + 16, 2 * c + (p4 >> 1)) + 8 * (p4 & 1))), Pb, acc[dt]); } }
    __syncthreads();
    { const float xi = __expf((float)(16 * w + fr + 1) * lgh); bf16x8 Qx[4];
#pragma unroll
      for (int s = 0; s < 4; ++s) { const u32x4 r = __builtin_bit_cast(u32x4, Qf[s]); u32x4 o; o.x = pkbf(bflo(r.x) * xi, bfhi(r.x) * xi); o.y = pkbf(bflo(r.y) * xi, bfhi(r.y) * xi); o.z = pkbf(bflo(r.z) * xi, bfhi(r.z) * xi); o.w = pkbf(bflo(r.w) * xi, bfhi(r.w) * xi); Qx[s] = __builtin_bit_cast(bf16x8, o); }
#pragma unroll
      for (int dt = 0; dt < 16; ++dt) { LAS unsigned char* rb = lds + (dt < 8 ? 98304 : 0);
#pragma unroll
          for (int s = 0; s < 4; ++s) { const bf16x8 rf = *(const LAS bf16x8*)(rb + offb(16 * (dt & 7) + fr, 4 * s + fq)); acc[dt] = mfma16(rf, Qx[s], acc[dt]); } } }
    u32x2 gg[16];
    { const bf16_t* gp = Z + ZO_GR + ((size_t)h * NP + row) * 256 + 4 * fq;
#pragma unroll
      for (int dt = 0; dt < 16; ++dt) gg[dt] = *(const u32x2*)(gp + 16 * dt); }
    __builtin_amdgcn_sched_barrier(0);
    float ss = 0.f;
#pragma unroll
    for (int dt = 0; dt < 16; ++dt) ss += acc[dt][0] * acc[dt][0] + acc[dt][1] * acc[dt][1] + acc[dt][2] * acc[dt][2] + acc[dt][3] * acc[dt][3];
    ss += shx(ss, 16); ss += shx(ss, 32);
    const float rstd = rsqrtf(ss * (1.f / 256.f) + EPS);
    bf16_t* op = ORET + row * DM + h * 256 + 4 * fq;
#pragma unroll
    for (int dt = 0; dt < 16; ++dt) { const u32x2 g = gg[dt]; const float g0 = bflo(g.x), g1 = bfhi(g.x), g2 = bflo(g.y), g3 = bfhi(g.y);
        u32x2 o; o.x = pkbf(acc[dt][0] * rstd * g0 * sigmoidf_(g0), acc[dt][1] * rstd * g1 * sigmoidf_(g1)); o.y = pkbf(acc[dt][2] * rstd * g2 * sigmoidf_(g2), acc[dt][3] * rstd * g3 * sigmoidf_(g3));
        *(u32x2*)(op + 16 * dt) = o; }
    __syncthreads();
}

__device__ __forceinline__ void p8_rms(const float* X, const float* nw, bf16_t* H2, int gw, int nwv, int lane) {
    float4 wv[4];
#pragma unroll
    for (int j = 0; j < 4; ++j) wv[j] = *(const float4*)(nw + j * 256 + lane * 4);
    for (int row0 = gw * 2; row0 < NR; row0 += nwv * 2) { float4 v[2][4];
#pragma unroll
        for (int k = 0; k < 2; ++k)
#pragma unroll
            for (int j = 0; j < 4; ++j) v[k][j] = *(const float4*)(X + (size_t)(row0 + k) * DM + j * 256 + lane * 4);
        __builtin_amdgcn_sched_barrier(0);
#pragma unroll
        for (int k = 0; k < 2; ++k) { float ss = 0.f;
#pragma unroll
            for (int j = 0; j < 4; ++j) ss += v[k][j].x * v[k][j].x + v[k][j].y * v[k][j].y + v[k][j].z * v[k][j].z + v[k][j].w * v[k][j].w;
            const float rstd = rsqrtf(wsum64(ss) * (1.f / 1024.f) + EPS);
#pragma unroll
            for (int j = 0; j < 4; ++j) { const float4 w = wv[j];
                u32x2 o; o.x = pkbf(v[k][j].x * rstd * w.x, v[k][j].y * rstd * w.y); o.y = pkbf(v[k][j].z * rstd * w.z, v[k][j].w * rstd * w.w); *(u32x2*)(H2 + (size_t)(row0 + k) * DM + j * 256 + lane * 4) = o; } } }
}

constexpr int PT_CAP = 65;
constexpr int PL_SVL = 0;
constexpr int PL_EL = PT_CAP * 16 * 20 * 4;
constexpr int PL_GL = PL_EL + PT_CAP * 128 * 4;
constexpr int PL_ACT = PL_GL + PT_CAP * 128 * 4;
static_assert(PL_ACT + 8 * 128 * 4 <= LDS_BAR, "PEER LDS map");

struct RowBuf { u32x4 a[8]; u32x2 b[8]; };
__device__ __forceinline__ f32x32 cv6(const u32x4& a, const u32x2& b) { u32x6 p = {a.x, a.y, a.z, a.w, b.x, b.y};
    f32x32 r = __builtin_amdgcn_cvt_scalef32_pk32_f32_fp6(p, 1.0f);
    return r; }
__device__ __forceinline__ void peer_issue(RowBuf& B, const __amdgpu_buffer_rsrc_t tab, const LAS int* el, int h, int lane) {
    const int hl = lane & 31, upi = (lane >> 5) & 1; const int lo = hl * 16, lo8 = 512 - hl * 8;
    const LAS i32x4* ep = (const LAS i32x4*)(el + h * 16 + 8 * upi); const i32x4 e0 = ep[0], e1 = ep[1];
    const int e[8] = {e0[0], e0[1], e0[2], e0[3], e1[0], e1[1], e1[2], e1[3]};
#pragma unroll
    for (int i = 0; i < 8; ++i) { const int off = e[i] * 768 + lo;
        B.a[i] = __builtin_amdgcn_raw_buffer_load_b128(tab, off, 0, 0); B.b[i] = __builtin_amdgcn_raw_buffer_load_b64(tab, off + lo8, 0, 0); }
}
__device__ __forceinline__ float peer_dot32(const f32x32& r, const f32x2 (&hf)[16]) {
    f32x2 a = {0.f, 0.f};
#pragma unroll
    for (int j = 0; j < 16; ++j) { f32x2 rr; rr.x = r[2 * j]; rr.y = r[2 * j + 1]; a = __builtin_elementwise_fma(rr, hf[j], a); }
    return a.x + a.y;
}
__device__ __forceinline__ void peer_udot(const RowBuf& B, const f32x2 (&hf)[16], LAS float* act, int h, int lane) {
    const bool h4 = lane & 16, h3 = lane & 8, h2 = lane & 4;
    float p[8];
#pragma unroll
    for (int i = 0; i < 8; ++i) { u32x4 ra = B.a[i]; u32x2 rb = B.b[i]; if (i > 0) asm volatile("" : "+v"(ra), "+v"(rb), "+v"(p[i - 1]));
        p[i] = peer_dot32(cv6(ra, rb), hf); }
    float q[4];
#pragma unroll
    for (int i = 0; i < 4; ++i) { const float snd = h4 ? p[i] : p[i + 4], keep = h4 ? p[i + 4] : p[i]; q[i] = keep + shx(snd, 16); }
    float r[2];
#pragma unroll
    for (int i = 0; i < 2; ++i) { const float snd = h3 ? q[i] : q[i + 2], keep = h3 ? q[i + 2] : q[i]; r[i] = keep + shx(snd, 8); }
    float t; { const float snd = h2 ? r[0] : r[1], keep = h2 ? r[1] : r[0]; t = keep + shx(snd, 4); }
    t += shx(t, 2); t += shx(t, 1);
    if ((lane & 3) == 0) act[h * 16 + ((lane >> 5) & 1) * 8 + ((lane >> 4) & 1) * 4 + ((lane >> 3) & 1) * 2 + ((lane >> 2) & 1)] = t;
}
__device__ __forceinline__ void peer_vacc(const RowBuf& B, const LAS float* coef, int h, int lane, f32x32& o) {
    const LAS float* cp = coef + h * 16 + ((lane >> 5) & 1) * 8;
#pragma unroll
    for (int i = 0; i < 8; ++i) { const float c = cp[i];
        u32x4 ra = B.a[i]; u32x2 rb = B.b[i]; asm volatile("" : "+v"(ra), "+v"(rb), "+v"(o));
        const f32x32 r = cv6(ra, rb);
        o = __builtin_elementwise_fma(r, (f32x32)c, o); }
}
__device__ __forceinline__ void peer_load_h(const bf16_t* H2, int row, int lane, f32x2 (&hf)[16]) {
    const bf16_t* hp = H2 + (size_t)row * DM + (lane & 31) * 32;
#pragma unroll
    for (int k = 0; k < 4; ++k) { const u32x4 v = *(const u32x4*)(hp + 8 * k);
        hf[4 * k] = (f32x2){bflo(v.x), bfhi(v.x)}; hf[4 * k + 1] = (f32x2){bflo(v.y), bfhi(v.y)}; hf[4 * k + 2] = (f32x2){bflo(v.z), bfhi(v.z)}; hf[4 * k + 3] = (f32x2){bflo(v.w), bfhi(v.w)}; }
}
__device__ __forceinline__ void peer_join(const f32x32& o, int lane, f32x2 (&y)[8]) {
    (void)lane;
#pragma unroll
    for (int j = 0; j < 8; ++j) {
        const u32x2 p0 = __builtin_amdgcn_permlane32_swap(__float_as_uint(o[2 * j]), __float_as_uint(o[16 + 2 * j]), false, false);
        const u32x2 p1 = __builtin_amdgcn_permlane32_swap(__float_as_uint(o[2 * j + 1]), __float_as_uint(o[16 + 2 * j + 1]), false, false);
        y[j].x = __uint_as_float(p0.x) + __uint_as_float(p0.y); y[j].y = __uint_as_float(p1.x) + __uint_as_float(p1.y); }
}
#define MK_FRESH_LANE() int lane; asm volatile("v_mbcnt_lo_u32_b32 %0, -1, 0\n\tv_mbcnt_hi_u32_b32 %0, -1, %0" : "=v"(lane));
__device__ __forceinline__ void p10_peer(const Params& P, int l, const int* SC, const bf16_t* H2, float* X, bf16_t* Hn, LAS unsigned char* lds, int w, int bid, int G) {
    const int t0 = (int)(((long)bid * NP) / G), t1 = (int)(((long)(bid + 1) * NP) / G);
    LAS int* svl = (LAS int*)(lds + PL_SVL); LAS int* elist = (LAS int*)(lds + PL_EL); LAS float* glist = (LAS float*)(lds + PL_GL);
    const __amdgpu_buffer_rsrc_t Ub = __builtin_amdgcn_make_buffer_rsrc((void*)(P.ws + WS_UBF + (size_t)l * SZ_TAB6), 0, (int)SZ_TAB6, 0x00020000);
    const __amdgpu_buffer_rsrc_t Vb = __builtin_amdgcn_make_buffer_rsrc((void*)(P.ws + WS_VBF + (size_t)l * SZ_TAB6), 0, (int)SZ_TAB6, 0x00020000);
    const float* USC = (const float*)(P.ws + WS_TSC) + (size_t)l * 16384; const float* VSC = (const float*)(P.ws + WS_TSC) + (size_t)(2 + l) * 16384;
    const bool last = (l == NLAYER - 1); const float* nwn = P.in[7] + (last ? 0 : (l + 1) * DM);
    for (int c0 = t0; c0 < t1; c0 += PT_CAP - 1) {
        const int ntp = (t1 - c0) < PT_CAP - 1 ? (t1 - c0) : PT_CAP - 1; const int smp = (c0 == t0 && bid < NSMP) ? NP + bid : -1; const int nt = ntp + (smp >= 0 ? 1 : 0);
#define MK_ROWOF(ti) ((ti) < ntp ? c0 + (ti) : smp)
#ifndef MK_P10MASK
#define MK_P10MASK 31
#endif
        if (MK_P10MASK & 1) { MK_FRESH_LANE(); const int ngrp = (nt + 15) >> 4;
          for (int it = w; it < ngrp * 4; it += 8) { const int tg = it >> 2, hq = it & 3, ti = tg * 16 + (lane & 15), hpi = hq * 4 + (lane >> 4); const bool ok = ti < nt; const int row = MK_ROWOF(ok ? ti : nt - 1);
            const int* sp = SC + ((size_t)(row >> 4) * 512 + hpi * 32) * 64 + (row & 15) * 4;
            int sv[16];
#pragma unroll
            for (int i = 0; i < 16; ++i) sv[i] = (int)0x80000000;
            i32x4 va[8], vb[8];
#pragma unroll
            for (int j = 0; j < 8; ++j) va[j] = *(const i32x4*)(sp + (size_t)j * 64);
#pragma unroll
            for (int b = 0; b < 4; ++b) {
                if (b < 3) {
#pragma unroll
                    for (int j = 0; j < 8; ++j) { const i32x4 t = *(const i32x4*)(sp + (size_t)((b + 1) * 8 + j) * 64); if (b & 1) va[j] = t; else vb[j] = t; } }
                __builtin_amdgcn_sched_barrier(0);
#pragma unroll
                for (int j = 0; j < 8; ++j) { const i32x4 v = (b & 1) ? vb[j] : va[j]; ins16(sv, v[0]); ins16(sv, v[1]); ins16(sv, v[2]); ins16(sv, v[3]); }
                __builtin_amdgcn_sched_barrier(0);
            }
            if (ok) { LAS int* d = svl + (ti * 16 + hpi) * 20;
#pragma unroll
                for (int i = 0; i < 4; ++i) *(LAS i32x4*)(d + 4 * i) = (i32x4){sv[4 * i], sv[4 * i + 1], sv[4 * i + 2], sv[4 * i + 3]}; } } }
        __syncthreads();
        if (MK_P10MASK & 2) { MK_FRESH_LANE(); const int tid = w * 64 + lane; for (int it = tid; it < nt * 8; it += 512) { const int ti = it >> 3, h = it & 7; const LAS int* pa = svl + (ti * 16 + 2 * h) * 20; const LAS int* pb = pa + 20;
            float fa[16], fb[16];
#pragma unroll
            for (int i = 0; i < 4; ++i) { const i32x4 va = *(const LAS i32x4*)(pa + 4 * i), vb = *(const LAS i32x4*)(pb + 4 * i);
#pragma unroll
                for (int e = 0; e < 4; ++e) { fa[4 * i + e] = unsortable(va[e] & ~127); fb[4 * i + e] = unsortable(vb[e] & ~127); } }
            int top[16];
#pragma unroll
            for (int i = 0; i < 16; ++i) top[i] = (int)0x80000000;
#pragma unroll
            for (int i = 0; i < 16; ++i)
#pragma unroll
                for (int j = 0; j < 16; ++j) if ((i + 1) * (j + 1) <= 16) ins16(top, (sortable(fa[i] + fb[j]) & ~255) | (255 - (i * 16 + j)));
            float ev[16]; float sum = 0.f; const float mxv = unsortable(top[0] & ~255);
#pragma unroll
            for (int k = 0; k < 16; ++k) { ev[k] = __expf(unsortable(top[k] & ~255) - mxv); sum += ev[k]; }
            const float inv = 1.f / sum;
#pragma unroll
            for (int k = 0; k < 16; ++k) { const int cidx = 255 - (top[k] & 255), ia = 127 - (pa[cidx >> 4] & 127), ib = 127 - (pb[cidx & 15] & 127);
                elist[ti * 128 + h * 16 + k] = ia * 128 + ib; glist[ti * 128 + h * 16 + k] = ev[k] * inv; } } }
        __syncthreads();
        if (MK_P10MASK & 4) { LAS float* actl = (LAS float*)(lds + PL_SVL);
          if (MK_P10MASK & 8) { MK_FRESH_LANE(); RowBuf B0, B1;
            for (int ti = w; ti < ntp; ti += 8) {
              const int row = c0 + ti; const LAS int* el = elist + ti * 128; LAS float* act = actl + ti * 128;
              peer_issue(B0, Ub, el, 0, lane);
              f32x2 hf[16]; peer_load_h(H2, row, lane, hf);
#pragma unroll 1
              for (int hh = 0; hh < 6; hh += 2) {
                  peer_issue(B1, Ub, el, hh + 1, lane);
                  peer_udot(B0, hf, act, hh, lane);
                  peer_issue(B0, Ub, el, hh + 2, lane);
                  peer_udot(B1, hf, act, hh + 1, lane);
              }
              peer_issue(B1, Ub, el, 7, lane);
              peer_udot(B0, hf, act, 6, lane);
              peer_udot(B1, hf, act, 7, lane); } }
          if (smp >= 0) { MK_FRESH_LANE(); const int ti = ntp, row = smp; const LAS int* el = elist + ti * 128; LAS float* act = actl + ti * 128;
              RowBuf B; peer_issue(B, Ub, el, w, lane);
              f32x2 hf[16]; peer_load_h(H2, row, lane, hf);
              peer_udot(B, hf, act, w, lane); }
          __syncthreads();
          { MK_FRESH_LANE(); float us0[9], us1[9], vs0[9], vs1[9];
#pragma unroll
            for (int k = 0; k < 9; ++k) { const int ti = w + 8 * k; us0[k] = us1[k] = vs0[k] = vs1[k] = 0.f;
                if (ti < nt) { const LAS int* el = elist + ti * 128; const int e0 = el[lane], e1 = el[64 + lane]; us0[k] = USC[e0]; us1[k] = USC[e1]; vs0[k] = VSC[e0]; vs1[k] = VSC[e1]; } }
            __builtin_amdgcn_sched_barrier(0);
#pragma unroll
            for (int k = 0; k < 9; ++k) { const int ti = w + 8 * k;
                if (ti < nt) { const LAS float* gl = glist + ti * 128; LAS float* act = actl + ti * 128;
                    const float a0 = act[lane] * us0[k], a1 = act[64 + lane] * us1[k]; const float g0 = gl[lane] * vs0[k], g1 = gl[64 + lane] * vs1[k];
                    act[lane] = g0 * 0.5f * a0 * (1.f + erff(a0 * 0.70710678118654752f)); act[64 + lane] = g1 * 0.5f * a1 * (1.f + erff(a1 * 0.70710678118654752f)); } } }
          __syncthreads();
          if (MK_P10MASK & 16) { MK_FRESH_LANE(); RowBuf B0, B1;
            const int dofw = (lane & 31) * 32 + ((lane >> 5) & 1) * 16;
            const float4 w0 = *(const float4*)(nwn + dofw), w1 = *(const float4*)(nwn + dofw + 4), w2 = *(const float4*)(nwn + dofw + 8), w3 = *(const float4*)(nwn + dofw + 12);
            for (int ti = w; ti < ntp; ti += 8) {
              const int row = c0 + ti; const LAS int* el = elist + ti * 128; const LAS float* act = actl + ti * 128;
              peer_issue(B0, Vb, el, 0, lane);
              f32x32 o = (f32x32)0.f;
#pragma unroll 1
              for (int hh = 0; hh < 6; hh += 2) {
                  peer_issue(B1, Vb, el, hh + 1, lane);
                  peer_vacc(B0, act, hh, lane, o);
                  peer_issue(B0, Vb, el, hh + 2, lane);
                  peer_vacc(B1, act, hh + 1, lane, o);
              }
              peer_issue(B1, Vb, el, 7, lane);
              peer_vacc(B0, act, 6, lane, o);
              const int dof = (lane & 31) * 32 + ((lane >> 5) & 1) * 16;
              float* xr = X + (size_t)row * DM + dof;
              const float4 x0 = *(const float4*)(xr), x1 = *(const float4*)(xr + 4), x2 = *(const float4*)(xr + 8), x3 = *(const float4*)(xr + 12);
              __builtin_amdgcn_sched_barrier(0);
              peer_vacc(B1, act, 7, lane, o);
              asm volatile("" ::: "memory"); __builtin_amdgcn_sched_barrier(0);
              f32x2 yo[8]; peer_join(o, lane, yo);
              float y[16];
              {
                y[0] = x0.x + yo[0].x; y[1] = x0.y + yo[0].y; y[2] = x0.z + yo[1].x; y[3] = x0.w + yo[1].y; y[4] = x1.x + yo[2].x; y[5] = x1.y + yo[2].y; y[6] = x1.z + yo[3].x; y[7] = x1.w + yo[3].y;
                y[8] = x2.x + yo[4].x; y[9] = x2.y + yo[4].y; y[10] = x2.z + yo[5].x; y[11] = x2.w + yo[5].y; y[12] = x3.x + yo[6].x; y[13] = x3.y + yo[6].y; y[14] = x3.z + yo[7].x; y[15] = x3.w + yo[7].y; }
              float* dst = last ? (row < NP ? P.out + O_YP + (size_t)row * DM : P.out + O_YS + (size_t)(row - NP) * DM) + dof : xr;
              *(float4*)(dst) = make_float4(y[0], y[1], y[2], y[3]); *(float4*)(dst + 4) = make_float4(y[4], y[5], y[6], y[7]);
              *(float4*)(dst + 8) = make_float4(y[8], y[9], y[10], y[11]); *(float4*)(dst + 12) = make_float4(y[12], y[13], y[14], y[15]);
              if (!last) { float ss = 0.f;
#pragma unroll
                  for (int i = 0; i < 16; ++i) ss += y[i] * y[i];
                  const float rstd = rsqrtf(wsum64(ss) * (1.f / 1024.f) + EPS);
                  u32x4 o0, o1; o0.x = pkbf(y[0] * rstd * w0.x, y[1] * rstd * w0.y); o0.y = pkbf(y[2] * rstd * w0.z, y[3] * rstd * w0.w); o0.z = pkbf(y[4] * rstd * w1.x, y[5] * rstd * w1.y); o0.w = pkbf(y[6] * rstd * w1.z, y[7] * rstd * w1.w);
                  o1.x = pkbf(y[8] * rstd * w2.x, y[9] * rstd * w2.y); o1.y = pkbf(y[10] * rstd * w2.z, y[11] * rstd * w2.w); o1.z = pkbf(y[12] * rstd * w3.x, y[13] * rstd * w3.y); o1.w = pkbf(y[14] * rstd * w3.z, y[15] * rstd * w3.w);
                  *(u32x4*)(Hn + (size_t)row * DM + dof) = o0; *(u32x4*)(Hn + (size_t)row * DM + dof + 8) = o1; }
            } }
          if (smp >= 0) { MK_FRESH_LANE(); const int ti = ntp, row = smp; const LAS int* el = elist + ti * 128; const LAS float* act = actl + ti * 128;
              LAS float* part = (LAS float*)(lds + PL_SVL + 36864); LAS float* red = part + 8192;
              RowBuf B; peer_issue(B, Vb, el, w, lane);
              f32x32 o = (f32x32)0.f;
              peer_vacc(B, act, w, lane, o);
              { f32x2 yo[8]; peer_join(o, lane, yo); const int dof = (lane & 31) * 32 + ((lane >> 5) & 1) * 16;
#pragma unroll
                for (int i = 0; i < 4; ++i) *(LAS f32x4*)(part + w * 1024 + dof + 4 * i) = (f32x4){yo[2 * i].x, yo[2 * i].y, yo[2 * i + 1].x, yo[2 * i + 1].y}; }
              __syncthreads();
              const int tid = w * 64 + lane; float y0 = 0.f, y1 = 0.f;
#pragma unroll
              for (int ww = 0; ww < 8; ++ww) { y0 += part[ww * 1024 + 2 * tid]; y1 += part[ww * 1024 + 2 * tid + 1]; }
              float* xr = X + (size_t)row * DM + 2 * tid; const float2 xv = *(const float2*)xr; y0 += xv.x; y1 += xv.y;
              float* dst = last ? P.out + O_YS + (size_t)(row - NP) * DM + 2 * tid : xr; *(float2*)dst = make_float2(y0, y1);
              if (!last) { const float s = wsum64(y0 * y0 + y1 * y1); if (lane == 0) red[w] = s;
                  __syncthreads();
                  const float ss = red[0] + red[1] + red[2] + red[3] + red[4] + red[5] + red[6] + red[7]; const float rstd = rsqrtf(ss * (1.f / 1024.f) + EPS); const float2 wn = *(const float2*)(nwn + 2 * tid);
                  *(unsigned*)(Hn + (size_t)row * DM + 2 * tid) = pkbf(y0 * rstd * wn.x, y1 * rstd * wn.y); }
          } }
        __syncthreads();
#undef MK_ROWOF
    }
}

constexpr int NPH = 1 + 10 * NLAYER;
__global__ void __launch_bounds__(512, 2) mk_fwd(Params P) {
    extern __shared__ __attribute__((aligned(16))) unsigned char lds_raw[];
    LAS unsigned char* lds = (LAS unsigned char*)lds_raw;
    const int wave = __builtin_amdgcn_readfirstlane((int)threadIdx.x >> 6), bid = blockIdx.x, G = gridDim.x;
    const int nw = G * 8;
    unsigned char* ws = P.ws;
    XcdBarrier bar; bar.wv = wave; bar.bar = (unsigned*)(ws + WS_CTL); bar.x = 0; bar.st = (volatile LAS unsigned*)(lds + LDS_BAR);
    if (P.use_bar) {
        if (wave == 0 && xb_lane() == 0u) *(LAS u32x4*)(lds + LDS_BAR) = (u32x4){0u, 0u, 0u, 0u};
        __syncthreads();
        bar = xcd_barrier_post((unsigned*)(ws + WS_CTL), (volatile LAS unsigned*)(lds + LDS_BAR), wave);
    }
    const int lo = P.ph_lo, hi = P.ph_hi;
#define IN(k) (lo <= (k) && (k) < hi)
#ifndef MK_PHMASK
#define MK_PHMASK 0xffff
#endif
#define PHM(k) ((MK_PHMASK >> (k)) & 1)
#ifndef MK_P3MASK
#define MK_P3MASK 0xf
#endif
#define P3M(k) ((MK_P3MASK >> (k)) & 1)
#ifndef MK_REP
#define MK_REP -1
#endif
#define NREP(k) ((MK_REP == (k) && l == NLAYER - 1) ? 2 : 1)
#ifdef MK_DBLBAR
#define SEAM(k) do { if (IN(k) && IN((k) + 1)) { xcd_barrier(bar); xcd_barrier(bar); } } while (0)
#else
#define SEAM(k) do { if (IN(k) && IN((k) + 1)) xcd_barrier(bar); } while (0)
#endif
#define PH_T() int t_; asm volatile("v_mbcnt_lo_u32_b32 %0, -1, 0\n\tv_mbcnt_hi_u32_b32 %0, -1, %0" : "=v"(t_)); t_ += wave * 64; const int l_ = t_ & 63, w_ = __builtin_amdgcn_readfirstlane(t_ >> 6), gw_ = bid * 8 + w_, gwr_ = (G - 1 - bid) * 8 + w_; (void)l_; (void)gw_; (void)gwr_; \
    unsigned long long wsv_ = (unsigned long long)P.ws; asm volatile("" : "+s"(wsv_)); unsigned char* wsp = (unsigned char*)(__attribute__((address_space(1))) unsigned char*)wsv_;   \
    bf16_t* const H = (bf16_t*)(wsp + WS_H); bf16_t* const H2 = (bf16_t*)(wsp + WS_H2); bf16_t* const Z = (bf16_t*)(wsp + WS_Z); float* const X = (float*)(wsp + WS_XRES); \
    bf16_t* const OG = (bf16_t*)(wsp + WS_OG); float* const LSE = (float*)(wsp + WS_LSE); bf16_t* const AO = (bf16_t*)(wsp + WS_AO); \
    float* const RU = (float*)(wsp + WS_RU); bf16_t* const RS = (bf16_t*)(wsp + WS_RS); bf16_t* const ORET = (bf16_t*)(wsp + WS_ORET); \
    float* const MIX1 = (float*)(wsp + WS_MIX1); bf16_t* const MIXED = (bf16_t*)(wsp + WS_MIXED); int* const SC = (int*)(wsp + WS_SC); \
    (void)H; (void)H2; (void)Z; (void)X; (void)OG; (void)LSE; (void)AO; (void)RU; (void)RS; (void)ORET; (void)MIX1; (void)MIXED; (void)SC;
#define PH_W() const bf16_t* WtIn = (const bf16_t*)(wsp + WS_WTIN + l * SZ_WTIN); const bf16_t* WtOa = (const bf16_t*)(wsp + WS_WTOA + l * SZ_WTOA); const bf16_t* WtOr = (const bf16_t*)(wsp + WS_WTOR + l * SZ_WSQ); \
    const bf16_t* WtOut = (const bf16_t*)(wsp + WS_WTOUT + l * SZ_WSQ); const bf16_t* WtS = (const bf16_t*)(wsp + WS_WTS + l * SZ_WTS); (void)WtIn; (void)WtOa; (void)WtOr; (void)WtOut; (void)WtS;
    if (PHM(0) && IN(0)) for (int rep_ = 0; rep_ < (MK_REP == 0 ? 2 : 1); ++rep_) { PH_T(); p0_prologue(P, lds, t_, bid, G); }
    SEAM(0);
#pragma unroll
    for (int l = 0; l < NLAYER; ++l) {
        const int pb = 1 + 10 * l;
        if (PHM(1) && IN(pb + 0)) for (int rep_ = 0; rep_ < NREP(1); ++rep_) { PH_T(); PH_W(); pg8::Gemm g{H, WtIn, NP, INC, DM}; pg8::StaticOrder S; S.init(NP, INC, G, bid); const float* bg = P.in[9] + (size_t)l * 2048; EpiZ E{Z, bg};
            pg8::gemm_phase<EpiZ, pg8::StaticOrder, false>(lds, g, S, E, nullptr, t_);
            skinny<QZ>(H + (size_t)NP * DM, WtIn, INC, DM, QZ{Z, bg}, gwr_, nw, l_);
            if (bid >= G / 2) conv_tables(P, l, (bid - G / 2) * 8 + w_, (G - G / 2) * 8, l_); }
        SEAM(pb + 0);
#ifndef MK_REP3SUB
#define MK_REP3SUB 0
#endif
#define NREP3(s) ((((MK_REP3SUB >> (s)) & 1) && l == NLAYER - 1) ? 2 : 1)
        if (PHM(3) && IN(pb + 2)) { PH_T();
            if (P3M(1)) for (int rr = 0; rr < NREP3(1); ++rr) for (int u = bid; u < 512; u += G) ret1_unit(P, Z, RU, u, lds, t_);
            if (P3M(0)) for (int rr = 0; rr < NREP3(0); ++rr) attn_phase(P, l, Z, OG, LSE, lds, t_, bid, G);
        }
        SEAM(pb + 2);
        if (PHM(4) && IN(pb + 3)) for (int rep_ = 0; rep_ < NREP(4); ++rep_) { PH_T();
            for (int u = G - 1 - bid; u < 128; u += G) sret_unit(P, l, Z, ORET, u, lds, t_);
            for (int u = G - 1 - bid; u < 96; u += G) sattn_unit(P, l, Z, OG, LSE, u, lds, t_);
            p4_scan_combine(P, l, RU, RS, OG, LSE, AO, t_, bid, G); }
        SEAM(pb + 3);
        if (PHM(5) && IN(pb + 4)) for (int rep_ = 0; rep_ < NREP(5); ++rep_) { PH_T(); if (gw_ < NSMP) combine_row(OG, LSE, AO, NP + gw_, l_); for (int u = bid; u < 512; u += G) ret3_unit(P, Z, RS, ORET, u, lds, t_); }
        SEAM(pb + 4);
        if (PHM(6) && IN(pb + 5)) for (int rep_ = 0; rep_ < NREP(6); ++rep_) { PH_T(); PH_W();
            { pg8::Gemm g{AO, WtOa, NP, DM, 512}; pg8::StaticOrder S; S.init(NP, DM, G, bid); EpiQuadB<QGateA, 4> E{QGateA{Z, MIX1}};
              pg8::gemm_phase<EpiQuadB<QGateA, 4>, pg8::StaticOrder, false>(lds, g, S, E, nullptr, t_);
              skinny8<QGateA>(AO + (size_t)NP * 512, WtOa, DM, 512, QGateA{Z, MIX1}, G - 1 - bid, G, w_, l_, lds); }
            { pg8::Gemm g{ORET, WtOr, NP, DM, DM}; pg8::StaticOrder S; S.init(NP, DM, G, bid); EpiQuadB<QGateB, 4> E{QGateB{Z, MIX1, MIXED}};
              pg8::gemm_phase<EpiQuadB<QGateB, 4>, pg8::StaticOrder, false>(lds, g, S, E, nullptr, t_);
              skinny8<QGateB>(ORET + (size_t)NP * DM, WtOr, DM, DM, QGateB{Z, MIX1, MIXED}, G - 1 - bid, G, w_, l_, lds); } }
        SEAM(pb + 5);
        if (PHM(7) && IN(pb + 6)) for (int rep_ = 0; rep_ < NREP(7); ++rep_) { PH_T(); PH_W(); pg8::Gemm g{MIXED, WtOut, NP, DM, DM}; pg8::StaticOrder S; S.init(NP, DM, G, bid); const float* xp_ = l == 0 ? P.in[0] : X; const float* xs_ = l == 0 ? P.in[1] : X + (size_t)NP * DM; EpiQuadB<QRes, 4> E{QRes{xp_, xs_, X}};
            pg8::gemm_phase<EpiQuadB<QRes, 4>, pg8::StaticOrder, false>(lds, g, S, E, nullptr, t_);
            skinny8<QRes>(MIXED + (size_t)NP * DM, WtOut, DM, DM, QRes{xp_, xs_, X}, G - 1 - bid, G, w_, l_, lds); }
        SEAM(pb + 6);
        if (PHM(8) && IN(pb + 7)) for (int rep_ = 0; rep_ < NREP(8); ++rep_) { PH_T(); p8_rms(X, P.in[15] + (size_t)l * DM, H2, gw_, nw, l_); }
        SEAM(pb + 7);
        if (PHM(9) && IN(pb + 8)) for (int rep_ = 0; rep_ < NREP(9); ++rep_) { PH_T(); PH_W(); pg8::Gemm g{H2, WtS, NP, 2048, DM}; pg8::StaticOrder S; S.init(NP, 2048, G, bid); EpiQuad<QKey> E{QKey{SC}};
            pg8::gemm_phase<EpiQuad<QKey>, pg8::StaticOrder, false>(lds, g, S, E, nullptr, t_);
            skinny8<QKey>(H2 + (size_t)NP * DM, WtS, 2048, DM, QKey{SC}, G - 1 - bid, G, w_, l_, lds); }
        SEAM(pb + 8);
        if (PHM(10) && IN(pb + 9)) for (int rep_ = 0; rep_ < NREP(10); ++rep_) { PH_T(); p10_peer(P, l, SC, H2, X, H, lds, wave, bid, G); }
        SEAM(pb + 9);
    }
#undef IN
#undef SEAM
}
}

#ifndef MK_ONE_LAUNCH
#define MK_ONE_LAUNCH 1
#endif
static int t5_bucket(long dist) {
    const int max_exact = 16;
    if (dist < max_exact) return (int)dist;
    const double ratio = log((double)(dist < 1 ? 1 : dist) / max_exact) / log(2048.0 / max_exact);
    long large = max_exact + (long)(ratio * (32 - max_exact));
    return (int)(large < 31 ? large : 31);
}
extern "C" void kernel_launch(void* const* d_in, const int* in_sizes, int n_in, void* d_out, int out_size, void* d_ws, size_t ws_size, hipStream_t stream) {
    using namespace mk;
    static int grid = 0;
    if (grid == 0) {
        if (n_in != 20 || (size_t)out_size != O_END || ws_size < WS_END) { fprintf(stderr, "kernel_launch: unexpected shapes (n_in %d out %d ws %zu need %zu)\n", n_in, out_size, ws_size, (size_t)WS_END); grid = -1; return; }
        int dev = 0, cus = 0, per_cu = 0;
        if (hipGetDevice(&dev) != hipSuccess || hipDeviceGetAttribute(&cus, hipDeviceAttributeMultiprocessorCount, dev) != hipSuccess) { grid = -1; return; }
        if (hipFuncSetAttribute((const void*)mk_fwd, hipFuncAttributeMaxDynamicSharedMemorySize, LDS_BYTES) != hipSuccess) { fprintf(stderr, "kernel_launch: hipFuncSetAttribute failed\n"); grid = -1; return; }
        if (hipOccupancyMaxActiveBlocksPerMultiprocessor(&per_cu, (const void*)mk_fwd, 512, LDS_BYTES) != hipSuccess || per_cu < 1) { fprintf(stderr, "kernel_launch: occupancy query says %d\n", per_cu); (void)hipGetLastError(); }
        grid = cus;
    }
    if (grid < 0) return;
    Params p; memset(&p, 0, sizeof(p));
    for (int i = 0; i < 20; ++i) p.in[i] = (const float*)d_in[i];
    p.out = (float*)d_out; p.ws = (unsigned char*)d_ws; p.rsq128 = 0.08838834764831845f;
    for (int i = 0; i < 64; ++i) { const double lin = (i == 63) ? 1.0 : i * (1.0 / 63.0); p.ang[i] = (float)(1.0 / pow(10000.0, lin)); }
    for (int h = 0; h < 4; ++h) p.logg[h] = (float)log(1.0 - pow(2.0, -5.0 - h));
    for (int g = 0; g < 3; ++g) for (int m = 0; m <= 128; ++m) p.bucket[g][m] = (unsigned char)t5_bucket((long)m << (2 * g));
    (void)hipMemsetAsync(d_ws, 0, CTL_BYTES, stream);
#if MK_ONE_LAUNCH
    p.ph_lo = 0; p.ph_hi = NPH; p.use_bar = 1;
    hipLaunchKernelGGL(mk_fwd, dim3(grid), dim3(512), LDS_BYTES, stream, p);
#else
    for (int ph = 0; ph < NPH; ++ph) { p.ph_lo = ph; p.ph_hi = ph + 1; p.use_bar = 0; hipLaunchKernelGGL(mk_fwd, dim3(grid), dim3(512), LDS_BYTES, stream, p); }
#endif
}
```

```cpp
#include <hip/hip_runtime.h>
#include <math.h>
#include <stdio.h>
#include <string.h>
namespace pg8 {
#define PG8_LAS __attribute__((address_space(3)))
typedef unsigned short bf16_t;
typedef short bf16x8 __attribute__((ext_vector_type(8)));
typedef float f32x4 __attribute__((ext_vector_type(4)));
typedef unsigned u32x4 __attribute__((ext_vector_type(4)));
constexpr int BM = 256, BK = 64, HALF = 128, HTB = HALF * BK * 2  , STAGE_BYTES = 8 * HTB, NXCD = 8, WGM = 8;

__host__ __device__ __forceinline__ int lds_byte(int r, int c) { const int st = (r >> 4) * 2 + (c >> 5), rr = r & 15, cc = c & 31, ob = rr * 64 + cc * 2; return st * 1024 + (ob ^ (((ob >> 9) & 1) << 5)); }
__host__ __device__ __forceinline__ void stage_rc(int b, int& R, int& C) { const int st = b / 1024, sb = b % 1024, swz = sb ^ (((sb >> 9) & 1) << 5); R = (st >> 1) * 16 + swz / 64; C = (st & 1) * 32 + (swz % 64) / 2; }
__host__ __device__ __forceinline__ int perm32(int rho) { const int n = rho >> 4, i = rho & 15; return 8 * (i >> 2) + 4 * n + (i & 3); }

struct Unit { int pm, pn; };
struct Gemm { const bf16_t* A; const bf16_t* Bt; int M, N, K; };

struct StaticOrder {
    int nM, nN, nwg, G, c;
    __host__ __device__ void init(int M, int N, int G_, int c_) { nM = M / BM; nN = N / BM; nwg = nM * nN; G = G_; c = c_; }
    __host__ __device__ bool next(int i, Unit& u) const {
        const long L = (long)i * G + c; if (L >= nwg) return false;
        int wgid = (int)L; { const int q = nwg / NXCD, r = nwg % NXCD, xcd = wgid % NXCD, off = wgid / NXCD; wgid = (xcd < r ? xcd * (q + 1) : r * (q + 1) + (xcd - r) * q) + off; }
        const int nig = WGM * nN, gid = wgid / nig, fm = gid * WGM, gsz = (nM - fm) < WGM ? (nM - fm) : WGM;
        u.pm = fm + ((wgid % nig) % gsz); u.pn = (wgid % nig) / gsz; return true;
    }
    __device__ __forceinline__ void a_ready(const Unit&) const {}
    __device__ __forceinline__ void done(const Unit&) const {}
};
__device__ __forceinline__ unsigned cvt_pk_bf16(float lo, float hi) { unsigned r; asm volatile("v_cvt_pk_bf16_f32 %0, %1, %2" : "=v"(r) : "v"(lo), "v"(hi)); return r; }
template <class Epi, class Sched, bool STAMP = false>
__device__ __forceinline__ void gemm_phase(PG8_LAS unsigned char* lds, const Gemm g, const Sched& S, const Epi& E, unsigned long long* stamps, int tid_in) {
    int tid_ = tid_in; asm volatile("" : "+v"(tid_));
    const int tid = tid_, wid = __builtin_amdgcn_readfirstlane(tid >> 6), lane = tid & 63, wr = wid >> 2, wc = wid & 3, fr = lane & 15, fq = lane >> 4;
    const int K = g.K, nt = K / BK;
    int ts_lo = 0, ts_hi = 0, nts = 0; const unsigned long long rt_entry = STAMP ? (unsigned long long)wall_clock64() : 0ull;
#define PG8_STAMP() do { if (STAMP && wid == 0 && nts < 64) { const unsigned long long _c = (unsigned long long)clock64(); \
        ts_lo = (lane == nts) ? (int)(unsigned)_c : ts_lo; ts_hi = (lane == nts) ? (int)(unsigned)(_c >> 32) : ts_hi; ++nts; } } while (0)
    PG8_STAMP();
    unsigned voffA[2], voffB[2];
#pragma unroll
    for (int i = 0; i < 2; ++i) { int R, C; stage_rc(tid * 16 + i * 8192, R, C); const int Rb = Epi::PERM ? ((R & ~31) + perm32(R & 31)) : R;
        voffA[i] = (unsigned)(R * K + C) * 2u; voffB[i] = (unsigned)(Rb * K + C) * 2u; }
    const size_t kstep = (size_t)(BK * 2);
    const size_t hstep = (size_t)HALF * K * 2;
    const size_t tstep = 2 * hstep;
    const unsigned ldsw = (unsigned)wid * 1024u;
    const int aoff = lds_byte(wr * 64 + fr, fq * 8), boff = lds_byte(wc * 32 + fr, fq * 8);
#define PG8_SA(b, h) (((b) * 2 + (h)) * HTB)
#define PG8_SB(b, h) ((4 + (b) * 2 + (h)) * HTB)
#define PG8_STAGE(bufoff, gbase, voff) do { _Pragma("unroll") for (int _i = 0; _i < 2; ++_i) \
        __builtin_amdgcn_global_load_lds((const unsigned*)((const char*)(gbase) + (voff)[_i]), (PG8_LAS unsigned*)(lds + (bufoff) + ldsw + _i * 8192), 16, 0, 0); } while (0)
#define PG8_LDA(dst, b, h) do { _Pragma("unroll") for (int m = 0; m < 4; ++m) _Pragma("unroll") for (int k = 0; k < 2; ++k) dst[m][k] = *(const PG8_LAS bf16x8*)(lds + PG8_SA(b, h) + aoff + m * 2048 + k * 1024); } while (0)
#define PG8_LDB(dst, b, h) do { _Pragma("unroll") for (int n = 0; n < 2; ++n) _Pragma("unroll") for (int k = 0; k < 2; ++k) dst[n][k] = *(const PG8_LAS bf16x8*)(lds + PG8_SB(b, h) + boff + n * 2048 + k * 1024); } while (0)
#define PG8_MMA(ai, bj, At, Bt) do { __builtin_amdgcn_s_setprio(1); _Pragma("unroll") for (int m = 0; m < 4; ++m) _Pragma("unroll") for (int n = 0; n < 2; ++n) _Pragma("unroll") for (int k = 0; k < 2; ++k) \
        acc[ai][bj][m][n] = __builtin_amdgcn_mfma_f32_16x16x32_bf16(Bt[n][k], At[m][k], acc[ai][bj][m][n], 0, 0, 0); __builtin_amdgcn_s_setprio(0); } while (0)
#define PG8_WAIT_V(n) asm volatile("s_waitcnt vmcnt(" #n ")" ::: "memory")
#define PG8_WAIT_L(n) asm volatile("s_waitcnt lgkmcnt(" #n ")" ::: "memory")
#define PG8_BAR __builtin_amdgcn_s_barrier()
#define PG8_SCHED __builtin_amdgcn_sched_barrier(0)
    Unit cur, nxt; int ui = 0;
    if (!S.next(0, cur)) return;
    f32x4 acc[2][2][4][2];
#pragma unroll
    for (int a = 0; a < 2; ++a)
#pragma unroll
        for (int b = 0; b < 2; ++b)
#pragma unroll
            for (int m = 0; m < 4; ++m)
#pragma unroll
                for (int n = 0; n < 2; ++n) acc[a][b][m][n] = (f32x4){0.f, 0.f, 0.f, 0.f};
    bf16x8 At[4][2], B0[2][2], B1[2][2];
    const char* cA = (const char*)g.A + (size_t)cur.pm * tstep; const char* cB = (const char*)g.Bt + (size_t)cur.pn * tstep;
    S.a_ready(cur);
    PG8_STAGE(PG8_SB(0, 0), cB, voffB); PG8_STAGE(PG8_SA(0, 0), cA, voffA); PG8_STAGE(PG8_SB(0, 1), cB + hstep, voffB); PG8_STAGE(PG8_SA(0, 1), cA + hstep, voffA);
    if (wr == 1) PG8_BAR;
    PG8_WAIT_V(4); PG8_BAR;
    PG8_STAGE(PG8_SB(1, 0), cB + kstep, voffB); PG8_STAGE(PG8_SA(1, 0), cA + kstep, voffA); PG8_STAGE(PG8_SB(1, 1), cB + hstep + kstep, voffB);
    PG8_WAIT_V(6); PG8_BAR;
    PG8_STAMP();
    for (;;) {
        const bool has_next = S.next(ui + 1, nxt);
        const char* nA = has_next ? (const char*)g.A + (size_t)nxt.pm * tstep : cA; const char* nB = has_next ? (const char*)g.Bt + (size_t)nxt.pn * tstep : cB;
        for (int t = 0; t < nt; t += 2) {
            const bool last = (t == nt - 2);
            const char* a1 = cA + (size_t)(t + 1) * kstep;
            const char* a2 = last ? nA : cA + (size_t)(t + 2) * kstep; const char* b2 = last ? nB : cB + (size_t)(t + 2) * kstep;
            const char* a3 = a2 + kstep; const char* b3 = b2 + kstep;
            if (last && has_next) S.a_ready(nxt);
            PG8_LDB(B0, 0, 0); PG8_SCHED; PG8_LDA(At, 0, 0); PG8_STAGE(PG8_SA(1, 1), a1 + hstep, voffA);
            PG8_WAIT_L(8); PG8_BAR; PG8_WAIT_L(0); PG8_MMA(0, 0, At, B0); PG8_BAR; PG8_SCHED;
            PG8_LDB(B1, 0, 1); PG8_STAGE(PG8_SB(0, 0), b2, voffB);
            PG8_BAR; PG8_WAIT_L(0); PG8_MMA(0, 1, At, B1); PG8_BAR;
            PG8_LDA(At, 0, 1); PG8_STAGE(PG8_SA(0, 0), a2, voffA);
            PG8_BAR; PG8_WAIT_L(0); PG8_MMA(1, 0, At, B0); PG8_BAR; PG8_SCHED;
            PG8_STAGE(PG8_SB(0, 1), b2 + hstep, voffB);
            PG8_WAIT_V(6); PG8_BAR; PG8_MMA(1, 1, At, B1); PG8_BAR;
            PG8_LDB(B0, 1, 0); PG8_SCHED; PG8_LDA(At, 1, 0); PG8_STAGE(PG8_SA(0, 1), a2 + hstep, voffA);
            PG8_WAIT_L(8); PG8_BAR; PG8_WAIT_L(0); PG8_MMA(0, 0, At, B0); PG8_BAR; PG8_SCHED;
            PG8_LDB(B1, 1, 1); PG8_STAGE(PG8_SB(1, 0), b3, voffB);
            PG8_BAR; PG8_WAIT_L(0); PG8_MMA(0, 1, At, B1); PG8_BAR;
            PG8_LDA(At, 1, 1); PG8_STAGE(PG8_SA(1, 0), a3, voffA);
            PG8_BAR; PG8_WAIT_L(0); PG8_MMA(1, 0, At, B0); PG8_BAR; PG8_SCHED;
            PG8_STAGE(PG8_SB(1, 1), b3 + hstep, voffB);
            PG8_WAIT_V(6); PG8_BAR; PG8_MMA(1, 1, At, B1); PG8_BAR;
        }
        PG8_STAMP();
        if constexpr (!Epi::AFTER_DRAIN) { E(acc, cur, wr, wc, fr, fq); S.done(cur); }
        PG8_STAMP();
        if (!has_next) break;
#pragma unroll
        for (int a = 0; a < 2; ++a)
#pragma unroll
            for (int b = 0; b < 2; ++b)
#pragma unroll
                for (int m = 0; m < 4; ++m)
#pragma unroll
                    for (int n = 0; n < 2; ++n) acc[a][b][m][n] = (f32x4){0.f, 0.f, 0.f, 0.f};
        cur = nxt; cA = nA; cB = nB; ++ui;
    }
    PG8_WAIT_V(0);
    if (wr == 0) PG8_BAR;
    PG8_BAR;
    if constexpr (Epi::AFTER_DRAIN) { E.fused(acc, cur, wr, wc, fr, fq, lds, wid, lane); S.done(cur); }
    PG8_STAMP();
    if (STAMP && wid == 0) { stamps[lane] = lane < nts ? (((unsigned long long)(unsigned)ts_hi << 32) | (unsigned)ts_lo) : 0ull;
        if (lane == 62) stamps[62] = rt_entry; if (lane == 63) stamps[63] = (unsigned long long)wall_clock64(); }
#undef PG8_STAMP
#undef PG8_SA
#undef PG8_SB
#undef PG8_STAGE
#undef PG8_LDA
#undef PG8_LDB
#undef PG8_MMA
#undef PG8_WAIT_V
#undef PG8_WAIT_L
#undef PG8_BAR
#undef PG8_SCHED
}
}

#define XB_TMO      128
#define XB_XCNT(j)  (256  + 64 * (j))
#define XB_XSUB(j)  (1280 + 64 * (j))
#define XB_XGEN(j)  (2304 + 64 * (j))
#define XB_TOP      3328
#define XB_TOPGEN   3392
#define XCD_BAR_WORDS 3456
#define XB_SPIN_CAP (1u << 18)
#define LAS __attribute__((address_space(3)))

__device__ __forceinline__ unsigned xb_ld(unsigned* p)              { return __hip_atomic_load(p, __ATOMIC_RELAXED, __HIP_MEMORY_SCOPE_AGENT); }
__device__ __forceinline__ unsigned xb_add(unsigned* p, unsigned v) { return __hip_atomic_fetch_add(p, v, __ATOMIC_RELAXED, __HIP_MEMORY_SCOPE_AGENT); }
__device__ __forceinline__ unsigned xb_xcc_id() { return (unsigned)__builtin_amdgcn_s_getreg((3 << 11) | 20) & 0xFu; }
#define XB_SPIN(cond, bar) do { unsigned _sp = 0; while (cond) { __builtin_amdgcn_s_sleep(1); \
    if ((++_sp & 255u) == 0u) { if (xb_ld(&(bar)[XB_TMO])) break; if (_sp > XB_SPIN_CAP) { atomicAdd(&(bar)[XB_TMO], 1u); break; } } } } while (0)

struct XcdBarrier {
    int wv;
    unsigned* bar; unsigned x;
    volatile LAS unsigned* st;
};

__device__ __forceinline__ unsigned xb_lane() { unsigned l; asm volatile("v_mbcnt_lo_u32_b32 %0, -1, 0\n\tv_mbcnt_hi_u32_b32 %0, -1, %0" : "=v"(l)); return l; }
__device__ __forceinline__ XcdBarrier xcd_barrier_post(unsigned* bar, volatile LAS unsigned* st, int wv) {
    XcdBarrier b; b.wv = wv; b.bar = bar; b.x = xb_xcc_id(); b.st = st;
    if (wv == 0 && xb_lane() == 0u) (void)xb_add(&bar[XB_XCNT(b.x)], 1u);
    return b;
}
__device__ __forceinline__ void xcd_barrier_complete(unsigned* bar, unsigned x, unsigned& nloc, unsigned& nx) {
    const unsigned G = gridDim.x * gridDim.y * gridDim.z;
    unsigned sum, cnt, mine, sp = 0u;
    for (;;) {
        sum = 0u; cnt = 0u; mine = 0u;
#pragma unroll
        for (unsigned j = 0; j < 16; ++j) { const unsigned c = xb_ld(&bar[XB_XCNT(j)]); sum += c; cnt += (c > 0u) ? 1u : 0u; mine = (j == x) ? c : mine; }
        if (sum == G) break;
        __builtin_amdgcn_s_sleep(1);
        if ((++sp & 255u) == 0u) { if (xb_ld(&bar[XB_TMO])) break; if (sp > XB_SPIN_CAP) { atomicAdd(&bar[XB_TMO], 1u); break; } }
    }
    nloc = mine > 0u ? mine : 1u; nx = cnt > 0u ? cnt : 1u;
}

__device__ __forceinline__ void xcd_barrier(const XcdBarrier& b) {
    asm volatile("s_waitcnt vmcnt(0)" ::: "memory");
    __syncthreads();
    if (b.wv == 0 && xb_lane() == 0u) {
        unsigned* bar = b.bar;
        __builtin_amdgcn_s_waitcnt(0);
        unsigned nloc = b.st[0], nx = b.st[1];
        if (nloc == 0u) { xcd_barrier_complete(bar, b.x, nloc, nx); b.st[0] = nloc; b.st[1] = nx; }
        const unsigned old = xb_add(&bar[XB_XSUB(b.x)], 1u);
        const unsigned gen = old / nloc;
        if (old + 1u == (gen + 1u) * nloc) {
            __builtin_amdgcn_fence(__ATOMIC_RELEASE, "agent");
            asm volatile("s_waitcnt vmcnt(0)" ::: "memory");
            const unsigned og = xb_add(&bar[XB_TOP], 1u);
            const unsigned tg = og / nx;
            if (og + 1u == (tg + 1u) * nx) xb_add(&bar[XB_TOPGEN], 1u);
            else XB_SPIN(xb_ld(&bar[XB_TOPGEN]) == tg, bar);
            __builtin_amdgcn_fence(__ATOMIC_ACQUIRE, "agent");
            xb_add(&bar[XB_XGEN(b.x)], 1u);
            asm volatile("s_waitcnt vmcnt(0)" ::: "memory");
        } else {
            XB_SPIN(xb_ld(&bar[XB_XGEN(b.x)]) == gen, bar);
            __builtin_amdgcn_fence(__ATOMIC_ACQUIRE, "agent");
            asm volatile("s_waitcnt vmcnt(0)" ::: "memory");
        }
    }
    __syncthreads();
}


namespace mk {
using pg8::bf16_t; using pg8::bf16x8; using pg8::f32x4; using pg8::u32x4;
typedef unsigned u32x2 __attribute__((ext_vector_type(2)));
typedef short s16x4 __attribute__((ext_vector_type(4)));
typedef int i32x4 __attribute__((ext_vector_type(4)));
typedef __bf16 bf2_t __attribute__((ext_vector_type(2)));
typedef float f32x2 __attribute__((ext_vector_type(2)));
typedef float f32x16 __attribute__((ext_vector_type(16)));
typedef float f32x32 __attribute__((ext_vector_type(32)));
typedef unsigned u32x6 __attribute__((ext_vector_type(6)));

constexpr int DM = 1024, NP = 16384, NSMP = 32, NR = NP + NSMP, INC = 9728, NLAYER = 2;
constexpr int C_QA = 0, C_KA = 1536, C_VA = 3072, C_QR = 4608, C_KR = 5120, C_VR = 5632, C_GR = 6656, C_GA = 7680, C_GB = 8704;
constexpr float EPS = 1e-6f;
constexpr int LDS_BYTES = 162816, LDS_BAR = 162800;

constexpr size_t al256(size_t x) { return (x + 255) & ~(size_t)255; }
constexpr size_t WS_CTL = 0, CTL_BYTES = 65536;
constexpr size_t SZ_WTIN = (size_t)INC * DM * 2, SZ_WTOA = (size_t)DM * 512 * 2, SZ_WSQ = (size_t)DM * DM * 2, SZ_WTS = (size_t)2048 * DM * 2, SZ_TAB = (size_t)16384 * DM * 2;
constexpr size_t WS_WTIN = WS_CTL + CTL_BYTES;
constexpr size_t WS_WTOA = WS_WTIN + NLAYER * SZ_WTIN;
constexpr size_t WS_WTOR = WS_WTOA + NLAYER * SZ_WTOA;
constexpr size_t WS_WTOUT = WS_WTOR + NLAYER * SZ_WSQ;
constexpr size_t WS_WTS = WS_WTOUT + NLAYER * SZ_WSQ;
constexpr size_t WS_UBF = WS_WTS + NLAYER * SZ_WTS;
constexpr size_t WS_VBF = WS_UBF + NLAYER * SZ_TAB;
constexpr size_t WS_XRES = WS_VBF + NLAYER * SZ_TAB;
constexpr size_t WS_H = WS_XRES + al256((size_t)NR * DM * 4);
constexpr size_t WS_H2 = WS_H + al256((size_t)NR * DM * 2);
constexpr size_t WS_Z = WS_H2 + al256((size_t)NR * DM * 2);
constexpr size_t ZO_A = 0;
constexpr size_t ZO_RQ = ZO_A + (size_t)NP * 4608;
constexpr size_t ZO_RK = ZO_RQ + (size_t)NP * 512;
constexpr size_t ZO_RV = ZO_RK + (size_t)NP * 512;
constexpr size_t ZO_GR = ZO_RV + (size_t)NP * 1024;
constexpr size_t ZO_GA = ZO_GR + (size_t)NP * 1024;
constexpr size_t ZO_GB = ZO_GA + (size_t)NP * 1024;
static_assert(ZO_GB + (size_t)NP * 1024 == (size_t)NP * INC, "compact layouts fill the prompt part of Z exactly");
constexpr size_t WS_OG = WS_Z + al256((size_t)NR * INC * 2);
constexpr size_t WS_LSE = WS_OG + al256((size_t)3 * NR * 512 * 2);
constexpr size_t WS_AO = WS_LSE + al256((size_t)3 * NR * 4 * 4);
constexpr size_t WS_RU = WS_AO + al256((size_t)NR * 512 * 2);
constexpr size_t WS_RS = WS_RU + (size_t)2 * 64 * 4 * 32768 * 4;
constexpr size_t WS_ORET = WS_RS + (size_t)2 * 64 * 4 * 32768 * 2;
constexpr size_t WS_MIX1 = WS_ORET + al256((size_t)NR * DM * 2);
constexpr size_t WS_MIXED = WS_MIX1 + al256((size_t)NR * DM * 4);
constexpr size_t WS_SC = WS_MIXED + al256((size_t)NR * DM * 2);
constexpr size_t WS_TSC = WS_SC + al256((size_t)NR * 2048 * 4);
constexpr size_t WS_CS = WS_TSC + (size_t)4 * 16384 * 4;
constexpr size_t WS_BT = WS_CS + al256((size_t)8193 * 64 * 8);
constexpr size_t WS_END = WS_BT + al256((size_t)12 * 132 * 4);
constexpr size_t SZ_TAB8 = (size_t)16384 * DM;
constexpr size_t SZ_TAB6 = (size_t)16384 * 768;

constexpr size_t O_YP = 0, O_YS = O_YP + (size_t)NP * DM, O_KV1P = O_YS + (size_t)NSMP * DM;
constexpr size_t O_KV4P = O_KV1P + (size_t)2 * 2 * 128 * 1024, O_KV16P = O_KV4P + (size_t)2 * 2 * 512 * 1024, O_RETP = O_KV16P + (size_t)2 * 2 * 2048 * 1024;
constexpr size_t O_KV1S = O_RETP + (size_t)2 * 2 * 4 * 32768, O_KV4S = O_KV1S + 65536, O_KV16S = O_KV4S + 65536, O_RETS = O_KV16S + 65536;
constexpr size_t O_END = O_RETS + (size_t)2 * 32 * 4 * 32768;

struct Params {
    const float* in[20]; float* out; unsigned char* ws;
    float ang[64]; float logg[4];
    unsigned char bucket[3][132]; unsigned char padb[4];
    int ph_lo, ph_hi, use_bar; float rsq128;
};
static_assert(sizeof(Params) == 20 * 8 + 16 + 256 + 16 + 400 + 16, "Params has holes");

__device__ __forceinline__ unsigned pkbf(float lo, float hi) { unsigned r; asm("v_cvt_pk_bf16_f32 %0, %1, %2" : "=v"(r) : "v"(lo), "v"(hi)); return r; }
__device__ __forceinline__ float bflo(unsigned u) { return __uint_as_float(u << 16); }
__device__ __forceinline__ float bfhi(unsigned u) { return __uint_as_float(u & 0xffff0000u); }
__device__ __forceinline__ float bf1(bf16_t u) { return __uint_as_float(((unsigned)u) << 16); }
__device__ __forceinline__ bf16_t tobf1(float f) { return (bf16_t)(pkbf(f, 0.f) & 0xffffu); }
__device__ __forceinline__ float tobf1f(float f) { return __uint_as_float(pkbf(f, 0.f) << 16); }
__device__ __forceinline__ unsigned offb(unsigned row, unsigned ch) { return 256u * row + 16u * (ch ^ (((row & 3u) << 2) | ((row >> 2) & 3u))); }
__device__ __forceinline__ s16x4 trr(LAS unsigned char* p) { return __builtin_amdgcn_ds_read_tr16_b64_v4i16((LAS s16x4*)p); }
__device__ __forceinline__ bf16x8 cat4(s16x4 a, s16x4 b) { bf16x8 r; r[0] = a[0]; r[1] = a[1]; r[2] = a[2]; r[3] = a[3]; r[4] = b[0]; r[5] = b[1]; r[6] = b[2]; r[7] = b[3]; return r; }
__device__ __forceinline__ bf16x8 pack8(f32x4 a, f32x4 b) { u32x4 w; w.x = pkbf(a[0], a[1]); w.y = pkbf(a[2], a[3]); w.z = pkbf(b[0], b[1]); w.w = pkbf(b[2], b[3]); return __builtin_bit_cast(bf16x8, w); }
__device__ __forceinline__ f32x4 mfma16(bf16x8 a, bf16x8 b, f32x4 c) { return __builtin_amdgcn_mfma_f32_16x16x32_bf16(a, b, c, 0, 0, 0); }
__device__ __forceinline__ float shx(float v, int m) {
    const int x = __float_as_int(v); int r;
    switch (m) {
        case 1: r = __builtin_amdgcn_ds_swizzle(x, (1 << 10) | 0x1f); break;
        case 2: r = __builtin_amdgcn_ds_swizzle(x, (2 << 10) | 0x1f); break;
        case 4: r = __builtin_amdgcn_ds_swizzle(x, (4 << 10) | 0x1f); break;
        case 8: r = __builtin_amdgcn_ds_swizzle(x, (8 << 10) | 0x1f); break;
        case 16: r = __builtin_amdgcn_ds_swizzle(x, (16 << 10) | 0x1f); break;
        default: { const u32x2 p = __builtin_amdgcn_permlane32_swap((unsigned)x, (unsigned)x, false, false); r = (int)(xb_lane() < 32u ? p.y : p.x); } break;
    }
    return __int_as_float(r);
}
__device__ __forceinline__ float wsum64(float v) { v += shx(v, 32); v += shx(v, 16); v += shx(v, 8); v += shx(v, 4); v += shx(v, 2); v += shx(v, 1); return v; }
__device__ __forceinline__ float sigmoidf_(float x) { return 1.f / (1.f + __expf(-x)); }
__device__ __forceinline__ int med3i(int a, int b, int c) { int r; asm("v_med3_i32 %0, %1, %2, %3" : "=v"(r) : "v"(a), "v"(b), "v"(c)); return r; }
__device__ __forceinline__ int sortable(float x) { const int b = __float_as_int(x); return b ^ ((b >> 31) & 0x7fffffff); }
__device__ __forceinline__ float unsortable(int s) { return __int_as_float(s ^ ((s >> 31) & 0x7fffffff)); }
__device__ __forceinline__ void ins16(int (&sv)[16], int x) {
#pragma unroll
    for (int i = 15; i >= 1; --i) sv[i] = med3i(sv[i - 1], sv[i], x);
    sv[0] = sv[0] > x ? sv[0] : x;
}
__device__ __forceinline__ float dot2bf(unsigned a, unsigned b, float c) { return __builtin_amdgcn_fdot2_f32_bf16(__builtin_bit_cast(bf2_t, a), __builtin_bit_cast(bf2_t, b), c, false); }

template <class Q> struct EpiQuad {
    static constexpr bool PERM = false, AFTER_DRAIN = false;
    Q q;
    __device__ __forceinline__ void operator()(const f32x4 (&acc)[2][2][4][2], const pg8::Unit& u, int wr, int wc, int fr, int fq) const {
        const int row0 = u.pm * 256 + wr * 64 + fr, col0 = u.pn * 256 + wc * 32 + 4 * fq;
#pragma unroll
        for (int ai = 0; ai < 2; ++ai)
#pragma unroll
            for (int m = 0; m < 4; ++m)
#pragma unroll
                for (int bj = 0; bj < 2; ++bj)
#pragma unroll
                    for (int n = 0; n < 2; ++n) { q.quad(row0 + ai * 128 + m * 16, col0 + bj * 128 + n * 16, acc[ai][bj][m][n]); if (Q::FENCE) asm volatile("" ::: "memory"); }
    }
};
template <class Q, int MB  > struct EpiQuadB {
    static constexpr bool PERM = false, AFTER_DRAIN = false;
    Q q;
    __device__ __forceinline__ void operator()(const f32x4 (&acc)[2][2][4][2], const pg8::Unit& u, int wr, int wc, int fr, int fq) const {
        const int row0 = u.pm * 256 + wr * 64 + fr, col0 = u.pn * 256 + wc * 32 + 4 * fq;
#pragma unroll
        for (int ai = 0; ai < 2; ++ai)
#pragma unroll
            for (int mp = 0; mp < 4 / MB; ++mp) { typename Q::L ld[MB][2][2];
#pragma unroll
                for (int mm = 0; mm < MB; ++mm)
#pragma unroll
                    for (int bj = 0; bj < 2; ++bj)
#pragma unroll
                        for (int n = 0; n < 2; ++n) ld[mm][bj][n] = q.load(row0 + ai * 128 + (MB * mp + mm) * 16, col0 + bj * 128 + n * 16);
                __builtin_amdgcn_sched_barrier(0);
#pragma unroll
                for (int mm = 0; mm < MB; ++mm)
#pragma unroll
                    for (int bj = 0; bj < 2; ++bj)
#pragma unroll
                        for (int n = 0; n < 2; ++n) q.fin(row0 + ai * 128 + (MB * mp + mm) * 16, col0 + bj * 128 + n * 16, acc[ai][bj][MB * mp + mm][n], ld[mm][bj][n]);
                asm volatile("" ::: "memory"); }
    }
};
struct QZ { static constexpr bool FENCE = false; bf16_t* Z; const float* bg;
    __device__ __forceinline__ void quad(int row, int col, f32x4 v) const {
        if (col >= C_GA) { const f32x4 b = *(const f32x4*)(bg + (col - C_GA)); v[0] = sigmoidf_(v[0] + b[0]); v[1] = sigmoidf_(v[1] + b[1]); v[2] = sigmoidf_(v[2] + b[2]); v[3] = sigmoidf_(v[3] + b[3]); }
        u32x2 w; w.x = pkbf(v[0], v[1]); w.y = pkbf(v[2], v[3]); *(u32x2*)(Z + (size_t)row * INC + col) = w; } };
struct EpiZ {
    static constexpr bool PERM = true, AFTER_DRAIN = false;
    bf16_t* Z; const float* bg;
    __device__ __forceinline__ void operator()(const f32x4 (&acc)[2][2][4][2], const pg8::Unit& u, int wr, int wc, int fr, int fq) const {
        const int pn = u.pn; const bool gate = pn >= 30;
        size_t base; int rs, bjs, dsh = 0;
        if (pn < 18) { const int which = pn / 6, g = (pn % 6) >> 1; dsh = 2 * g; base = ZO_A + (size_t)(((which * 3 + g) * 4 + 2 * (pn & 1)) * 2) * 8192 * 128; rs = 128; bjs = 2 * 8192 * 128; }
        else if (pn < 22) { base = (pn < 20 ? ZO_RQ : ZO_RK) + (size_t)(2 * (pn & 1)) * NP * 128; rs = 128; bjs = NP * 128; }
        else if (pn < 30) { base = (pn < 26 ? ZO_RV + (size_t)(pn - 22) * NP * 256 : ZO_GR + (size_t)(pn - 26) * NP * 256); rs = 256; bjs = 128; }
        else { base = (pn < 34 ? ZO_GA + (size_t)(pn - 30) * 256 : ZO_GB + (size_t)(pn - 34) * 256); rs = 1024; bjs = 128; }
        const int row0 = u.pm * 256 + wr * 64 + fr, dim = wc * 32 + 8 * fq, col0 = pn * 256 + dim;
#pragma unroll
        for (int bj = 0; bj < 2; ++bj) {
            f32x4 b0 = {0.f, 0.f, 0.f, 0.f}, b1 = {0.f, 0.f, 0.f, 0.f};
            if (gate) { b0 = *(const f32x4*)(bg + (col0 + bj * 128 - C_GA)); b1 = *(const f32x4*)(bg + (col0 + bj * 128 - C_GA) + 4); }
#pragma unroll
            for (int ai = 0; ai < 2; ++ai)
#pragma unroll
                for (int m = 0; m < 4; ++m) { f32x4 v0 = acc[ai][bj][m][0], v1 = acc[ai][bj][m][1];
                    if (gate) { v0[0] = sigmoidf_(v0[0] + b0[0]); v0[1] = sigmoidf_(v0[1] + b0[1]); v0[2] = sigmoidf_(v0[2] + b0[2]); v0[3] = sigmoidf_(v0[3] + b0[3]);
                                v1[0] = sigmoidf_(v1[0] + b1[0]); v1[1] = sigmoidf_(v1[1] + b1[1]); v1[2] = sigmoidf_(v1[2] + b1[2]); v1[3] = sigmoidf_(v1[3] + b1[3]); }
                    u32x4 w; w.x = pkbf(v0[0], v0[1]); w.y = pkbf(v0[2], v0[3]); w.z = pkbf(v1[0], v1[1]); w.w = pkbf(v1[2], v1[3]);
                    const int row = row0 + ai * 128 + m * 16, t = row & 8191, rt = (row & ~8191) + ((t & ((1 << dsh) - 1)) << (13 - dsh)) + (t >> dsh);
                    *(u32x4*)(Z + base + (size_t)rt * rs + bj * bjs + dim) = w; } }
    }
};
struct QGateA { static constexpr bool FENCE = true; const bf16_t* Z; float* M1;
    typedef u32x2 L;
    __device__ __forceinline__ L load(int row, int col) const { return *(const u32x2*)(row < NP ? Z + ZO_GA + (size_t)row * 1024 + col : Z + (size_t)row * INC + C_GA + col); }
    __device__ __forceinline__ void fin(int row, int col, f32x4 v, L g) const { u32x2 o; o.x = pkbf(bflo(g.x) * v[0], bfhi(g.x) * v[1]); o.y = pkbf(bflo(g.y) * v[2], bfhi(g.y) * v[3]); *(u32x2*)((bf16_t*)M1 + (size_t)row * DM + col) = o; }
    __device__ __forceinline__ void quad(int row, int col, f32x4 v) const { fin(row, col, v, load(row, col)); } };
struct QGateB { static constexpr bool FENCE = true; const bf16_t* Z; const float* M1; bf16_t* MX;
    struct L { u32x2 g; u32x2 m; };
    __device__ __forceinline__ L load(int row, int col) const { L l; l.g = *(const u32x2*)(row < NP ? Z + ZO_GB + (size_t)row * 1024 + col : Z + (size_t)row * INC + C_GB + col); l.m = *(const u32x2*)((const bf16_t*)M1 + (size_t)row * DM + col); return l; }
    __device__ __forceinline__ void fin(int row, int col, f32x4 v, L l) const { u32x2 w; w.x = pkbf(bflo(l.m.x) + bflo(l.g.x) * v[0], bfhi(l.m.x) + bfhi(l.g.x) * v[1]); w.y = pkbf(bflo(l.m.y) + bflo(l.g.y) * v[2], bfhi(l.m.y) + bfhi(l.g.y) * v[3]); *(u32x2*)(MX + (size_t)row * DM + col) = w; }
    __device__ __forceinline__ void quad(int row, int col, f32x4 v) const { fin(row, col, v, load(row, col)); } };
struct QRes { static constexpr bool FENCE = true; const float* Xp; const float* Xs; float* X;
    typedef f32x4 L;
    __device__ __forceinline__ L load(int row, int col) const { return *(const f32x4*)(row < NP ? Xp + (size_t)row * DM + col : Xs + (size_t)(row - NP) * DM + col); }
    __device__ __forceinline__ void fin(int row, int col, f32x4 v, L x) const { *(f32x4*)(X + (size_t)row * DM + col) = x + v; }
    __device__ __forceinline__ void quad(int row, int col, f32x4 v) const { fin(row, col, v, load(row, col)); } };
struct QKey { static constexpr bool FENCE = false; int* SC;
    __device__ __forceinline__ void quad(int row, int col, f32x4 v) const {
        i32x4 k; const int kb = 127 - (col & 127);
        k[0] = (sortable(v[0]) & ~127) | kb; k[1] = (sortable(v[1]) & ~127) | (kb - 1); k[2] = (sortable(v[2]) & ~127) | (kb - 2); k[3] = (sortable(v[3]) & ~127) | (kb - 3);
        *(i32x4*)(SC + ((size_t)(row >> 4) * 512 + (col >> 2)) * 64 + (row & 15) * 4) = k; } };

template <class Q> __device__ __forceinline__ void skinny(const bf16_t* Hs, const bf16_t* Bt, int N, int K, const Q& q, int gw, int nw, int lane_) {
    int lane = lane_; asm volatile("" : "+v"(lane));
    const int fr = lane & 15, fq = lane >> 4;
    for (int t = gw; t < (N >> 3); t += nw) { const int ct = t >> 1, rh = t & 1;
        f32x4 a0 = {0.f, 0.f, 0.f, 0.f};
        const bf16_t* bp = Bt + (size_t)(ct * 16 + fr) * K + fq * 8; const bf16_t* h0 = Hs + (size_t)(rh * 16 + fr) * K + fq * 8;
        bf16x8 wa[8], xa[8], wb[8], xb[8];
#pragma unroll
        for (int j = 0; j < 8; ++j) { wa[j] = *(const bf16x8*)(bp + 32 * j); xa[j] = *(const bf16x8*)(h0 + 32 * j); }
#pragma unroll
        for (int c = 0; c < K / 256; ++c) {
            if (c + 1 < K / 256) {
#pragma unroll
                for (int j = 0; j < 8; ++j) { const bf16x8 tw = *(const bf16x8*)(bp + 256 * (c + 1) + 32 * j), tx = *(const bf16x8*)(h0 + 256 * (c + 1) + 32 * j); if (c & 1) { wa[j] = tw; xa[j] = tx; } else { wb[j] = tw; xb[j] = tx; } } }
            __builtin_amdgcn_sched_barrier(0);
#pragma unroll
            for (int j = 0; j < 8; ++j) a0 = (c & 1) ? mfma16(wb[j], xb[j], a0) : mfma16(wa[j], xa[j], a0);
            __builtin_amdgcn_sched_barrier(0);
        }
        q.quad(NP + rh * 16 + fr, ct * 16 + 4 * fq, a0);
    }
}
template <class Q> __device__ __forceinline__ void skinny8(const bf16_t* Hs, const bf16_t* Bt, int N, int K, const Q& q, int ublk, int nblk, int w, int lane_, LAS unsigned char* lds) {
    int lane = lane_; asm volatile("" : "+v"(lane));
    const int fr = lane & 15, fq = lane >> 4; LAS f32x4* part = (LAS f32x4*)lds;
    for (int t = ublk; t < (N >> 3); t += nblk) { const int ct = t >> 1, rh = t & 1, ks = K >> 3;
        const bf16_t* bp = Bt + (size_t)(ct * 16 + fr) * K + w * ks + fq * 8; const bf16_t* h0 = Hs + (size_t)(rh * 16 + fr) * K + w * ks + fq * 8;
        bf16x8 wv[4], xv[4];
#pragma unroll
        for (int j = 0; j < 4; ++j) if (j < K / 256) { wv[j] = *(const bf16x8*)(bp + 32 * j); xv[j] = *(const bf16x8*)(h0 + 32 * j); }
        __builtin_amdgcn_sched_barrier(0);
        f32x4 a0 = {0.f, 0.f, 0.f, 0.f};
#pragma unroll
        for (int j = 0; j < 4; ++j) if (j < K / 256) a0 = mfma16(wv[j], xv[j], a0);
        __syncthreads();
        part[w * 64 + lane] = a0;
        __syncthreads();
        if (w == 0) { f32x4 a = part[lane];
#pragma unroll
            for (int ww = 1; ww < 8; ++ww) a += part[ww * 64 + lane];
            q.quad(NP + rh * 16 + fr, ct * 16 + 4 * fq, a); }
        __syncthreads();
    }
}

__device__ __forceinline__ void tconv_tile(const float* src, int K, int N, bf16_t* dst, int tile, LAS float* T, int tid) {
    const int ntn = N >> 6, tk = tile / ntn, tn = tile - tk * ntn, k0 = tk * 64, n0 = tn * 64;
#pragma unroll
    for (int i = 0; i < 2; ++i) { const int idx = tid + 512 * i, kr = idx >> 4, c4 = idx & 15; const float4 v = *(const float4*)(src + (size_t)(k0 + kr) * N + n0 + c4 * 4);
        LAS float* t = T + kr * 65 + c4 * 4; t[0] = v.x; t[1] = v.y; t[2] = v.z; t[3] = v.w; }
    __syncthreads();
    { const int n = tid >> 3, kq = tid & 7; float f[8];
#pragma unroll
      for (int i = 0; i < 8; ++i) f[i] = T[(kq * 8 + i) * 65 + n];
      u32x4 w; w.x = pkbf(f[0], f[1]); w.y = pkbf(f[2], f[3]); w.z = pkbf(f[4], f[5]); w.w = pkbf(f[6], f[7]);
      *(u32x4*)(dst + (size_t)(n0 + n) * K + k0 + kq * 8) = w; }
    __syncthreads();
}
__device__ __forceinline__ void wts_unit(const float* pwq, const float* sk, bf16_t* WtS, int hp, int dt, LAS float* skc, LAS float* pwc, int tid) {
    const int p = hp & 1, d0 = dt * 64;
#pragma unroll
    for (int i = 0; i < 8; ++i) { const int idx = tid + 512 * i, k = idx >> 5, c4 = idx & 31; const float4 v = *(const float4*)(sk + (size_t)(p * 128 + k) * 128 + c4 * 4);
        skc[(c4 * 4 + 0) * 132 + k] = v.x; skc[(c4 * 4 + 1) * 132 + k] = v.y; skc[(c4 * 4 + 2) * 132 + k] = v.z; skc[(c4 * 4 + 3) * 132 + k] = v.w; }
#pragma unroll
    for (int i = 0; i < 4; ++i) { const int idx = tid + 512 * i, d = idx >> 5, c4 = idx & 31; const float4 v = *(const float4*)(pwq + (size_t)(d0 + d) * 2048 + hp * 128 + c4 * 4);
        pwc[(c4 * 4 + 0) * 68 + d] = v.x; pwc[(c4 * 4 + 1) * 68 + d] = v.y; pwc[(c4 * 4 + 2) * 68 + d] = v.z; pwc[(c4 * 4 + 3) * 68 + d] = v.w; }
    __syncthreads();
    const int tk = tid & 31, td = tid >> 5;
    float acc[4][4];
#pragma unroll
    for (int i = 0; i < 4; ++i)
#pragma unroll
        for (int j = 0; j < 4; ++j) acc[i][j] = 0.f;
#pragma unroll 4
    for (int c = 0; c < 128; ++c) { const f32x4 a = *(const LAS f32x4*)(skc + c * 132 + tk * 4); const f32x4 b = *(const LAS f32x4*)(pwc + c * 68 + td * 4);
#pragma unroll
        for (int i = 0; i < 4; ++i)
#pragma unroll
            for (int j = 0; j < 4; ++j) acc[i][j] += a[i] * b[j]; }
#pragma unroll
    for (int i = 0; i < 4; ++i) { u32x2 w; w.x = pkbf(acc[i][0], acc[i][1]); w.y = pkbf(acc[i][2], acc[i][3]); *(u32x2*)(WtS + (size_t)(hp * 128 + tk * 4 + i) * DM + d0 + td * 4) = w; }
    __syncthreads();
}
#ifndef MK_FP6_IL
#define MK_FP6_IL 1
#endif
__device__ __forceinline__ void conv_tables(const Params& P, int layer, int gw, int nw, int lane) {
    unsigned char* ws = P.ws; const int hl = lane & 31, up = lane >> 5; float* tsc = (float*)(ws + WS_TSC);
    for (int r0 = gw * 4; r0 < 2 * 16384; r0 += nw * 4) {
        float4 v[2][8];
#pragma unroll
        for (int k = 0; k < 2; ++k) { const int q = r0 + 2 * k + up, tb = q >> 14, rr = layer * 16384 + (q & 16383); const float* src = P.in[18 + tb] + (size_t)rr * DM + hl * 32;
#pragma unroll
            for (int j = 0; j < 8; ++j) v[k][j] = *(const float4*)(src + 4 * j); }
#pragma unroll
        for (int k = 0; k < 2; ++k) { const int q = r0 + 2 * k + up, tb = q >> 14, rr = layer * 16384 + (q & 16383), r = tb * 32768 + rr; float m = 0.f;
#pragma unroll
            for (int j = 0; j < 8; ++j) m = fmaxf(m, fmaxf(fmaxf(fabsf(v[k][j].x), fabsf(v[k][j].y)), fmaxf(fabsf(v[k][j].z), fabsf(v[k][j].w))));
#pragma unroll
            for (int o = 1; o < 32; o <<= 1) m = fmaxf(m, shx(m, o));
            float s = 1.f; if (m > 1e-30f) s = __uint_as_float(__float_as_uint(7.5f / m) & 0x7f800000u);
            float e[32];
#pragma unroll
            for (int j = 0; j < 8; ++j) { e[4 * j] = v[k][j].x * s; e[4 * j + 1] = v[k][j].y * s; e[4 * j + 2] = v[k][j].z * s; e[4 * j + 3] = v[k][j].w * s; }
            f32x16 xa, xb;
#pragma unroll
            for (int i = 0; i < 16; ++i) { xa[i] = MK_FP6_IL ? e[2 * i] : e[i]; xb[i] = MK_FP6_IL ? e[2 * i + 1] : e[16 + i]; }
            u32x6 p = __builtin_amdgcn_cvt_scalef32_2xpk16_fp6_f32(xa, xb, 1.0f);
            unsigned char* dst = ws + (tb ? WS_VBF : WS_UBF) + (size_t)rr * 768;
            *(u32x4*)(dst + hl * 16) = (u32x4){p[0], p[1], p[2], p[3]}; *(u32x2*)(dst + 512 + hl * 8) = (u32x2){p[4], p[5]};
            if (hl == 0) tsc[r] = 1.f / s; } }
}
__device__ __forceinline__ void p0_prologue(const Params& P, LAS unsigned char* lds, int tid, int bid, int G) {
    unsigned char* ws = P.ws;
    for (int u = bid; u < NLAYER * 3072; u += G) {
        const int l = u / 3072, t = u - l * 3072;
        if (t < 2432) tconv_tile(P.in[8] + (size_t)l * DM * INC, DM, INC, (bf16_t*)(ws + WS_WTIN + l * SZ_WTIN), t, (LAS float*)lds, tid);
        else if (t < 2560) tconv_tile(P.in[12] + (size_t)l * 512 * DM, 512, DM, (bf16_t*)(ws + WS_WTOA + l * SZ_WTOA), t - 2432, (LAS float*)lds, tid);
        else if (t < 2816) tconv_tile(P.in[13] + (size_t)l * DM * DM, DM, DM, (bf16_t*)(ws + WS_WTOR + l * SZ_WSQ), t - 2560, (LAS float*)lds, tid);
        else tconv_tile(P.in[14] + (size_t)l * DM * DM, DM, DM, (bf16_t*)(ws + WS_WTOUT + l * SZ_WSQ), t - 2816, (LAS float*)lds, tid);
    }
    for (int u = bid; u < NLAYER * 256; u += G) {
        const int l = u >> 8, r = u & 255, hp = r >> 4, dt = r & 15;
        wts_unit(P.in[16] + (size_t)l * DM * 2048, P.in[17] + (size_t)l * 2 * 128 * 128, (bf16_t*)(ws + WS_WTS + l * SZ_WTS), hp, dt, (LAS float*)lds, (LAS float*)(lds + 128 * 132 * 4), tid);
    }
    if (bid == 0) { float* bt = (float*)(ws + WS_BT); for (int idx = tid; idx < 12 * 132; idx += 512) { const int gj = idx / 132, m = idx - gj * 132, g = gj >> 2, j = gj & 3;
        bt[idx] = m <= 128 ? P.in[6][(int)P.bucket[g][m] * 12 + g * 4 + j] : 0.f; } }
    { float2* cs = (float2*)(ws + WS_CS);
      for (int idx = bid * 512 + tid; idx < 8193 * 64; idx += G * 512) { const int pi = idx >> 6, i = idx & 63; const float pos = pi == 8192 ? 16384.f : (float)pi;
        const float th = pos * P.ang[i]; const double td = (double)th; const double kq = rint(td * 0.15915494309189535); const float rf = (float)(td - kq * 6.283185307179586);
        cs[idx] = make_float2(cosf(rf), sinf(rf)); } }
    { const int lane = tid & 63, gw = bid * 8 + (tid >> 6), nw = G * 8; bf16_t* H = (bf16_t*)(ws + WS_H); const float* nw1 = P.in[7];
      float4 wv[4];
#pragma unroll
      for (int j = 0; j < 4; ++j) wv[j] = *(const float4*)(nw1 + j * 256 + lane * 4);
      for (int row0 = gw * 2; row0 < NR; row0 += nw * 2) {
        float4 v[2][4];
#pragma unroll
        for (int k = 0; k < 2; ++k) { const int row = row0 + k; const float* x = row < NP ? P.in[0] + (size_t)row * DM : P.in[1] + (size_t)(row - NP) * DM;
#pragma unroll
            for (int j = 0; j < 4; ++j) v[k][j] = *(const float4*)(x + j * 256 + lane * 4); }
        __builtin_amdgcn_sched_barrier(0);
#pragma unroll
        for (int k = 0; k < 2; ++k) { const int row = row0 + k; float ss = 0.f;
#pragma unroll
            for (int j = 0; j < 4; ++j) ss += v[k][j].x * v[k][j].x + v[k][j].y * v[k][j].y + v[k][j].z * v[k][j].z + v[k][j].w * v[k][j].w;
            const float rstd = rsqrtf(wsum64(ss) * (1.f / 1024.f) + EPS);
#pragma unroll
            for (int j = 0; j < 4; ++j) { const float4 w = wv[j];
                u32x2 o; o.x = pkbf(v[k][j].x * rstd * w.x, v[k][j].y * rstd * w.y); o.y = pkbf(v[k][j].z * rstd * w.z, v[k][j].w * rstd * w.w); *(u32x2*)(H + (size_t)row * DM + j * 256 + lane * 4) = o; } } } }
}

struct AttnRaw { u32x4 kr[8], vr[8]; bf16x8 q[4]; float4 kw0, kw1; float bias, qw; };
struct AttnIdx { int g, j, b, d, r, blk, i0; size_t rowbase; };
__device__ __forceinline__ AttnIdx attn_decode(int u) { AttnIdx a; a.g = u >> 9; const int rem = u & 511; a.j = rem & 3; const int sb = rem >> 2; a.b = sb >> 6; const int x = sb & 63, dsh = 2 * a.g;
    a.d = 1 << dsh; a.r = x >> (6 - dsh); a.blk = x & ((64 >> dsh) - 1); a.rowbase = (size_t)a.b * 8192 + a.r; a.i0 = a.blk * 128; return a; }
__device__ __forceinline__ void attn_load(const __amdgpu_buffer_rsrc_t Zr, const float* qn, const float* kn, const float* BT, const AttnIdx& a, AttnRaw& R, int tid, int w, int fr, int fq) {
    const int dsh = 2 * a.g, sub0 = (a.r << (13 - dsh)) + a.i0;
    const int hk = ((((1 * 3 + a.g) * 4 + a.j) * 2 + a.b) * 8192) * 128, hv = ((((2 * 3 + a.g) * 4 + a.j) * 2 + a.b) * 8192) * 128, hq = ((((0 * 3 + a.g) * 4 + a.j) * 2 + a.b) * 8192) * 128;
#pragma unroll
    for (int c = 0; c < 8; ++c) { const int id = tid + 512 * c, kk = id >> 4, ch = id & 15; int i = a.i0 - 128 + kk; i = i < 0 ? 0 : i;
        const int ro = (((a.r << (13 - dsh)) + i) * 128 + ch * 8); R.kr[c] = __builtin_amdgcn_raw_buffer_load_b128(Zr, (hk + ro) * 2, 0, 0); R.vr[c] = __builtin_amdgcn_raw_buffer_load_b128(Zr, (hv + ro) * 2, 0, 0); }
    { const float* kwp = kn + a.g * 128 + (tid & 15) * 8; R.kw0 = *(const float4*)kwp; R.kw1 = *(const float4*)(kwp + 4); R.bias = BT[(a.g * 4 + a.j) * 132 + (tid < 132 ? tid : 0)]; R.qw = qn[a.g * 128 + (tid & 127)]; }
    const int qoff = (hq + (sub0 + 16 * w + fr) * 128 + fq * 8) * 2;
#pragma unroll
    for (int s = 0; s < 4; ++s) R.q[s] = __builtin_bit_cast(bf16x8, __builtin_amdgcn_raw_buffer_load_b128(Zr, qoff + 64 * s, 0, 0));
}
__device__ __forceinline__ void attn_phase(const Params& P, int l, const bf16_t* Z, bf16_t* OG, float* LSE, LAS unsigned char* lds, int tid_in, int bid, int G) {
    const int w = __builtin_amdgcn_readfirstlane(tid_in >> 6);
    LAS unsigned char* Ks = lds; LAS unsigned char* Vs = lds + 65536; LAS float* biasv = (LAS float*)(lds + 131072);
    const __amdgpu_buffer_rsrc_t Zr = __builtin_amdgcn_make_buffer_rsrc((void*)Z, 0, (int)((size_t)NR * INC * 2), 0x00020000);
    AttnRaw R; int u = bid;
    const float* qn = P.in[10] + l * 384; const float* kn = P.in[11] + l * 384; const float* BT = (const float*)(P.ws + WS_BT); LAS float* qwl = (LAS float*)(lds + 131072 + 1024);
    if (u < 1536) { const int l0 = tid_in & 63; attn_load(Zr, qn, kn, BT, attn_decode(u), R, tid_in, w, l0 & 15, l0 >> 4); }
    for (; u < 1536; u += G) {
        int lane; asm volatile("v_mbcnt_lo_u32_b32 %0, -1, 0\n\tv_mbcnt_hi_u32_b32 %0, -1, %0" : "=v"(lane));
        const int tid = w * 64 + lane, fr = lane & 15, fq = lane >> 4, q4 = fr >> 2, p4 = fr & 3;
        const AttnIdx a = attn_decode(u); const int g = a.g, j = a.j, blk = a.blk;
        { const int ch = tid & 15; const float4 kw0 = R.kw0, kw1 = R.kw1;
          const int keep = 128 << (2 * g); float* kvb = P.out + (g == 0 ? O_KV1P : (g == 1 ? O_KV4P : O_KV16P)) + (size_t)(l * 2 + a.b) * keep * 1024 + j * 128 + ch * 8;
#pragma unroll
          for (int c = 0; c < 8; ++c) { const int id = tid + 512 * c, kk = id >> 4; const u32x4 raw = R.kr[c];
            float f[8] = {bflo(raw.x), bfhi(raw.x), bflo(raw.y), bfhi(raw.y), bflo(raw.z), bfhi(raw.z), bflo(raw.w), bfhi(raw.w)};
            float ss = 0.f;
#pragma unroll
            for (int i = 0; i < 8; ++i) ss += f[i] * f[i];
            ss += shx(ss, 1); ss += shx(ss, 2); ss += shx(ss, 4); ss += shx(ss, 8);
            const float rstd = rsqrtf(ss * (1.f / 128.f) + EPS);
            f[0] *= rstd * kw0.x; f[1] *= rstd * kw0.y; f[2] *= rstd * kw0.z; f[3] *= rstd * kw0.w; f[4] *= rstd * kw1.x; f[5] *= rstd * kw1.y; f[6] *= rstd * kw1.z; f[7] *= rstd * kw1.w;
            u32x4 o; o.x = pkbf(f[0], f[1]); o.y = pkbf(f[2], f[3]); o.z = pkbf(f[4], f[5]); o.w = pkbf(f[6], f[7]);
            *(LAS u32x4*)(Ks + offb(kk, ch)) = o; *(LAS u32x4*)(Vs + offb(kk, ch)) = R.vr[c];
            if (c >= 4) { const int tt = a.r + a.d * (a.i0 - 128 + kk) - (8192 - keep);
                if (tt >= 0) { float* d = kvb + (size_t)tt * 1024; const u32x4 vr = R.vr[c];
                    *(float4*)d = make_float4(f[0], f[1], f[2], f[3]); *(float4*)(d + 4) = make_float4(f[4], f[5], f[6], f[7]);
                    *(float4*)(d + 512) = make_float4(bflo(vr.x), bfhi(vr.x), bflo(vr.y), bfhi(vr.y)); *(float4*)(d + 516) = make_float4(bflo(vr.z), bfhi(vr.z), bflo(vr.w), bfhi(vr.w)); } }
            __builtin_amdgcn_sched_barrier(0); } }
        if (tid < 132) biasv[tid] = R.bias;
        if (tid < 128) qwl[tid] = R.qw;
        const size_t qrow = a.rowbase + (size_t)a.d * (a.i0 + 16 * w + fr);
        __syncthreads();
        bf16x8 Qf[4];
        { float ss = 0.f; float qf[4][8];
#pragma unroll
          for (int s = 0; s < 4; ++s) { const u32x4 r4 = __builtin_bit_cast(u32x4, R.q[s]); qf[s][0] = bflo(r4.x); qf[s][1] = bfhi(r4.x); qf[s][2] = bflo(r4.y); qf[s][3] = bfhi(r4.y); qf[s][4] = bflo(r4.z); qf[s][5] = bfhi(r4.z); qf[s][6] = bflo(r4.w); qf[s][7] = bfhi(r4.w);
#pragma unroll
              for (int i = 0; i < 8; ++i) ss += qf[s][i] * qf[s][i]; }
          ss += shx(ss, 16); ss += shx(ss, 32);
          const float rstd = rsqrtf(ss * (1.f / 128.f) + EPS) * P.rsq128; const LAS float* qwp = qwl + fq * 8;
#pragma unroll
          for (int s = 0; s < 4; ++s) { const f32x4 w0 = *(const LAS f32x4*)(qwp + 32 * s), w1 = *(const LAS f32x4*)(qwp + 32 * s + 4); u32x4 o;
              o.x = pkbf(qf[s][0] * rstd * w0[0], qf[s][1] * rstd * w0[1]); o.y = pkbf(qf[s][2] * rstd * w0[2], qf[s][3] * rstd * w0[3]); o.z = pkbf(qf[s][4] * rstd * w1[0], qf[s][5] * rstd * w1[1]); o.w = pkbf(qf[s][6] * rstd * w1[2], qf[s][7] * rstd * w1[3]);
              Qf[s] = __builtin_bit_cast(bf16x8, o); } }
        { int un = u + G; asm volatile("" : "+s"(un));
          if (un < 1536) attn_load(Zr, qn, kn, BT, attn_decode(un), R, tid, w, fr, fq); }
        f32x4 sa[9];
#pragma unroll
        for (int ti = 0; ti < 9; ++ti) { sa[ti] = (f32x4){0.f, 0.f, 0.f, 0.f}; const int kt = w + ti;
#pragma unroll
            for (int s = 0; s < 4; ++s) { const bf16x8 kf = *(const LAS bf16x8*)(Ks + offb(16 * kt + fr, 4 * s + fq)); sa[ti] = mfma16(kf, Qf[s], sa[ti]); }
            if (ti & 1) __builtin_amdgcn_sched_barrier(0); }
        float mx = -3.0e38f;
#pragma unroll
        for (int ti = 0; ti < 9; ++ti)
#pragma unroll
            for (int e = 0; e < 4; ++e) { const int kk = 16 * (w + ti) + 4 * fq + e, m = 128 + fr - 16 * ti - 4 * fq - e; const bool ok = (m >= 0) && (m <= 128) && (blk > 0 || kk >= 128);
                const int mc = m < 0 ? 0 : (m > 128 ? 128 : m); const float bv = biasv[mc]; float sv = sa[ti][e] + bv; sv = ok ? sv : -1.0e30f; sa[ti][e] = sv; mx = fmaxf(mx, sv); }
        mx = fmaxf(mx, shx(mx, 16)); mx = fmaxf(mx, shx(mx, 32));
        float sum = 0.f;
#pragma unroll
        for (int ti = 0; ti < 9; ++ti)
#pragma unroll
            for (int e = 0; e < 4; ++e) { const float pe = __expf(sa[ti][e] - mx); sa[ti][e] = pe; sum += pe; }
        sum += shx(sum, 16); sum += shx(sum, 32);
        f32x4 oa[8];
#pragma unroll
        for (int c = 0; c < 8; ++c) oa[c] = (f32x4){0.f, 0.f, 0.f, 0.f};
#pragma unroll
        for (int ks = 0; ks < 5; ++ks) { const int T0 = 2 * ks, T1 = 2 * ks + 1;
            const f32x4 z4 = {0.f, 0.f, 0.f, 0.f}; const bf16x8 Pb = pack8(sa[T0], T1 < 9 ? sa[T1] : z4);
            const int rb0 = 16 * (w + T0) + 4 * fq; int rb1 = 16 * (w + T1) + 4 * fq; rb1 = rb1 > 252 ? 252 : rb1;
#pragma unroll
            for (int c = 0; c < 8; ++c) { const s16x4 a0 = trr(Vs + offb(rb0 + q4, 2 * c + (p4 >> 1)) + 8 * (p4 & 1)); const s16x4 a1 = trr(Vs + offb(rb1 + q4, 2 * c + (p4 >> 1)) + 8 * (p4 & 1));
                oa[c] = mfma16(cat4(a0, a1), Pb, oa[c]); }
            __builtin_amdgcn_sched_barrier(0); }
        const float inv = 1.f / sum; bf16_t* orow = OG + ((size_t)g * NR + qrow) * 512 + j * 128;
#pragma unroll
        for (int c = 0; c < 8; ++c) { u32x2 o; o.x = pkbf(oa[c][0] * inv, oa[c][1] * inv); o.y = pkbf(oa[c][2] * inv, oa[c][3] * inv); *(u32x2*)(orow + 16 * c + 4 * fq) = o; }
        if (fq == 0) LSE[((size_t)g * NR + qrow) * 4 + j] = mx + __logf(sum);
        __syncthreads();
    }
}

__device__ __forceinline__ void sattn_unit(const Params& P, int l, const bf16_t* Z, bf16_t* OG, float* LSE, int u, LAS unsigned char* lds, int tid) {
    const int lane = tid & 63, w = __builtin_amdgcn_readfirstlane(tid >> 6);
    const int b = u / 3, g = u - b * 3, d = 1 << (2 * g), lg = 128 * d;
    const float* cache = P.in[2 + g] + ((size_t)(l * 32 + b) * lg) * 1024;
    const bf16_t* zr = Z + (size_t)(NP + b) * INC;
    LAS float* sc = (LAS float*)lds;
    LAS float* st = (LAS float*)(lds + 2112);
    LAS float* part = (LAS float*)(lds + 4096);
    float q[8];
    { const u32x2 a = *(const u32x2*)(zr + C_QA + g * 512 + lane * 4), c = *(const u32x2*)(zr + C_QA + g * 512 + 256 + lane * 4);
      q[0] = bflo(a.x); q[1] = bfhi(a.x); q[2] = bflo(a.y); q[3] = bfhi(a.y); q[4] = bflo(c.x); q[5] = bfhi(c.x); q[6] = bflo(c.y); q[7] = bfhi(c.y);
      float s1 = q[0] * q[0] + q[1] * q[1] + q[2] * q[2] + q[3] * q[3], s2 = q[4] * q[4] + q[5] * q[5] + q[6] * q[6] + q[7] * q[7];
#pragma unroll
      for (int o = 1; o < 32; o <<= 1) { s1 += shx(s1, o); s2 += shx(s2, o); }
      const float r1 = rsqrtf(s1 * (1.f / 128.f) + EPS) * P.rsq128, r2 = rsqrtf(s2 * (1.f / 128.f) + EPS) * P.rsq128;
      const float4 wq = *(const float4*)(P.in[10] + (l * 3 + g) * 128 + (lane & 31) * 4);
      q[0] = tobf1f(q[0] * r1 * wq.x); q[1] = tobf1f(q[1] * r1 * wq.y); q[2] = tobf1f(q[2] * r1 * wq.z); q[3] = tobf1f(q[3] * r1 * wq.w);
      q[4] = tobf1f(q[4] * r2 * wq.x); q[5] = tobf1f(q[5] * r2 * wq.y); q[6] = tobf1f(q[6] * r2 * wq.z); q[7] = tobf1f(q[7] * r2 * wq.w); }
    if (w == 0) {
        float k[8];
        { const u32x2 a = *(const u32x2*)(zr + C_KA + g * 512 + lane * 4), c = *(const u32x2*)(zr + C_KA + g * 512 + 256 + lane * 4);
            k[0] = bflo(a.x); k[1] = bfhi(a.x); k[2] = bflo(a.y); k[3] = bfhi(a.y); k[4] = bflo(c.x); k[5] = bfhi(c.x); k[6] = bflo(c.y); k[7] = bfhi(c.y);
            float t1 = k[0] * k[0] + k[1] * k[1] + k[2] * k[2] + k[3] * k[3], t2 = k[4] * k[4] + k[5] * k[5] + k[6] * k[6] + k[7] * k[7];
#pragma unroll
            for (int o = 1; o < 32; o <<= 1) { t1 += shx(t1, o); t2 += shx(t2, o); }
            const float r1 = rsqrtf(t1 * (1.f / 128.f) + EPS), r2 = rsqrtf(t2 * (1.f / 128.f) + EPS); const float4 wk = *(const float4*)(P.in[11] + (l * 3 + g) * 128 + (lane & 31) * 4);
            k[0] *= r1 * wk.x; k[1] *= r1 * wk.y; k[2] *= r1 * wk.z; k[3] *= r1 * wk.w; k[4] *= r2 * wk.x; k[5] *= r2 * wk.y; k[6] *= r2 * wk.z; k[7] *= r2 * wk.w;
            float* kvd = P.out + (g == 0 ? O_KV1S : (g == 1 ? O_KV4S : O_KV16S)) + (size_t)(l * 32 + b) * 1024;
            *(float4*)(kvd + lane * 4) = make_float4(k[0], k[1], k[2], k[3]); *(float4*)(kvd + 256 + lane * 4) = make_float4(k[4], k[5], k[6], k[7]);
            const u32x2 va = *(const u32x2*)(zr + C_VA + g * 512 + lane * 4), vc = *(const u32x2*)(zr + C_VA + g * 512 + 256 + lane * 4);
            *(float4*)(kvd + 512 + lane * 4) = make_float4(bflo(va.x), bfhi(va.x), bflo(va.y), bfhi(va.y)); *(float4*)(kvd + 768 + lane * 4) = make_float4(bflo(vc.x), bfhi(vc.x), bflo(vc.y), bfhi(vc.y));
#pragma unroll
            for (int i = 0; i < 8; ++i) k[i] = tobf1f(k[i]); }
        float s1 = q[0] * k[0] + q[1] * k[1] + q[2] * k[2] + q[3] * k[3], s2 = q[4] * k[4] + q[5] * k[5] + q[6] * k[6] + q[7] * k[7];
#pragma unroll
        for (int o = 1; o < 32; o <<= 1) { s1 += shx(s1, o); s2 += shx(s2, o); }
        if ((lane & 31) == 0) { const int h0 = lane >> 5; sc[h0 * 132] = s1; sc[(2 + h0) * 132] = s2; }
    }
#pragma unroll 1
    for (int half = 0; half < 2; ++half) {
        float4 ka[8], kb[8];
#pragma unroll
        for (int i = 0; i < 8; ++i) { const int jj = 1 + w + 8 * (half * 8 + i); const float* kp = cache + (size_t)(lg - jj * d) * 1024; ka[i] = *(const float4*)(kp + lane * 4); kb[i] = *(const float4*)(kp + 256 + lane * 4); }
#pragma unroll
        for (int i = 0; i < 8; ++i) { const int jj = 1 + w + 8 * (half * 8 + i);
            float s1 = q[0] * ka[i].x + q[1] * ka[i].y + q[2] * ka[i].z + q[3] * ka[i].w, s2 = q[4] * kb[i].x + q[5] * kb[i].y + q[6] * kb[i].z + q[7] * kb[i].w;
#pragma unroll
            for (int o = 1; o < 32; o <<= 1) { s1 += shx(s1, o); s2 += shx(s2, o); }
            if ((lane & 31) == 0) { const int h0 = lane >> 5; sc[h0 * 132 + jj] = s1; sc[(2 + h0) * 132 + jj] = s2; } }
    }
    __syncthreads();
    if (w < 4) { const float* btg = (const float*)(P.ws + WS_BT) + (g * 4 + w) * 132;
        const float v0 = sc[w * 132 + lane] + btg[lane], v1 = sc[w * 132 + 64 + lane] + btg[64 + lane], v2 = lane == 0 ? sc[w * 132 + 128] + btg[128] : -3.0e38f;
        float mx = fmaxf(fmaxf(v0, v1), v2);
#pragma unroll
        for (int o = 1; o < 64; o <<= 1) mx = fmaxf(mx, shx(mx, o));
        const float e0 = __expf(v0 - mx), e1 = __expf(v1 - mx), e2 = lane == 0 ? __expf(v2 - mx) : 0.f;
        sc[w * 132 + lane] = e0; sc[w * 132 + 64 + lane] = e1; if (lane == 0) sc[w * 132 + 128] = e2;
        const float sm = wsum64(e0 + e1 + e2);
        if (lane == 0) { st[w] = mx; st[4 + w] = sm; } }
    __syncthreads();
    float acc[8];
#pragma unroll
    for (int i = 0; i < 8; ++i) acc[i] = 0.f;
    if (w == 0) { const u32x2 a = *(const u32x2*)(zr + C_VA + g * 512 + lane * 4), c = *(const u32x2*)(zr + C_VA + g * 512 + 256 + lane * 4);
        const float p1 = sc[(lane >> 5) * 132], p2 = sc[(2 + (lane >> 5)) * 132];
        acc[0] += p1 * bflo(a.x); acc[1] += p1 * bfhi(a.x); acc[2] += p1 * bflo(a.y); acc[3] += p1 * bfhi(a.y); acc[4] += p2 * bflo(c.x); acc[5] += p2 * bfhi(c.x); acc[6] += p2 * bflo(c.y); acc[7] += p2 * bfhi(c.y); }
#pragma unroll 1
    for (int half = 0; half < 2; ++half) {
        float4 va[8], vb[8];
#pragma unroll
        for (int i = 0; i < 8; ++i) { const int jj = 1 + w + 8 * (half * 8 + i); const float* vp = cache + (size_t)(lg - jj * d) * 1024 + 512; va[i] = *(const float4*)(vp + lane * 4); vb[i] = *(const float4*)(vp + 256 + lane * 4); }
#pragma unroll
        for (int i = 0; i < 8; ++i) { const int jj = 1 + w + 8 * (half * 8 + i); const float p1 = sc[(lane >> 5) * 132 + jj], p2 = sc[(2 + (lane >> 5)) * 132 + jj];
            acc[0] += p1 * va[i].x; acc[1] += p1 * va[i].y; acc[2] += p1 * va[i].z; acc[3] += p1 * va[i].w; acc[4] += p2 * vb[i].x; acc[5] += p2 * vb[i].y; acc[6] += p2 * vb[i].z; acc[7] += p2 * vb[i].w; }
    }
    *(LAS f32x4*)(part + w * 512 + lane * 4) = (f32x4){acc[0], acc[1], acc[2], acc[3]};
    *(LAS f32x4*)(part + w * 512 + 256 + lane * 4) = (f32x4){acc[4], acc[5], acc[6], acc[7]};
    __syncthreads();
    { float s = 0.f;
#pragma unroll
      for (int ww = 0; ww < 8; ++ww) s += part[ww * 512 + tid];
      const int j = tid >> 7; OG[((size_t)g * NR + NP + b) * 512 + tid] = tobf1(s / st[4 + j]);
      if (tid < 4) LSE[((size_t)g * NR + NP + b) * 4 + tid] = st[tid] + __logf(st[4 + tid]); }
    __syncthreads();
}

template <bool ZETA> __device__ __forceinline__ void ret_stage(const bf16_t* Z, const float2* CS, size_t row0, int pos0, int h, float lgh, float rsq128, LAS unsigned char* lds, int tid) {
    u32x4 vraw[8];
#pragma unroll
    for (int c = 0; c < 8; ++c) { const int id = tid + 512 * c, tok = id >> 5, c32 = id & 31; vraw[c] = *(const u32x4*)(Z + ZO_RV + ((size_t)h * NP + row0 + tok) * 256 + c32 * 8); }
    __builtin_amdgcn_sched_barrier(0);
#pragma unroll
    for (int c = 0; c < 2; ++c) { const int id = tid + 512 * c, tok = id >> 3, c8 = id & 7; const bf16_t* kp = Z + ZO_RK + ((size_t)h * NP + row0 + tok) * 128 + c8 * 8;
        const u32x4 a = *(const u32x4*)kp, bq = *(const u32x4*)(kp + 64); const float4* cp = (const float4*)(CS + (size_t)(pos0 + tok) * 64 + c8 * 8);
        const float4 c0 = cp[0], c1 = cp[1], c2 = cp[2], c3 = cp[3];
        float sc = rsq128; if (ZETA) sc *= __expf((float)(127 - tok) * lgh);
        const float x1[8] = {bflo(a.x), bfhi(a.x), bflo(a.y), bfhi(a.y), bflo(a.z), bfhi(a.z), bflo(a.w), bfhi(a.w)}, x2[8] = {bflo(bq.x), bfhi(bq.x), bflo(bq.y), bfhi(bq.y), bflo(bq.z), bfhi(bq.z), bflo(bq.w), bfhi(bq.w)};
        const float cs[8] = {c0.x, c0.z, c1.x, c1.z, c2.x, c2.z, c3.x, c3.z}, sn[8] = {c0.y, c0.w, c1.y, c1.w, c2.y, c2.w, c3.y, c3.w};
        float o1[8], o2[8];
#pragma unroll
        for (int i = 0; i < 8; ++i) { o1[i] = (x1[i] * cs[i] - x2[i] * sn[i]) * sc; o2[i] = (x1[i] * sn[i] + x2[i] * cs[i]) * sc; }
        u32x4 w1, w2; w1.x = pkbf(o1[0], o1[1]); w1.y = pkbf(o1[2], o1[3]); w1.z = pkbf(o1[4], o1[5]); w1.w = pkbf(o1[6], o1[7]); w2.x = pkbf(o2[0], o2[1]); w2.y = pkbf(o2[2], o2[3]); w2.z = pkbf(o2[4], o2[5]); w2.w = pkbf(o2[6], o2[7]);
        *(LAS u32x4*)(lds + offb(tok, c8)) = w1; *(LAS u32x4*)(lds + offb(tok, c8 + 8)) = w2; }
#pragma unroll
    for (int c = 0; c < 8; ++c) { const int id = tid + 512 * c, tok = id >> 5, c32 = id & 31; *(LAS u32x4*)(lds + 32768 + (c32 >> 4) * 32768 + offb(tok, c32 & 15)) = vraw[c]; }
}
__device__ __forceinline__ void ret1_unit(const Params& P, const bf16_t* Z, float* RU, int u, LAS unsigned char* lds, int tid) {
    const int lane = tid & 63, w = __builtin_amdgcn_readfirstlane(tid >> 6), fr = lane & 15, fq = lane >> 4, q4 = fr >> 2, p4 = fr & 3;
    const int h = u & 3, bc = u >> 2;
    ret_stage<true>(Z, (const float2*)(P.ws + WS_CS), (size_t)bc * 128, (bc & 63) * 128, h, P.logg[h], P.rsq128, lds, tid);
    __syncthreads();
    f32x4 acc[8][2];
#pragma unroll
    for (int mt = 0; mt < 8; ++mt) { acc[mt][0] = (f32x4){0.f, 0.f, 0.f, 0.f}; acc[mt][1] = (f32x4){0.f, 0.f, 0.f, 0.f}; }
#pragma unroll
    for (int ks = 0; ks < 4; ++ks) {
        const int r0 = 32 * ks + 8 * fq + q4;
        bf16x8 Bf[2];
#pragma unroll
        for (int nt = 0; nt < 2; ++nt) { const int dvt = 2 * w + nt; LAS unsigned char* vb = lds + 32768 + (dvt >> 3) * 32768; const int c = dvt & 7;
            Bf[nt] = cat4(trr(vb + offb(r0, 2 * c + (p4 >> 1)) + 8 * (p4 & 1)), trr(vb + offb(r0 + 4, 2 * c + (p4 >> 1)) + 8 * (p4 & 1))); }
#pragma unroll
        for (int mt = 0; mt < 8; ++mt) { const bf16x8 Af = cat4(trr(lds + offb(r0, 2 * mt + (p4 >> 1)) + 8 * (p4 & 1)), trr(lds + offb(r0 + 4, 2 * mt + (p4 >> 1)) + 8 * (p4 & 1)));
            acc[mt][0] = mfma16(Af, Bf[0], acc[mt][0]); acc[mt][1] = mfma16(Af, Bf[1], acc[mt][1]); }
    }
    bf16_t* Up = (bf16_t*)RU + ((size_t)bc * 4 + h) * 32768;
#pragma unroll
    for (int mt = 0; mt < 8; ++mt)
#pragma unroll
        for (int nt = 0; nt < 2; ++nt) { u32x2 o; o.x = pkbf(acc[mt][nt][0], acc[mt][nt][1]); o.y = pkbf(acc[mt][nt][2], acc[mt][nt][3]); *(u32x2*)(Up + (size_t)(32 * w + 16 * nt + fr) * 128 + 16 * mt + 4 * fq) = o; }
    __syncthreads();
}
__device__ __forceinline__ void sret_unit(const Params& P, int l, const bf16_t* Z, bf16_t* ORET, int u, LAS unsigned char* lds, int tid) {
    const int b = u >> 2, h = u & 3; const bf16_t* zr = Z + (size_t)(NP + b) * INC;
    LAS float* qf = (LAS float*)lds; LAS float* kf = qf + 128; LAS float* part = kf + 128; LAS float* red = part + 512;
    if (tid < 64) { const float2 cs = ((const float2*)(P.ws + WS_CS))[(size_t)8192 * 64 + tid];
        const float q1 = bf1(zr[C_QR + h * 128 + tid]), q2 = bf1(zr[C_QR + h * 128 + 64 + tid]), k1 = bf1(zr[C_KR + h * 128 + tid]), k2 = bf1(zr[C_KR + h * 128 + 64 + tid]);
        qf[tid] = tobf1f(q1 * cs.x - q2 * cs.y); qf[64 + tid] = tobf1f(q1 * cs.y + q2 * cs.x);
        kf[tid] = tobf1f((k1 * cs.x - k2 * cs.y) * P.rsq128); kf[64 + tid] = tobf1f((k1 * cs.y + k2 * cs.x) * P.rsq128); }
    __syncthreads();
    const int e = tid & 255, half = tid >> 8; const float ve = bf1(zr[C_VR + h * 256 + e]); const float gamma = __expf(P.logg[h]);
    float qk = 0.f;
#pragma unroll 4
    for (int dk = 0; dk < 128; ++dk) qk += qf[dk] * kf[dk];
    const float* r0 = P.in[5] + ((size_t)(l * 32 + b) * 4 + h) * 32768; float* rn = P.out + O_RETS + ((size_t)(l * 32 + b) * 4 + h) * 32768;
    float acc = 0.f;
#pragma unroll
    for (int q = 0; q < 2; ++q) { float rv[32];
#pragma unroll
        for (int i = 0; i < 32; ++i) rv[i] = r0[(half * 64 + q * 32 + i) * 256 + e];
        __builtin_amdgcn_sched_barrier(0);
#pragma unroll
        for (int i = 0; i < 32; ++i) { const int dk = half * 64 + q * 32 + i; const float r = rv[i]; rn[dk * 256 + e] = gamma * r + kf[dk] * ve; acc += qf[dk] * r; }
        __builtin_amdgcn_sched_barrier(0); }
    part[half * 256 + e] = acc;
    __syncthreads();
    float o = 0.f;
    if (tid < 256) { o = qk * ve + gamma * (part[e] + part[256 + e]); const float s = wsum64(o * o); if ((tid & 63) == 0) red[tid >> 6] = s; }
    __syncthreads();
    if (tid < 256) { const float ss = red[0] + red[1] + red[2] + red[3]; const float rstd = rsqrtf(ss * (1.f / 256.f) + EPS); const float gr = bf1(zr[C_GR + h * 256 + e]);
        ORET[(size_t)(NP + b) * DM + h * 256 + e] = tobf1(o * rstd * gr * sigmoidf_(gr)); }
    __syncthreads();
}

struct CombIn { float l0, l1, l2; u32x4 a, bq, c; };
__device__ __forceinline__ void comb_load(const bf16_t* OG, const float* LSE, int row, int lane, CombIn& I) {
    const int j = lane >> 4;
    I.l0 = LSE[((size_t)0 * NR + row) * 4 + j]; I.l1 = LSE[((size_t)1 * NR + row) * 4 + j]; I.l2 = LSE[((size_t)2 * NR + row) * 4 + j];
    I.a = *(const u32x4*)(OG + ((size_t)0 * NR + row) * 512 + lane * 8); I.bq = *(const u32x4*)(OG + ((size_t)1 * NR + row) * 512 + lane * 8); I.c = *(const u32x4*)(OG + ((size_t)2 * NR + row) * 512 + lane * 8);
}
__device__ __forceinline__ void comb_fin(const CombIn& I, bf16_t* AO, int row, int lane) {
        const float l0 = I.l0, l1 = I.l1, l2 = I.l2; const u32x4 a = I.a, bq = I.bq, c = I.c;
        const float m = fmaxf(l0, fmaxf(l1, l2)); float w0 = __expf(l0 - m), w1 = __expf(l1 - m), w2 = __expf(l2 - m); const float inv = 1.f / (w0 + w1 + w2); w0 *= inv; w1 *= inv; w2 *= inv;
        u32x4 o;
        o.x = pkbf(w0 * bflo(a.x) + w1 * bflo(bq.x) + w2 * bflo(c.x), w0 * bfhi(a.x) + w1 * bfhi(bq.x) + w2 * bfhi(c.x));
        o.y = pkbf(w0 * bflo(a.y) + w1 * bflo(bq.y) + w2 * bflo(c.y), w0 * bfhi(a.y) + w1 * bfhi(bq.y) + w2 * bfhi(c.y));
        o.z = pkbf(w0 * bflo(a.z) + w1 * bflo(bq.z) + w2 * bflo(c.z), w0 * bfhi(a.z) + w1 * bfhi(bq.z) + w2 * bfhi(c.z));
        o.w = pkbf(w0 * bflo(a.w) + w1 * bflo(bq.w) + w2 * bflo(c.w), w0 * bfhi(a.w) + w1 * bfhi(bq.w) + w2 * bfhi(c.w));
        *(u32x4*)(AO + (size_t)row * 512 + lane * 8) = o;
}
__device__ __forceinline__ void combine_row(const bf16_t* OG, const float* LSE, bf16_t* AO, int row, int lane) { CombIn I; comb_load(OG, LSE, row, lane, I); comb_fin(I, AO, row, lane); }
__device__ __forceinline__ void p4_scan_combine(const Params& P, int l, const float* RU, bf16_t* RS, const bf16_t* OG, const float* LSE, bf16_t* AO, int tid, int bid, int G) {
    const int gt = bid * 512 + tid;
    if (gt < 65536) { const int bh = gt >> 13, b = bh >> 2, h = bh & 3, e4 = gt & 8191; const float g128 = __expf(128.f * P.logg[h]);
        f32x4 S = {0.f, 0.f, 0.f, 0.f};
        f32x4 ua[8], ub[8];
#pragma unroll
        for (int j = 0; j < 8; ++j) { const u32x2 t = *(const u32x2*)((const bf16_t*)RU + ((size_t)(b * 64 + j) * 4 + h) * 32768 + (size_t)e4 * 4); ua[j] = (f32x4){bflo(t.x), bfhi(t.x), bflo(t.y), bfhi(t.y)}; }
#pragma unroll
        for (int cb = 0; cb < 8; ++cb) {
            if (cb < 7) {
#pragma unroll
                for (int j = 0; j < 8; ++j) { const u32x2 q = *(const u32x2*)((const bf16_t*)RU + ((size_t)(b * 64 + (cb + 1) * 8 + j) * 4 + h) * 32768 + (size_t)e4 * 4); const f32x4 t = {bflo(q.x), bfhi(q.x), bflo(q.y), bfhi(q.y)}; if (cb & 1) ua[j] = t; else ub[j] = t; } }
            __builtin_amdgcn_sched_barrier(0);
#pragma unroll
            for (int j = 0; j < 8; ++j) { const size_t idx = ((size_t)(b * 64 + cb * 8 + j) * 4 + h) * 32768 + (size_t)e4 * 4;
                u32x2 o; o.x = pkbf(S[0], S[1]); o.y = pkbf(S[2], S[3]); *(u32x2*)(RS + idx) = o;
                const f32x4 uv = (cb & 1) ? ub[j] : ua[j]; S = S * g128 + uv; }
            __builtin_amdgcn_sched_barrier(0);
        }
        const int dv = (e4 * 4) >> 7, dk = (e4 * 4) & 127; float* o = P.out + O_RETP + ((size_t)(l * 2 + b) * 4 + h) * 32768;
#pragma unroll
        for (int i = 0; i < 4; ++i) o[(size_t)(dk + i) * 256 + dv] = S[i]; }
    const int lane = tid & 63, gw = bid * 8 + (tid >> 6), nw = G * 8;
    for (int row = gw; row < NP; row += 4 * nw) {
        if (row + 3 * nw < NP) { CombIn I[4];
#pragma unroll
            for (int k = 0; k < 4; ++k) comb_load(OG, LSE, row + k * nw, lane, I[k]);
            __builtin_amdgcn_sched_barrier(0);
#pragma unroll
            for (int k = 0; k < 4; ++k) comb_fin(I[k], AO, row + k * nw, lane); }
        else for (int r2 = row; r2 < NP; r2 += nw) combine_row(OG, LSE, AO, r2, lane); }
}

__device__ __forceinline__ void ret3_unit(const Params& P, const bf16_t* Z, const bf16_t* RS, bf16_t* ORET, int u, LAS unsigned char* lds, int tid) {
    const int lane = tid & 63, w = __builtin_amdgcn_readfirstlane(tid >> 6), fr = lane & 15, fq = lane >> 4, q4 = fr >> 2, p4 = fr & 3;
    const int h = u & 3, bc = u >> 2; const float lgh = P.logg[h];
    ret_stage<false>(Z, (const float2*)(P.ws + WS_CS), (size_t)bc * 128, (bc & 63) * 128, h, lgh, P.rsq128, lds, tid);
    const size_t row = (size_t)bc * 128 + 16 * w + fr;
    bf16x8 Qf[4];
    { const bf16_t* qp = Z + ZO_RQ + ((size_t)h * NP + row) * 128 + fq * 8;
#pragma unroll
      for (int s = 0; s < 4; ++s) Qf[s] = *(const bf16x8*)(qp + 32 * s);
      const float2* cp = (const float2*)(P.ws + WS_CS) + (size_t)((bc & 63) * 128 + 16 * w + fr) * 64 + fq * 8;
#pragma unroll
      for (int s = 0; s < 2; ++s) { const u32x4 a = __builtin_bit_cast(u32x4, Qf[s]), bq = __builtin_bit_cast(u32x4, Qf[s + 2]); const float4* c4 = (const float4*)(cp + 32 * s); const float4 c0 = c4[0], c1 = c4[1], c2 = c4[2], c3 = c4[3];
          const float x1[8] = {bflo(a.x), bfhi(a.x), bflo(a.y), bfhi(a.y), bflo(a.z), bfhi(a.z), bflo(a.w), bfhi(a.w)}, x2[8] = {bflo(bq.x), bfhi(bq.x), bflo(bq.y), bfhi(bq.y), bflo(bq.z), bfhi(bq.z), bflo(bq.w), bfhi(bq.w)};
          const float cs[8] = {c0.x, c0.z, c1.x, c1.z, c2.x, c2.z, c3.x, c3.z}, sn[8] = {c0.y, c0.w, c1.y, c1.w, c2.y, c2.w, c3.y, c3.w};
          float o1[8], o2[8];
#pragma unroll
          for (int i = 0; i < 8; ++i) { o1[i] = x1[i] * cs[i] - x2[i] * sn[i]; o2[i] = x1[i] * sn[i] + x2[i] * cs[i]; }
          u32x4 w1, w2; w1.x = pkbf(o1[0], o1[1]); w1.y = pkbf(o1[2], o1[3]); w1.z = pkbf(o1[4], o1[5]); w1.w = pkbf(o1[6], o1[7]); w2.x = pkbf(o2[0], o2[1]); w2.y = pkbf(o2[2], o2[3]); w2.z = pkbf(o2[4], o2[5]); w2.w = pkbf(o2[6], o2[7]);
          Qf[s] = __builtin_bit_cast(bf16x8, w1); Qf[s + 2] = __builtin_bit_cast(bf16x8, w2); } }
    u32x4 rr[8];
    { const bf16_t* Rp = RS + ((size_t)bc * 4 + h) * 32768;
#pragma unroll
      for (int c = 0; c < 8; ++c) rr[c] = *(const u32x4*)(Rp + (size_t)(tid + 512 * c) * 8); }
    __syncthreads();
    f32x4 Pm[8];
#pragma unroll
    for (int mt = 0; mt < 8; ++mt) { Pm[mt] = (f32x4){0.f, 0.f, 0.f, 0.f};
        if (mt <= w) {
#pragma unroll
            for (int s = 0; s < 4; ++s) { const bf16x8 kf = *(const LAS bf16x8*)(lds + offb(16 * mt + fr, 4 * s + fq)); Pm[mt] = mfma16(kf, Qf[s], Pm[mt]); }
#pragma unroll
            for (int e = 0; e < 4; ++e) { const int diff = 16 * w + fr - (16 * mt + 4 * fq + e); Pm[mt][e] = diff >= 0 ? Pm[mt][e] * __expf((float)diff * lgh) : 0.f; } } }
    __syncthreads();
#pragma unroll
    for (int c = 0; c < 8; ++c) { const int id = tid + 512 * c, dv = id >> 4, ch = id & 15;
        *(LAS u32x4*)(lds + (dv < 128 ? 98304 : 0) + offb(dv & 127, ch)) = rr[c]; }
    f32x4 acc[16];
#pragma unroll
    for (int dt = 0; dt < 16; ++dt) acc[dt] = (f32x4){0.f, 0.f, 0.f, 0.f};
#pragma unroll
    for (int ks = 0; ks < 4; ++ks) if (2 * ks <= w) { const bf16x8 Pb = pack8(Pm[2 * ks], Pm[2 * ks + 1]); const int r0 = 32 * ks + 4 * fq + q4;
#pragma unroll
        for (int dt = 0; dt < 16; ++dt) { LAS unsigned char* vb = lds + 32768 + (dt >> 3) * 32768; const int c = dt & 7;
            acc[dt] = mfma16(cat4(trr(vb + offb(r0, 2 * c + (p4 >> 1)) + 8 * (p4 & 1)), trr(vb + offb(r0 + 16, 2 * c + (p4 >> 1)) + 8 * (p4 & 1))), Pb, acc[dt]); } }
    __syncthreads();
    { const float xi = __expf((float)(16 * w + fr + 1) * lgh); bf16x8 Qx[4];
#pragma unroll
      for (int s = 0; s < 4; ++s) { const u32x4 r = __builtin_bit_cast(u32x4, Qf[s]); u32x4 o; o.x = pkbf(bflo(r.x) * xi, bfhi(r.x) * xi); o.y = pkbf(bflo(r.y) * xi, bfhi(r.y) * xi); o.z = pkbf(bflo(r.z) * xi, bfhi(r.z) * xi); o.w = pkbf(bflo(r.w) * xi, bfhi(r.w) * xi); Qx[s] = __builtin_bit_cast(bf16x8, o); }
#pragma unroll
      for (int dt = 0; dt < 16; ++dt) { LAS unsigned char* rb = lds + (dt < 8 ? 98304 : 0);
#pragma unroll
          for (int s = 0; s < 4; ++s) { const bf16x8 rf = *(const LAS bf16x8*)(rb + offb(16 * (dt & 7) + fr, 4 * s + fq)); acc[dt] = mfma16(rf, Qx[s], acc[dt]); } } }
    u32x2 gg[16];
    { const bf16_t* gp = Z + ZO_GR + ((size_t)h * NP + row) * 256 + 4 * fq;
#pragma unroll
      for (int dt = 0; dt < 16; ++dt) gg[dt] = *(const u32x2*)(gp + 16 * dt); }
    __builtin_amdgcn_sched_barrier(0);
    float ss = 0.f;
#pragma unroll
    for (int dt = 0; dt < 16; ++dt) ss += acc[dt][0] * acc[dt][0] + acc[dt][1] * acc[dt][1] + acc[dt][2] * acc[dt][2] + acc[dt][3] * acc[dt][3];
    ss += shx(ss, 16); ss += shx(ss, 32);
    const float rstd = rsqrtf(ss * (1.f / 256.f) + EPS);
    bf16_t* op = ORET + row * DM + h * 256 + 4 * fq;
#pragma unroll
    for (int dt = 0; dt < 16; ++dt) { const u32x2 g = gg[dt]; const float g0 = bflo(g.x), g1 = bfhi(g.x), g2 = bflo(g.y), g3 = bfhi(g.y);
        u32x2 o; o.x = pkbf(acc[dt][0] * rstd * g0 * sigmoidf_(g0), acc[dt][1] * rstd * g1 * sigmoidf_(g1)); o.y = pkbf(acc[dt][2] * rstd * g2 * sigmoidf_(g2), acc[dt][3] * rstd * g3 * sigmoidf_(g3));
        *(u32x2*)(op + 16 * dt) = o; }
    __syncthreads();
}

__device__ __forceinline__ void p8_rms(const float* X, const float* nw, bf16_t* H2, int gw, int nwv, int lane) {
    float4 wv[4];
#pragma unroll
    for (int j = 0; j < 4; ++j) wv[j] = *(const float4*)(nw + j * 256 + lane * 4);
    for (int row0 = gw * 2; row0 < NR; row0 += nwv * 2) { float4 v[2][4];
#pragma unroll
        for (int k = 0; k < 2; ++k)
#pragma unroll
            for (int j = 0; j < 4; ++j) v[k][j] = *(const float4*)(X + (size_t)(row0 + k) * DM + j * 256 + lane * 4);
        __builtin_amdgcn_sched_barrier(0);
#pragma unroll
        for (int k = 0; k < 2; ++k) { float ss = 0.f;
#pragma unroll
            for (int j = 0; j < 4; ++j) ss += v[k][j].x * v[k][j].x + v[k][j].y * v[k][j].y + v[k][j].z * v[k][j].z + v[k][j].w * v[k][j].w;
            const float rstd = rsqrtf(wsum64(ss) * (1.f / 1024.f) + EPS);
#pragma unroll
            for (int j = 0; j < 4; ++j) { const float4 w = wv[j];
                u32x2 o; o.x = pkbf(v[k][j].x * rstd * w.x, v[k][j].y * rstd * w.y); o.y = pkbf(v[k][j].z * rstd * w.z, v[k][j].w * rstd * w.w); *(u32x2*)(H2 + (size_t)(row0 + k) * DM + j * 256 + lane * 4) = o; } } }
}

constexpr int PT_CAP = 65;
constexpr int PL_SVL = 0;
constexpr int PL_EL = PT_CAP * 16 * 20 * 4;
constexpr int PL_GL = PL_EL + PT_CAP * 128 * 4;
constexpr int PL_ACT = PL_GL + PT_CAP * 128 * 4;
static_assert(PL_ACT + 8 * 128 * 4 <= LDS_BAR, "PEER LDS map");

struct RowBuf { u32x4 a[8]; u32x2 b[8]; };
__device__ __forceinline__ f32x32 cv6(const u32x4& a, const u32x2& b) { u32x6 p = {a.x, a.y, a.z, a.w, b.x, b.y};
    f32x32 r = __builtin_amdgcn_cvt_scalef32_pk32_f32_fp6(p, 1.0f);
    return r; }
__device__ __forceinline__ void peer_issue(RowBuf& B, const __amdgpu_buffer_rsrc_t tab, const LAS int* el, int h, int lane) {
    const int hl = lane & 31, upi = (lane >> 5) & 1; const int lo = hl * 16, lo8 = 512 - hl * 8;
    const LAS i32x4* ep = (const LAS i32x4*)(el + h * 16 + 8 * upi); const i32x4 e0 = ep[0], e1 = ep[1];
    const int e[8] = {e0[0], e0[1], e0[2], e0[3], e1[0], e1[1], e1[2], e1[3]};
#pragma unroll
    for (int i = 0; i < 8; ++i) { const int off = e[i] * 768 + lo;
        B.a[i] = __builtin_amdgcn_raw_buffer_load_b128(tab, off, 0, 0); B.b[i] = __builtin_amdgcn_raw_buffer_load_b64(tab, off + lo8, 0, 0); }
}
__device__ __forceinline__ float peer_dot32(const f32x32& r, const f32x2 (&hf)[16]) {
    f32x2 a = {0.f, 0.f};
#pragma unroll
    for (int j = 0; j < 16; ++j) { f32x2 rr; rr.x = r[2 * j]; rr.y = r[2 * j + 1]; a = __builtin_elementwise_fma(rr, hf[j], a); }
    return a.x + a.y;
}
__device__ __forceinline__ void peer_udot(const RowBuf& B, const f32x2 (&hf)[16], LAS float* act, int h, int lane) {
    const bool h3 = lane & 8, h2 = lane & 4;
    float p[8];
#pragma unroll
    for (int i = 0; i < 8; ++i) { u32x4 ra = B.a[i]; u32x2 rb = B.b[i]; if (i > 0) asm volatile("" : "+v"(ra), "+v"(rb), "+v"(p[i - 1]));
        p[i] = peer_dot32(cv6(ra, rb), hf); }
    float q[4];
#pragma unroll
    for (int i = 0; i < 4; ++i) { const u32x2 pr = __builtin_amdgcn_permlane16_swap(__float_as_uint(p[i]), __float_as_uint(p[i + 4]), false, false);
        q[i] = __uint_as_float(pr.x) + __uint_as_float(pr.y); }
    float r[2];
#pragma unroll
    for (int i = 0; i < 2; ++i) { const float snd = h3 ? q[i] : q[i + 2], keep = h3 ? q[i + 2] : q[i]; r[i] = keep + shx(snd, 8); }
    float t; { const float snd = h2 ? r[0] : r[1], keep = h2 ? r[1] : r[0]; t = keep + shx(snd, 4); }
    t += __int_as_float(__builtin_amdgcn_mov_dpp(__float_as_int(t), 0x4E, 0xF, 0xF, true)); t += __int_as_float(__builtin_amdgcn_mov_dpp(__float_as_int(t), 0xB1, 0xF, 0xF, true));
    if ((lane & 3) == 0) act[h * 16 + ((lane >> 5) & 1) * 8 + ((lane >> 4) & 1) * 4 + ((lane >> 3) & 1) * 2 + ((lane >> 2) & 1)] = t;
}
__device__ __forceinline__ void peer_vacc(const RowBuf& B, const LAS float* coef, int h, int lane, f32x32& o) {
    const LAS float* cp = coef + h * 16 + ((lane >> 5) & 1) * 8;
#pragma unroll
    for (int i = 0; i < 8; ++i) { const float c = cp[i];
        u32x4 ra = B.a[i]; u32x2 rb = B.b[i]; asm volatile("" : "+v"(ra), "+v"(rb), "+v"(o));
        const f32x32 r = cv6(ra, rb);
        o = __builtin_elementwise_fma(r, (f32x32)c, o); }
}
__device__ __forceinline__ void peer_load_h(const bf16_t* H2, int row, int lane, f32x2 (&hf)[16]) {
    const bf16_t* hp = H2 + (size_t)row * DM + (lane & 31) * 32;
#pragma unroll
    for (int k = 0; k < 4; ++k) { const u32x4 v = *(const u32x4*)(hp + 8 * k);
        hf[4 * k] = (f32x2){bflo(v.x), bfhi(v.x)}; hf[4 * k + 1] = (f32x2){bflo(v.y), bfhi(v.y)}; hf[4 * k + 2] = (f32x2){bflo(v.z), bfhi(v.z)}; hf[4 * k + 3] = (f32x2){bflo(v.w), bfhi(v.w)}; }
}
__device__ __forceinline__ void peer_join(const f32x32& o, int lane, f32x2 (&y)[8]) {
    (void)lane;
#pragma unroll
    for (int j = 0; j < 8; ++j) {
        const u32x2 p0 = __builtin_amdgcn_permlane32_swap(__float_as_uint(o[2 * j]), __float_as_uint(o[16 + 2 * j]), false, false);
        const u32x2 p1 = __builtin_amdgcn_permlane32_swap(__float_as_uint(o[2 * j + 1]), __float_as_uint(o[16 + 2 * j + 1]), false, false);
        y[j].x = __uint_as_float(p0.x) + __uint_as_float(p0.y); y[j].y = __uint_as_float(p1.x) + __uint_as_float(p1.y); }
}
#define MK_FRESH_LANE() int lane; asm volatile("v_mbcnt_lo_u32_b32 %0, -1, 0\n\tv_mbcnt_hi_u32_b32 %0, -1, %0" : "=v"(lane));
__device__ __forceinline__ void p10_peer(const Params& P, int l, const int* SC, const bf16_t* H2, float* X, bf16_t* Hn, LAS unsigned char* lds, int w, int bid, int G) {
    const int t0 = (int)(((long)bid * NP) / G), t1 = (int)(((long)(bid + 1) * NP) / G);
    LAS int* svl = (LAS int*)(lds + PL_SVL); LAS int* elist = (LAS int*)(lds + PL_EL); LAS float* glist = (LAS float*)(lds + PL_GL);
    const __amdgpu_buffer_rsrc_t Ub = __builtin_amdgcn_make_buffer_rsrc((void*)(P.ws + WS_UBF + (size_t)l * SZ_TAB6), 0, (int)SZ_TAB6, 0x00020000);
    const __amdgpu_buffer_rsrc_t Vb = __builtin_amdgcn_make_buffer_rsrc((void*)(P.ws + WS_VBF + (size_t)l * SZ_TAB6), 0, (int)SZ_TAB6, 0x00020000);
    const float* USC = (const float*)(P.ws + WS_TSC) + (size_t)l * 16384; const float* VSC = (const float*)(P.ws + WS_TSC) + (size_t)(2 + l) * 16384;
    const bool last = (l == NLAYER - 1); const float* nwn = P.in[7] + (last ? 0 : (l + 1) * DM);
    for (int c0 = t0; c0 < t1; c0 += PT_CAP - 1) {
        const int ntp = (t1 - c0) < PT_CAP - 1 ? (t1 - c0) : PT_CAP - 1; const int smp = (c0 == t0 && bid < NSMP) ? NP + bid : -1; const int nt = ntp + (smp >= 0 ? 1 : 0);
#define MK_ROWOF(ti) ((ti) < ntp ? c0 + (ti) : smp)
#ifndef MK_P10MASK
#define MK_P10MASK 31
#endif
        if (MK_P10MASK & 1) { MK_FRESH_LANE(); const int ngrp = (nt + 15) >> 4;
          for (int it = w; it < ngrp * 4; it += 8) { const int tg = it >> 2, hq = it & 3, ti = tg * 16 + (lane & 15), hpi = hq * 4 + (lane >> 4); const bool ok = ti < nt; const int row = MK_ROWOF(ok ? ti : nt - 1);
            const int* sp = SC + ((size_t)(row >> 4) * 512 + hpi * 32) * 64 + (row & 15) * 4;
            int sv[16];
#pragma unroll
            for (int i = 0; i < 16; ++i) sv[i] = (int)0x80000000;
            i32x4 va[8], vb[8];
#pragma unroll
            for (int j = 0; j < 8; ++j) va[j] = *(const i32x4*)(sp + (size_t)j * 64);
#pragma unroll
            for (int b = 0; b < 4; ++b) {
                if (b < 3) {
#pragma unroll
                    for (int j = 0; j < 8; ++j) { const i32x4 t = *(const i32x4*)(sp + (size_t)((b + 1) * 8 + j) * 64); if (b & 1) va[j] = t; else vb[j] = t; } }
                __builtin_amdgcn_sched_barrier(0);
#pragma unroll
                for (int j = 0; j < 8; ++j) { const i32x4 v = (b & 1) ? vb[j] : va[j]; ins16(sv, v[0]); ins16(sv, v[1]); ins16(sv, v[2]); ins16(sv, v[3]); }
                __builtin_amdgcn_sched_barrier(0);
            }
            if (ok) { LAS int* d = svl + (ti * 16 + hpi) * 20;
#pragma unroll
                for (int i = 0; i < 4; ++i) *(LAS i32x4*)(d + 4 * i) = (i32x4){sv[4 * i], sv[4 * i + 1], sv[4 * i + 2], sv[4 * i + 3]}; } } }
        __syncthreads();
        if (MK_P10MASK & 2) { MK_FRESH_LANE(); const int tid = w * 64 + lane; for (int it = tid; it < nt * 8; it += 512) { const int ti = it >> 3, h = it & 7; const LAS int* pa = svl + (ti * 16 + 2 * h) * 20; const LAS int* pb = pa + 20;
            float fa[16], fb[16];
#pragma unroll
            for (int i = 0; i < 4; ++i) { const i32x4 va = *(const LAS i32x4*)(pa + 4 * i), vb = *(const LAS i32x4*)(pb + 4 * i);
#pragma unroll
                for (int e = 0; e < 4; ++e) { fa[4 * i + e] = unsortable(va[e] & ~127); fb[4 * i + e] = unsortable(vb[e] & ~127); } }
            int top[16];
#pragma unroll
            for (int i = 0; i < 16; ++i) top[i] = (int)0x80000000;
#pragma unroll
            for (int i = 0; i < 16; ++i)
#pragma unroll
                for (int j = 0; j < 16; ++j) if ((i + 1) * (j + 1) <= 16) ins16(top, (sortable(fa[i] + fb[j]) & ~255) | (255 - (i * 16 + j)));
            float ev[16]; float sum = 0.f; const float mxv = unsortable(top[0] & ~255);
#pragma unroll
            for (int k = 0; k < 16; ++k) { ev[k] = __expf(unsortable(top[k] & ~255) - mxv); sum += ev[k]; }
            const float inv = 1.f / sum;
#pragma unroll
            for (int k = 0; k < 16; ++k) { const int cidx = 255 - (top[k] & 255), ia = 127 - (pa[cidx >> 4] & 127), ib = 127 - (pb[cidx & 15] & 127);
                elist[ti * 128 + h * 16 + k] = ia * 128 + ib; glist[ti * 128 + h * 16 + k] = ev[k] * inv; } } }
        __syncthreads();
        if (MK_P10MASK & 4) { LAS float* actl = (LAS float*)(lds + PL_SVL);
          if (MK_P10MASK & 8) { MK_FRESH_LANE(); RowBuf B0, B1;
            for (int ti = w; ti < ntp; ti += 8) {
              const int row = c0 + ti; const LAS int* el = elist + ti * 128; LAS float* act = actl + ti * 128;
              peer_issue(B0, Ub, el, 0, lane);
              f32x2 hf[16]; peer_load_h(H2, row, lane, hf);
#pragma unroll 1
              for (int hh = 0; hh < 6; hh += 2) {
                  peer_issue(B1, Ub, el, hh + 1, lane);
                  peer_udot(B0, hf, act, hh, lane);
                  peer_issue(B0, Ub, el, hh + 2, lane);
                  peer_udot(B1, hf, act, hh + 1, lane);
              }
              peer_issue(B1, Ub, el, 7, lane);
              peer_udot(B0, hf, act, 6, lane);
              peer_udot(B1, hf, act, 7, lane); } }
          if (smp >= 0) { MK_FRESH_LANE(); const int ti = ntp, row = smp; const LAS int* el = elist + ti * 128; LAS float* act = actl + ti * 128;
              RowBuf B; peer_issue(B, Ub, el, w, lane);
              f32x2 hf[16]; peer_load_h(H2, row, lane, hf);
              peer_udot(B, hf, act, w, lane); }
          __syncthreads();
          { MK_FRESH_LANE(); float us0[9], us1[9], vs0[9], vs1[9];
#pragma unroll
            for (int k = 0; k < 9; ++k) { const int ti = w + 8 * k; us0[k] = us1[k] = vs0[k] = vs1[k] = 0.f;
                if (ti < nt) { const LAS int* el = elist + ti * 128; const int e0 = el[lane], e1 = el[64 + lane]; us0[k] = USC[e0]; us1[k] = USC[e1]; vs0[k] = VSC[e0]; vs1[k] = VSC[e1]; } }
            __builtin_amdgcn_sched_barrier(0);
#pragma unroll
            for (int k = 0; k < 9; ++k) { const int ti = w + 8 * k;
                if (ti < nt) { const LAS float* gl = glist + ti * 128; LAS float* act = actl + ti * 128;
                    const float a0 = act[lane] * us0[k], a1 = act[64 + lane] * us1[k]; const float g0 = gl[lane] * vs0[k], g1 = gl[64 + lane] * vs1[k];
                    act[lane] = g0 * 0.5f * a0 * (1.f + erff(a0 * 0.70710678118654752f)); act[64 + lane] = g1 * 0.5f * a1 * (1.f + erff(a1 * 0.70710678118654752f)); } } }
          __syncthreads();
          if (MK_P10MASK & 16) { MK_FRESH_LANE(); RowBuf B0, B1;
            const int dofw = (lane & 31) * 32 + ((lane >> 5) & 1) * 16;
            const float4 w0 = *(const float4*)(nwn + dofw), w1 = *(const float4*)(nwn + dofw + 4), w2 = *(const float4*)(nwn + dofw + 8), w3 = *(const float4*)(nwn + dofw + 12);
            for (int ti = w; ti < ntp; ti += 8) {
              const int row = c0 + ti; const LAS int* el = elist + ti * 128; const LAS float* act = actl + ti * 128;
              peer_issue(B0, Vb, el, 0, lane);
              f32x32 o = (f32x32)0.f;
#pragma unroll 1
              for (int hh = 0; hh < 6; hh += 2) {
                  peer_issue(B1, Vb, el, hh + 1, lane);
                  peer_vacc(B0, act, hh, lane, o);
                  peer_issue(B0, Vb, el, hh + 2, lane);
                  peer_vacc(B1, act, hh + 1, lane, o);
              }
              peer_issue(B1, Vb, el, 7, lane);
              peer_vacc(B0, act, 6, lane, o);
              const int dof = (lane & 31) * 32 + ((lane >> 5) & 1) * 16;
              float* xr = X + (size_t)row * DM + dof;
              const float4 x0 = *(const float4*)(xr), x1 = *(const float4*)(xr + 4), x2 = *(const float4*)(xr + 8), x3 = *(const float4*)(xr + 12);
              __builtin_amdgcn_sched_barrier(0);
              peer_vacc(B1, act, 7, lane, o);
              asm volatile("" ::: "memory"); __builtin_amdgcn_sched_barrier(0);
              f32x2 yo[8]; peer_join(o, lane, yo);
              float y[16];
              {
                y[0] = x0.x + yo[0].x; y[1] = x0.y + yo[0].y; y[2] = x0.z + yo[1].x; y[3] = x0.w + yo[1].y; y[4] = x1.x + yo[2].x; y[5] = x1.y + yo[2].y; y[6] = x1.z + yo[3].x; y[7] = x1.w + yo[3].y;
                y[8] = x2.x + yo[4].x; y[9] = x2.y + yo[4].y; y[10] = x2.z + yo[5].x; y[11] = x2.w + yo[5].y; y[12] = x3.x + yo[6].x; y[13] = x3.y + yo[6].y; y[14] = x3.z + yo[7].x; y[15] = x3.w + yo[7].y; }
              float* dst = last ? (row < NP ? P.out + O_YP + (size_t)row * DM : P.out + O_YS + (size_t)(row - NP) * DM) + dof : xr;
              *(float4*)(dst) = make_float4(y[0], y[1], y[2], y[3]); *(float4*)(dst + 4) = make_float4(y[4], y[5], y[6], y[7]);
              *(float4*)(dst + 8) = make_float4(y[8], y[9], y[10], y[11]); *(float4*)(dst + 12) = make_float4(y[12], y[13], y[14], y[15]);
              if (!last) { float ss = 0.f;
#pragma unroll
                  for (int i = 0; i < 16; ++i) ss += y[i] * y[i];
                  const float rstd = rsqrtf(wsum64(ss) * (1.f / 1024.f) + EPS);
                  u32x4 o0, o1; o0.x = pkbf(y[0] * rstd * w0.x, y[1] * rstd * w0.y); o0.y = pkbf(y[2] * rstd * w0.z, y[3] * rstd * w0.w); o0.z = pkbf(y[4] * rstd * w1.x, y[5] * rstd * w1.y); o0.w = pkbf(y[6] * rstd * w1.z, y[7] * rstd * w1.w);
                  o1.x = pkbf(y[8] * rstd * w2.x, y[9] * rstd * w2.y); o1.y = pkbf(y[10] * rstd * w2.z, y[11] * rstd * w2.w); o1.z = pkbf(y[12] * rstd * w3.x, y[13] * rstd * w3.y); o1.w = pkbf(y[14] * rstd * w3.z, y[15] * rstd * w3.w);
                  *(u32x4*)(Hn + (size_t)row * DM + dof) = o0; *(u32x4*)(Hn + (size_t)row * DM + dof + 8) = o1; }
            } }
          if (smp >= 0) { MK_FRESH_LANE(); const int ti = ntp, row = smp; const LAS int* el = elist + ti * 128; const LAS float* act = actl + ti * 128;
              LAS float* part = (LAS float*)(lds + PL_SVL + 36864); LAS float* red = part + 8192;
              RowBuf B; peer_issue(B, Vb, el, w, lane);
              f32x32 o = (f32x32)0.f;
              peer_vacc(B, act, w, lane, o);
              { f32x2 yo[8]; peer_join(o, lane, yo); const int dof = (lane & 31) * 32 + ((lane >> 5) & 1) * 16;
#pragma unroll
                for (int i = 0; i < 4; ++i) *(LAS f32x4*)(part + w * 1024 + dof + 4 * i) = (f32x4){yo[2 * i].x, yo[2 * i].y, yo[2 * i + 1].x, yo[2 * i + 1].y}; }
              __syncthreads();
              const int tid = w * 64 + lane; float y0 = 0.f, y1 = 0.f;
#pragma unroll
              for (int ww = 0; ww < 8; ++ww) { y0 += part[ww * 1024 + 2 * tid]; y1 += part[ww * 1024 + 2 * tid + 1]; }
              float* xr = X + (size_t)row * DM + 2 * tid; const float2 xv = *(const float2*)xr; y0 += xv.x; y1 += xv.y;
              float* dst = last ? P.out + O_YS + (size_t)(row - NP) * DM + 2 * tid : xr; *(float2*)dst = make_float2(y0, y1);
              if (!last) { const float s = wsum64(y0 * y0 + y1 * y1); if (lane == 0) red[w] = s;
                  __syncthreads();
                  const float ss = red[0] + red[1] + red[2] + red[3] + red[4] + red[5] + red[6] + red[7]; const float rstd = rsqrtf(ss * (1.f / 1024.f) + EPS); const float2 wn = *(const float2*)(nwn + 2 * tid);
                  *(unsigned*)(Hn + (size_t)row * DM + 2 * tid) = pkbf(y0 * rstd * wn.x, y1 * rstd * wn.y); }
          } }
        __syncthreads();
#undef MK_ROWOF
    }
}

constexpr int NPH = 1 + 10 * NLAYER;
__global__ void __launch_bounds__(512, 2) mk_fwd(Params P) {
    extern __shared__ __attribute__((aligned(16))) unsigned char lds_raw[];
    LAS unsigned char* lds = (LAS unsigned char*)lds_raw;
    const int wave = __builtin_amdgcn_readfirstlane((int)threadIdx.x >> 6), bid = blockIdx.x, G = gridDim.x;
    const int nw = G * 8;
    unsigned char* ws = P.ws;
    XcdBarrier bar; bar.wv = wave; bar.bar = (unsigned*)(ws + WS_CTL); bar.x = 0; bar.st = (volatile LAS unsigned*)(lds + LDS_BAR);
    if (P.use_bar) {
        if (wave == 0 && xb_lane() == 0u) *(LAS u32x4*)(lds + LDS_BAR) = (u32x4){0u, 0u, 0u, 0u};
        __syncthreads();
        bar = xcd_barrier_post((unsigned*)(ws + WS_CTL), (volatile LAS unsigned*)(lds + LDS_BAR), wave);
    }
    const int lo = P.ph_lo, hi = P.ph_hi;
#define IN(k) (lo <= (k) && (k) < hi)
#ifndef MK_PHMASK
#define MK_PHMASK 0xffff
#endif
#define PHM(k) ((MK_PHMASK >> (k)) & 1)
#ifndef MK_P3MASK
#define MK_P3MASK 0xf
#endif
#define P3M(k) ((MK_P3MASK >> (k)) & 1)
#ifndef MK_REP
#define MK_REP -1
#endif
#define NREP(k) ((MK_REP == (k) && l == NLAYER - 1) ? 2 : 1)
#ifdef MK_DBLBAR
#define SEAM(k) do { if (IN(k) && IN((k) + 1)) { xcd_barrier(bar); xcd_barrier(bar); } } while (0)
#else
#define SEAM(k) do { if (IN(k) && IN((k) + 1)) xcd_barrier(bar); } while (0)
#endif
#define PH_T() int t_; asm volatile("v_mbcnt_lo_u32_b32 %0, -1, 0\n\tv_mbcnt_hi_u32_b32 %0, -1, %0" : "=v"(t_)); t_ += wave * 64; const int l_ = t_ & 63, w_ = __builtin_amdgcn_readfirstlane(t_ >> 6), gw_ = bid * 8 + w_, gwr_ = (G - 1 - bid) * 8 + w_; (void)l_; (void)gw_; (void)gwr_; \
    unsigned long long wsv_ = (unsigned long long)P.ws; asm volatile("" : "+s"(wsv_)); unsigned char* wsp = (unsigned char*)(__attribute__((address_space(1))) unsigned char*)wsv_;   \
    bf16_t* const H = (bf16_t*)(wsp + WS_H); bf16_t* const H2 = (bf16_t*)(wsp + WS_H2); bf16_t* const Z = (bf16_t*)(wsp + WS_Z); float* const X = (float*)(wsp + WS_XRES); \
    bf16_t* const OG = (bf16_t*)(wsp + WS_OG); float* const LSE = (float*)(wsp + WS_LSE); bf16_t* const AO = (bf16_t*)(wsp + WS_AO); \
    float* const RU = (float*)(wsp + WS_RU); bf16_t* const RS = (bf16_t*)(wsp + WS_RS); bf16_t* const ORET = (bf16_t*)(wsp + WS_ORET); \
    float* const MIX1 = (float*)(wsp + WS_MIX1); bf16_t* const MIXED = (bf16_t*)(wsp + WS_MIXED); int* const SC = (int*)(wsp + WS_SC); \
    (void)H; (void)H2; (void)Z; (void)X; (void)OG; (void)LSE; (void)AO; (void)RU; (void)RS; (void)ORET; (void)MIX1; (void)MIXED; (void)SC;
#define PH_W() const bf16_t* WtIn = (const bf16_t*)(wsp + WS_WTIN + l * SZ_WTIN); const bf16_t* WtOa = (const bf16_t*)(wsp + WS_WTOA + l * SZ_WTOA); const bf16_t* WtOr = (const bf16_t*)(wsp + WS_WTOR + l * SZ_WSQ); \
    const bf16_t* WtOut = (const bf16_t*)(wsp + WS_WTOUT + l * SZ_WSQ); const bf16_t* WtS = (const bf16_t*)(wsp + WS_WTS + l * SZ_WTS); (void)WtIn; (void)WtOa; (void)WtOr; (void)WtOut; (void)WtS;
    if (PHM(0) && IN(0)) for (int rep_ = 0; rep_ < (MK_REP == 0 ? 2 : 1); ++rep_) { PH_T(); p0_prologue(P, lds, t_, bid, G); }
    SEAM(0);
#pragma unroll
    for (int l = 0; l < NLAYER; ++l) {
        const int pb = 1 + 10 * l;
        if (PHM(1) && IN(pb + 0)) for (int rep_ = 0; rep_ < NREP(1); ++rep_) { PH_T(); PH_W(); pg8::Gemm g{H, WtIn, NP, INC, DM}; pg8::StaticOrder S; S.init(NP, INC, G, bid); const float* bg = P.in[9] + (size_t)l * 2048; EpiZ E{Z, bg};
            pg8::gemm_phase<EpiZ, pg8::StaticOrder, false>(lds, g, S, E, nullptr, t_);
            skinny<QZ>(H + (size_t)NP * DM, WtIn, INC, DM, QZ{Z, bg}, gwr_, nw, l_);
            if (bid >= G / 2) conv_tables(P, l, (bid - G / 2) * 8 + w_, (G - G / 2) * 8, l_); }
        SEAM(pb + 0);
#ifndef MK_REP3SUB
#define MK_REP3SUB 0
#endif
#define NREP3(s) ((((MK_REP3SUB >> (s)) & 1) && l == NLAYER - 1) ? 2 : 1)
        if (PHM(3) && IN(pb + 2)) { PH_T();
            if (P3M(1)) for (int rr = 0; rr < NREP3(1); ++rr) for (int u = bid; u < 512; u += G) ret1_unit(P, Z, RU, u, lds, t_);
            if (P3M(0)) for (int rr = 0; rr < NREP3(0); ++rr) attn_phase(P, l, Z, OG, LSE, lds, t_, bid, G);
        }
        SEAM(pb + 2);
        if (PHM(4) && IN(pb + 3)) for (int rep_ = 0; rep_ < NREP(4); ++rep_) { PH_T();
            for (int u = G - 1 - bid; u < 128; u += G) sret_unit(P, l, Z, ORET, u, lds, t_);
            for (int u = G - 1 - bid; u < 96; u += G) sattn_unit(P, l, Z, OG, LSE, u, lds, t_);
            p4_scan_combine(P, l, RU, RS, OG, LSE, AO, t_, bid, G); }
        SEAM(pb + 3);
        if (PHM(5) && IN(pb + 4)) for (int rep_ = 0; rep_ < NREP(5); ++rep_) { PH_T(); if (gw_ < NSMP) combine_row(OG, LSE, AO, NP + gw_, l_); for (int u = bid; u < 512; u += G) ret3_unit(P, Z, RS, ORET, u, lds, t_); }
        SEAM(pb + 4);
        if (PHM(6) && IN(pb + 5)) for (int rep_ = 0; rep_ < NREP(6); ++rep_) { PH_T(); PH_W();
            { pg8::Gemm g{AO, WtOa, NP, DM, 512}; pg8::StaticOrder S; S.init(NP, DM, G, bid); EpiQuadB<QGateA, 4> E{QGateA{Z, MIX1}};
              pg8::gemm_phase<EpiQuadB<QGateA, 4>, pg8::StaticOrder, false>(lds, g, S, E, nullptr, t_);
              skinny8<QGateA>(AO + (size_t)NP * 512, WtOa, DM, 512, QGateA{Z, MIX1}, G - 1 - bid, G, w_, l_, lds); }
            { pg8::Gemm g{ORET, WtOr, NP, DM, DM}; pg8::StaticOrder S; S.init(NP, DM, G, bid); EpiQuadB<QGateB, 4> E{QGateB{Z, MIX1, MIXED}};
              pg8::gemm_phase<EpiQuadB<QGateB, 4>, pg8::StaticOrder, false>(lds, g, S, E, nullptr, t_);
              skinny8<QGateB>(ORET + (size_t)NP * DM, WtOr, DM, DM, QGateB{Z, MIX1, MIXED}, G - 1 - bid, G, w_, l_, lds); } }
        SEAM(pb + 5);
        if (PHM(7) && IN(pb + 6)) for (int rep_ = 0; rep_ < NREP(7); ++rep_) { PH_T(); PH_W(); pg8::Gemm g{MIXED, WtOut, NP, DM, DM}; pg8::StaticOrder S; S.init(NP, DM, G, bid); const float* xp_ = l == 0 ? P.in[0] : X; const float* xs_ = l == 0 ? P.in[1] : X + (size_t)NP * DM; EpiQuadB<QRes, 4> E{QRes{xp_, xs_, X}};
            pg8::gemm_phase<EpiQuadB<QRes, 4>, pg8::StaticOrder, false>(lds, g, S, E, nullptr, t_);
            skinny8<QRes>(MIXED + (size_t)NP * DM, WtOut, DM, DM, QRes{xp_, xs_, X}, G - 1 - bid, G, w_, l_, lds); }
        SEAM(pb + 6);
        if (PHM(8) && IN(pb + 7)) for (int rep_ = 0; rep_ < NREP(8); ++rep_) { PH_T(); p8_rms(X, P.in[15] + (size_t)l * DM, H2, gw_, nw, l_); }
        SEAM(pb + 7);
        if (PHM(9) && IN(pb + 8)) for (int rep_ = 0; rep_ < NREP(9); ++rep_) { PH_T(); PH_W(); pg8::Gemm g{H2, WtS, NP, 2048, DM}; pg8::StaticOrder S; S.init(NP, 2048, G, bid); EpiQuad<QKey> E{QKey{SC}};
            pg8::gemm_phase<EpiQuad<QKey>, pg8::StaticOrder, false>(lds, g, S, E, nullptr, t_);
            skinny8<QKey>(H2 + (size_t)NP * DM, WtS, 2048, DM, QKey{SC}, G - 1 - bid, G, w_, l_, lds); }
        SEAM(pb + 8);
        if (PHM(10) && IN(pb + 9)) for (int rep_ = 0; rep_ < NREP(10); ++rep_) { PH_T(); p10_peer(P, l, SC, H2, X, H, lds, wave, bid, G); }
        SEAM(pb + 9);
    }
#undef IN
#undef SEAM
}
}

#ifndef MK_ONE_LAUNCH
#define MK_ONE_LAUNCH 1
#endif
static int t5_bucket(long dist) {
    const int max_exact = 16;
    if (dist < max_exact) return (int)dist;
    const double ratio = log((double)(dist < 1 ? 1 : dist) / max_exact) / log(2048.0 / max_exact);
    long large = max_exact + (long)(ratio * (32 - max_exact));
    return (int)(large < 31 ? large : 31);
}
extern "C" void kernel_launch(void* const* d_in, const int* in_sizes, int n_in, void* d_out, int out_size, void* d_ws, size_t ws_size, hipStream_t stream) {
    using namespace mk;
    static int grid = 0;
    if (grid == 0) {
        if (n_in != 20 || (size_t)out_size != O_END || ws_size < WS_END) { fprintf(stderr, "kernel_launch: unexpected shapes (n_in %d out %d ws %zu need %zu)\n", n_in, out_size, ws_size, (size_t)WS_END); grid = -1; return; }
        int dev = 0, cus = 0, per_cu = 0;
        if (hipGetDevice(&dev) != hipSuccess || hipDeviceGetAttribute(&cus, hipDeviceAttributeMultiprocessorCount, dev) != hipSuccess) { grid = -1; return; }
        if (hipFuncSetAttribute((const void*)mk_fwd, hipFuncAttributeMaxDynamicSharedMemorySize, LDS_BYTES) != hipSuccess) { fprintf(stderr, "kernel_launch: hipFuncSetAttribute failed\n"); grid = -1; return; }
        if (hipOccupancyMaxActiveBlocksPerMultiprocessor(&per_cu, (const void*)mk_fwd, 512, LDS_BYTES) != hipSuccess || per_cu < 1) { fprintf(stderr, "kernel_launch: occupancy query says %d\n", per_cu); (void)hipGetLastError(); }
        grid = cus;
    }
    if (grid < 0) return;
    Params p; memset(&p, 0, sizeof(p));
    for (int i = 0; i < 20; ++i) p.in[i] = (const float*)d_in[i];
    p.out = (float*)d_out; p.ws = (unsigned char*)d_ws; p.rsq128 = 0.08838834764831845f;
    for (int i = 0; i < 64; ++i) { const double lin = (i == 63) ? 1.0 : i * (1.0 / 63.0); p.ang[i] = (float)(1.0 / pow(10000.0, lin)); }
    for (int h = 0; h < 4; ++h) p.logg[h] = (float)log(1.0 - pow(2.0, -5.0 - h));
    for (int g = 0; g < 3; ++g) for (int m = 0; m <= 128; ++m) p.bucket[g][m] = (unsigned char)t5_bucket((long)m << (2 * g));
    (void)hipMemsetAsync(d_ws, 0, CTL_BYTES, stream);
#if MK_ONE_LAUNCH
    p.ph_lo = 0; p.ph_hi = NPH; p.use_bar = 1;
    hipLaunchKernelGGL(mk_fwd, dim3(grid), dim3(512), LDS_BYTES, stream, p);
#else
    for (int ph = 0; ph < NPH; ++ph) { p.ph_lo = ph; p.ph_hi = ph + 1; p.use_bar = 0; hipLaunchKernelGGL(mk_fwd, dim3(grid), dim3(512), LDS_BYTES, stream, p); }
#endif
}
```
